# Optimizing an MI355X kernel written in HIP

```python
import math
import jax, jax.numpy as jnp
from jax import lax
import numpy as np

D_MODEL = 2048
BATCH = 1
SEQ = 16384
DEPTH = 1

CHUNK = 64
Q_BLOCK = 128
D_MIX = D_MODEL
D_ATTN = D_MIX // 2
D_CONV = D_MIX - D_ATTN
V_HEAD_DIM = 128
N_DIFF_HEADS = D_ATTN // V_HEAD_DIM
QK_HEAD_DIM = V_HEAD_DIM // 2
CONV_WIDTH = 3
N_GROUPS = 4
EXPERTS_PER_GROUP = 8
N_EXPERTS = N_GROUPS * EXPERTS_PER_GROUP
TOP_K_INNER = 2
D_EXPERT = 512
MOE_BLOCK = 128
NORM_EPS = 1e-6
SUBLN_EPS = 1e-5
D_IN_PROJ = 3 * D_ATTN + 3 * D_CONV

kernel_name = "hybrid_diffattn_shortconv_hmoe_layer"


def rmsnorm(x, g, eps=NORM_EPS):
    xf = x.astype(jnp.float32)
    y = xf * lax.rsqrt(jnp.mean(xf * xf, axis=-1, keepdims=True) + eps)
    return (y * g.astype(jnp.float32)).astype(x.dtype)


def alibi_slopes(n_heads):
    start = 2.0 ** (-8.0 / n_heads)
    return jnp.asarray(start ** np.arange(1, n_heads + 1), dtype=jnp.float32)


def diff_attention(q, k, v, lam, lam_init, subln_w):
    b, s = q.shape[0], q.shape[1]
    nb = s // Q_BLOCK
    q = q * jnp.asarray(QK_HEAD_DIM ** -0.5, dtype=q.dtype)
    qb = jnp.moveaxis(q.reshape(b, nb, Q_BLOCK, N_DIFF_HEADS, 2, QK_HEAD_DIM), 1, 0)
    starts = jnp.arange(nb, dtype=jnp.int32) * Q_BLOCK
    slopes = alibi_slopes(N_DIFF_HEADS)
    kpos = jnp.arange(s, dtype=jnp.int32)

    def attend(args):
        q_blk, start = args
        sc = jnp.einsum('bqhmd,bkhmd->bmhqk', q_blk, k).astype(jnp.float32)
        qpos = start + jnp.arange(Q_BLOCK, dtype=jnp.int32)
        dist = jnp.abs(qpos[:, None] - kpos[None, :]).astype(jnp.float32)
        allowed = (kpos // CHUNK)[None, :] <= (qpos // CHUNK)[:, None]
        sc = jnp.where(allowed, sc - slopes[:, None, None] * dist, -jnp.inf)
        p = jax.nn.softmax(sc, axis=-1)
        a = p[:, 0] - lam * p[:, 1]
        return jnp.einsum('bhqk,bkhd->bqhd', a.astype(v.dtype), v)

    o = lax.map(attend, (qb, starts))
    o = jnp.moveaxis(o, 0, 1).reshape(b, s, N_DIFF_HEADS, V_HEAD_DIM)
    o = rmsnorm(o, subln_w, SUBLN_EPS) * jnp.asarray(1.0 - lam_init, dtype=o.dtype)
    return o.reshape(b, s, N_DIFF_HEADS * V_HEAD_DIM)


def short_conv(bg, cg, u, w):
    z = cg * u
    conv = lax.conv_general_dilated(
        z, w[:, None, :].astype(z.dtype), window_strides=(1,),
        padding=[(CONV_WIDTH - 1, 0)], dimension_numbers=('NWC', 'WIO', 'NWC'),
        feature_group_count=z.shape[-1])
    return bg * conv


def hier_moe(h, w_rg, b_rg, w_re, b_re, w_gate, w_up, w_down):
    b, s, d = h.shape
    t = h.reshape(-1, d)
    g_prob = jax.nn.softmax((t @ w_rg).astype(jnp.float32) + b_rg.astype(jnp.float32), axis=-1)
    g_w, g_idx = lax.top_k(g_prob, 1)
    e_logits = jnp.einsum('nd,dge->nge', t, w_re).astype(jnp.float32) + b_re.astype(jnp.float32)
    e_logits = jnp.take_along_axis(e_logits, g_idx[:, :, None], axis=1)[:, 0]
    e_w, e_idx = lax.top_k(jax.nn.softmax(e_logits, axis=-1), TOP_K_INNER)
    e_w = e_w / jnp.sum(e_w, axis=-1, keepdims=True)
    gate = g_w * e_w
    flat_idx = g_idx * EXPERTS_PER_GROUP + e_idx
    combine = jnp.sum(jax.nn.one_hot(flat_idx, N_EXPERTS, dtype=jnp.float32) * gate[..., None], axis=1)
    tb = t.reshape(-1, MOE_BLOCK, d)
    cb = combine.reshape(-1, MOE_BLOCK, N_EXPERTS).astype(t.dtype)

    def expert_block(args):
        tk, ck = args
        hg = jnp.einsum('td,edf->tef', tk, w_gate)
        hu = jnp.einsum('td,edf->tef', tk, w_up)
        a = jax.nn.silu(hg) * hu * ck[:, :, None]
        return jnp.einsum('tef,efd->td', a, w_down)

    return lax.map(expert_block, (tb, cb)).reshape(b, s, d)


def setup_inputs(seed: int = 0) -> dict:
    key = jax.random.key(seed)
    ks = jax.random.split(key, 24)
    f32 = jnp.float32
    nrm = lambda k, shape, scale: jax.random.normal(k, shape, f32) * scale
    gain = lambda k, shape: 1.0 + 0.05 * jax.random.normal(k, shape, f32)
    L = DEPTH
    return {
        "x": nrm(ks[0], (BATCH, SEQ, D_MODEL), 1.0),
        "c": nrm(ks[1], (BATCH, D_MODEL), 1.0),
        "w_ada": nrm(ks[2], (L, D_MODEL, 6 * D_MODEL), 0.5 * D_MODEL ** -0.5),
        "b_ada": nrm(ks[3], (L, 6 * D_MODEL), 0.02),
        "g_pre1": gain(ks[4], (L, D_MODEL)),
        "w_in": nrm(ks[5], (L, D_MODEL, D_IN_PROJ), D_MODEL ** -0.5),
        "lam_q1": nrm(ks[6], (L, QK_HEAD_DIM), 0.1),
        "lam_k1": nrm(ks[7], (L, QK_HEAD_DIM), 0.1),
        "lam_q2": nrm(ks[8], (L, QK_HEAD_DIM), 0.1),
        "lam_k2": nrm(ks[9], (L, QK_HEAD_DIM), 0.1),
        "g_subln": gain(ks[10], (L, V_HEAD_DIM)),
        "w_conv": nrm(ks[11], (L, CONV_WIDTH, D_CONV), CONV_WIDTH ** -0.5),
        "w_out": nrm(ks[12], (L, D_MIX, D_MODEL), D_MIX ** -0.5),
        "g_post1": gain(ks[13], (L, D_MODEL)),
        "g_pre2": gain(ks[14], (L, D_MODEL)),
        "w_router_g": nrm(ks[15], (L, D_MODEL, N_GROUPS), D_MODEL ** -0.5),
        "b_router_g": nrm(ks[16], (L, N_GROUPS), 0.01),
        "w_router_e": nrm(ks[17], (L, D_MODEL, N_GROUPS, EXPERTS_PER_GROUP), D_MODEL ** -0.5),
        "b_router_e": nrm(ks[18], (L, N_GROUPS, EXPERTS_PER_GROUP), 0.01),
        "w_gate": nrm(ks[19], (L, N_EXPERTS, D_MODEL, D_EXPERT), D_MODEL ** -0.5),
        "w_up": nrm(ks[20], (L, N_EXPERTS, D_MODEL, D_EXPERT), D_MODEL ** -0.5),
        "w_down": nrm(ks[21], (L, N_EXPERTS, D_EXPERT, D_MODEL), D_EXPERT ** -0.5),
        "g_post2": gain(ks[22], (L, D_MODEL)),
    }


def reference(x, c, w_ada, b_ada, g_pre1, w_in, lam_q1, lam_k1, lam_q2, lam_k2, g_subln,
              w_conv, w_out, g_post1, g_pre2, w_router_g, b_router_g, w_router_e, b_router_e,
              w_gate, w_up, w_down, g_post2):
    b, s, _ = x.shape
    splits = [D_ATTN, 2 * D_ATTN, 3 * D_ATTN, 3 * D_ATTN + D_CONV, 3 * D_ATTN + 2 * D_CONV]
    for l in range(DEPTH):
        lam_init = 0.8 - 0.6 * math.exp(-0.3 * l)
        mod = jax.nn.silu(c) @ w_ada[l] + b_ada[l]
        sh1, sc1, gt1, sh2, sc2, gt2 = jnp.split(mod[:, None, :], 6, axis=-1)

        h = rmsnorm(x, g_pre1[l]) * (1.0 + sc1) + sh1
        proj = h @ w_in[l]
        q, k, v, bg, cg, u = jnp.split(proj, splits, axis=-1)
        q = q.reshape(b, s, N_DIFF_HEADS, 2, QK_HEAD_DIM)
        k = k.reshape(b, s, N_DIFF_HEADS, 2, QK_HEAD_DIM)
        v = v.reshape(b, s, N_DIFF_HEADS, V_HEAD_DIM)
        lam = (jnp.exp(jnp.sum(lam_q1[l] * lam_k1[l]).astype(jnp.float32))
               - jnp.exp(jnp.sum(lam_q2[l] * lam_k2[l]).astype(jnp.float32)) + lam_init)
        y_attn = diff_attention(q, k, v, lam, lam_init, g_subln[l])
        y_conv = short_conv(bg, cg, u, w_conv[l])
        y = jnp.concatenate([y_attn, y_conv], axis=-1) @ w_out[l]
        x = x + gt1 * rmsnorm(y, g_post1[l])

        h = rmsnorm(x, g_pre2[l]) * (1.0 + sc2) + sh2
        y = hier_moe(h, w_router_g[l], b_router_g[l], w_router_e[l], b_router_e[l],
                     w_gate[l], w_up[l], w_down[l])
        x = x + gt2 * rmsnorm(y, g_post2[l])
    return x
```

```cpp
#include <hip/hip_runtime.h>
#include <hip/hip_bf16.h>
#include <cstdio>
#include <cstdint>
#include <cmath>

namespace pg8 {
#define PG8_LAS __attribute__((address_space(3)))
typedef unsigned short bf16_t;
typedef short bf16x8 __attribute__((ext_vector_type(8)));
typedef float f32x4 __attribute__((ext_vector_type(4)));
typedef unsigned u32x4 __attribute__((ext_vector_type(4)));
constexpr int BM = 256, BK = 64, HALF = 128, HTB = HALF * BK * 2  , STAGE_BYTES = 8 * HTB, NXCD = 8, WGM = 8;

__host__ __device__ __forceinline__ int lds_byte(int r, int c) { const int st = (r >> 4) * 2 + (c >> 5), rr = r & 15, cc = c & 31, ob = rr * 64 + cc * 2; return st * 1024 + (ob ^ (((ob >> 9) & 1) << 5)); }
__host__ __device__ __forceinline__ void stage_rc(int b, int& R, int& C) { const int st = b / 1024, sb = b % 1024, swz = sb ^ (((sb >> 9) & 1) << 5); R = (st >> 1) * 16 + swz / 64; C = (st & 1) * 32 + (swz % 64) / 2; }
__host__ __device__ __forceinline__ int perm32(int rho) { const int n = rho >> 4, i = rho & 15; return 8 * (i >> 2) + 4 * n + (i & 3); }

struct Unit { int pm, pn; int e, row0, nvalid; };
struct Gemm { const bf16_t* A; const bf16_t* Bt; int M, N, K; };

struct StaticOrder {
    static constexpr bool GATHER = false;
    int nM, nN, nwg, G, c;
    __host__ __device__ void init(int M, int N, int G_, int c_) { nM = M / BM; nN = N / BM; nwg = nM * nN; G = G_; c = c_; }
    __device__ __forceinline__ bool next(int i, Unit& u) const {
        const long L = (long)i * G + c; if (L >= nwg) return false;
        int wgid = (int)L; { const int q = nwg / NXCD, r = nwg % NXCD, xcd = wgid % NXCD, off = wgid / NXCD; wgid = (xcd < r ? xcd * (q + 1) : r * (q + 1) + (xcd - r) * q) + off; }
        const int nig = WGM * nN, gid = wgid / nig, fm = gid * WGM, gsz = (nM - fm) < WGM ? (nM - fm) : WGM;
        u.pm = fm + ((wgid % nig) % gsz); u.pn = (wgid % nig) / gsz; u.e = 0; u.row0 = 0; u.nvalid = 256; return true;
    }
    __device__ __forceinline__ void rows(const Unit& u, const int (&RA)[2], const int (&CA)[2], int K, unsigned (&v)[2][2]) const {
#pragma unroll
        for (int h = 0; h < 2; ++h)
#pragma unroll
            for (int i = 0; i < 2; ++i) v[h][i] = (unsigned)(((u.pm * BM + h * HALF + RA[i]) * K + CA[i]) * 2);
    }
};

__device__ __forceinline__ unsigned cvt_pk_bf16(float lo, float hi) { unsigned r; asm volatile("v_cvt_pk_bf16_f32 %0, %1, %2" : "=v"(r) : "v"(lo), "v"(hi)); return r; }

struct EpiBf16 {
    static constexpr bool PERM = true;
    bf16_t* O; int ldc; int scale_cols; float scale0;
    __device__ __forceinline__ void operator()(const f32x4 (&acc)[2][2][4][2], const Unit& u, int wr, int wc, int fr, int fq) const {
        const int row0 = u.pm * BM + wr * 64 + fr; const int colt = u.pn * BM;
        const float sc = (colt < scale_cols) ? scale0 : 1.f;
        const int col0 = colt + wc * 32 + 8 * fq;
#pragma unroll
        for (int ai = 0; ai < 2; ++ai)
#pragma unroll
            for (int m = 0; m < 4; ++m) { bf16_t* rowp = O + (size_t)(row0 + ai * HALF + m * 16) * ldc + col0;
#pragma unroll
                for (int bj = 0; bj < 2; ++bj) { f32x4 v0 = acc[ai][bj][m][0] * sc, v1 = acc[ai][bj][m][1] * sc;
                    u32x4 w; w.x = cvt_pk_bf16(v0[0], v0[1]); w.y = cvt_pk_bf16(v0[2], v0[3]); w.z = cvt_pk_bf16(v1[0], v1[1]); w.w = cvt_pk_bf16(v1[2], v1[3]);
                    *(u32x4*)(rowp + bj * HALF) = w; } }
    }
};

template <class Epi, class Sched, bool ALIGN_EPI = false>
__device__ __forceinline__ void gemm_phase(PG8_LAS unsigned char* lds, const Gemm g, const Sched& S, const Epi& E) {
    const int tid = threadIdx.x, wid = __builtin_amdgcn_readfirstlane(tid >> 6), lane = tid & 63, wr = wid >> 2, wc = wid & 3, fr = lane & 15, fq = lane >> 4;
    const int K = g.K, nt = K / BK;
    int RA[2], CA[2]; unsigned voffB[2];
#pragma unroll
    for (int i = 0; i < 2; ++i) { int R, C; stage_rc(tid * 16 + i * 8192, R, C); const int Rb = Epi::PERM ? ((R & ~31) + perm32(R & 31)) : R;
        RA[i] = R; CA[i] = C; voffB[i] = (unsigned)(Rb * K + C) * 2u; }
    const size_t kstep = (size_t)(BK * 2);
    const size_t hstep = (size_t)HALF * K * 2;
    const size_t tstep = 2 * hstep;
    const unsigned ldsw = (unsigned)wid * 1024u;
    const int aoff = lds_byte(wr * 64 + fr, fq * 8), boff = lds_byte(wc * 32 + fr, fq * 8);
    const char* const Abase = (const char*)g.A;
#define PG8_SA(b, h) (((b) * 2 + (h)) * HTB)
#define PG8_SB(b, h) ((4 + (b) * 2 + (h)) * HTB)
#define PG8_STAGE(bufoff, gbase, voff) do { _Pragma("unroll") for (int _i = 0; _i < 2; ++_i) \
        __builtin_amdgcn_global_load_lds((const unsigned*)((const char*)(gbase) + (voff)[_i]), (PG8_LAS unsigned*)(lds + (bufoff) + ldsw + _i * 8192), 16, 0, 0); } while (0)
#define PG8_STAGE_A(bufoff, v0, v1, kb) do { \
        __builtin_amdgcn_global_load_lds((const unsigned*)(Abase + (size_t)((v0) + (kb))), (PG8_LAS unsigned*)(lds + (bufoff) + ldsw), 16, 0, 0); \
        __builtin_amdgcn_global_load_lds((const unsigned*)(Abase + (size_t)((v1) + (kb))), (PG8_LAS unsigned*)(lds + (bufoff) + ldsw + 8192), 16, 0, 0); } while (0)
#define PG8_LDA(dst, b, h) do { _Pragma("unroll") for (int m = 0; m < 4; ++m) _Pragma("unroll") for (int k = 0; k < 2; ++k) dst[m][k] = *(const PG8_LAS bf16x8*)(lds + PG8_SA(b, h) + aoff + m * 2048 + k * 1024); } while (0)
#define PG8_LDB(dst, b, h) do { _Pragma("unroll") for (int n = 0; n < 2; ++n) _Pragma("unroll") for (int k = 0; k < 2; ++k) dst[n][k] = *(const PG8_LAS bf16x8*)(lds + PG8_SB(b, h) + boff + n * 2048 + k * 1024); } while (0)
#define PG8_MMA(ai, bj, At, Bt) do { __builtin_amdgcn_s_setprio(1); _Pragma("unroll") for (int m = 0; m < 4; ++m) _Pragma("unroll") for (int n = 0; n < 2; ++n) _Pragma("unroll") for (int k = 0; k < 2; ++k) \
        acc[ai][bj][m][n] = __builtin_amdgcn_mfma_f32_16x16x32_bf16(Bt[n][k], At[m][k], acc[ai][bj][m][n], 0, 0, 0); __builtin_amdgcn_s_setprio(0); } while (0)
#define PG8_WAIT_V(n) asm volatile("s_waitcnt vmcnt(" #n ")" ::: "memory")
#define PG8_WAIT_L(n) asm volatile("s_waitcnt lgkmcnt(" #n ")" ::: "memory")
#define PG8_BAR __builtin_amdgcn_s_barrier()
#define PG8_SCHED __builtin_amdgcn_sched_barrier(0)
    Unit cur, nxt; int ui = 0;
    if (!S.next(0, cur)) return;
    f32x4 acc[2][2][4][2];
#pragma unroll
    for (int a = 0; a < 2; ++a)
#pragma unroll
        for (int b = 0; b < 2; ++b)
#pragma unroll
            for (int m = 0; m < 4; ++m)
#pragma unroll
                for (int n = 0; n < 2; ++n) acc[a][b][m][n] = (f32x4){0.f, 0.f, 0.f, 0.f};
    bf16x8 At[4][2], B0[2][2], B1[2][2];
    unsigned vAc[2][2], vAn[2][2];
    S.rows(cur, RA, CA, K, vAc);
    const char* cB = (const char*)g.Bt + (size_t)cur.pn * tstep;
    PG8_STAGE(PG8_SB(0, 0), cB, voffB); PG8_STAGE(PG8_SB(0, 1), cB + hstep, voffB); PG8_STAGE_A(PG8_SA(0, 0), vAc[0][0], vAc[0][1], 0u); PG8_STAGE_A(PG8_SA(0, 1), vAc[1][0], vAc[1][1], 0u);
    if (wr == 1) PG8_BAR;
    PG8_WAIT_V(2); PG8_BAR;
    PG8_STAGE(PG8_SB(1, 0), cB + kstep, voffB); PG8_STAGE_A(PG8_SA(1, 0), vAc[0][0], vAc[0][1], (unsigned)kstep); PG8_STAGE(PG8_SB(1, 1), cB + hstep + kstep, voffB);
    PG8_WAIT_V(6); PG8_BAR;
    for (;;) {
        const bool has_next = S.next(ui + 1, nxt);
        if (has_next) S.rows(nxt, RA, CA, K, vAn);
        else { vAn[0][0] = vAc[0][0]; vAn[0][1] = vAc[0][1]; vAn[1][0] = vAc[1][0]; vAn[1][1] = vAc[1][1]; }
        const char* nB = has_next ? (const char*)g.Bt + (size_t)nxt.pn * tstep : cB;
        for (int t = 0; t < nt; t += 2) {
            const bool last = (t == nt - 2);
            const unsigned kb1 = (unsigned)(t + 1) * (unsigned)kstep;
            const unsigned kb2 = last ? 0u : (unsigned)(t + 2) * (unsigned)kstep, kb3 = kb2 + (unsigned)kstep;
            const unsigned x00 = last ? vAn[0][0] : vAc[0][0], x01 = last ? vAn[0][1] : vAc[0][1], x10 = last ? vAn[1][0] : vAc[1][0], x11 = last ? vAn[1][1] : vAc[1][1];
            const char* b2 = last ? nB : cB + (size_t)(t + 2) * kstep; const char* b3 = b2 + kstep;
            PG8_LDB(B0, 0, 0); PG8_LDB(B1, 0, 1); PG8_SCHED; PG8_LDA(At, 0, 0); PG8_STAGE_A(PG8_SA(1, 1), vAc[1][0], vAc[1][1], kb1);
            PG8_WAIT_V(8); PG8_WAIT_L(0); PG8_BAR; PG8_MMA(0, 0, At, B0); PG8_MMA(0, 1, At, B1); PG8_BAR; PG8_SCHED;
            PG8_LDA(At, 0, 1); PG8_STAGE(PG8_SB(0, 0), b2, voffB); PG8_STAGE(PG8_SB(0, 1), b2 + hstep, voffB); PG8_STAGE_A(PG8_SA(0, 0), x00, x01, kb2);
            PG8_WAIT_V(8); PG8_WAIT_L(0); PG8_BAR; PG8_MMA(1, 0, At, B0); PG8_MMA(1, 1, At, B1); PG8_BAR; PG8_SCHED;
            PG8_LDB(B0, 1, 0); PG8_LDB(B1, 1, 1); PG8_SCHED; PG8_LDA(At, 1, 0); PG8_STAGE_A(PG8_SA(0, 1), x10, x11, kb2);
            PG8_WAIT_V(8); PG8_WAIT_L(0); PG8_BAR; PG8_MMA(0, 0, At, B0); PG8_MMA(0, 1, At, B1); PG8_BAR; PG8_SCHED;
            PG8_LDA(At, 1, 1); PG8_STAGE(PG8_SB(1, 0), b3, voffB); PG8_STAGE(PG8_SB(1, 1), b3 + hstep, voffB); PG8_STAGE_A(PG8_SA(1, 0), x00, x01, kb3);
            PG8_WAIT_V(8); PG8_WAIT_L(0); PG8_BAR; PG8_MMA(1, 0, At, B0); PG8_MMA(1, 1, At, B1); PG8_BAR; PG8_SCHED;
        }
        if constexpr (ALIGN_EPI) { if (wr == 0) PG8_BAR; }
        E(acc, cur, wr, wc, fr, fq);
        if (!has_next) break;
#pragma unroll
        for (int a = 0; a < 2; ++a)
#pragma unroll
            for (int b = 0; b < 2; ++b)
#pragma unroll
                for (int m = 0; m < 4; ++m)
#pragma unroll
                    for (int n = 0; n < 2; ++n) acc[a][b][m][n] = (f32x4){0.f, 0.f, 0.f, 0.f};
        cur = nxt; cB = nB; ++ui;
        vAc[0][0] = vAn[0][0]; vAc[0][1] = vAn[0][1]; vAc[1][0] = vAn[1][0]; vAc[1][1] = vAn[1][1];
        if constexpr (ALIGN_EPI) { if (wr == 1) PG8_BAR; }
    }
    PG8_WAIT_V(0);
    if constexpr (!ALIGN_EPI) { if (wr == 0) PG8_BAR; }
    PG8_BAR;
#undef PG8_SA
#undef PG8_SB
#undef PG8_STAGE
#undef PG8_STAGE_A
#undef PG8_LDA
#undef PG8_LDB
#undef PG8_MMA
#undef PG8_WAIT_V
#undef PG8_WAIT_L
#undef PG8_BAR
#undef PG8_SCHED
}
}

namespace att {
typedef __attribute__((address_space(3))) const char* lds_cptr;
typedef __attribute__((address_space(3))) char* lds_ptr;
using bf16x8 = __attribute__((ext_vector_type(8))) short;
using s16x4 = __attribute__((ext_vector_type(4))) short;
using f32x16 = __attribute__((ext_vector_type(16))) float;
using f32x4 = __attribute__((ext_vector_type(4))) float;
using u32x4 = __attribute__((ext_vector_type(4))) unsigned;
typedef short v4i16_t __attribute__((ext_vector_type(4)));
typedef float f32x2_t __attribute__((ext_vector_type(2))); typedef __bf16 bf16x2_t __attribute__((ext_vector_type(2)));
constexpr int PITCH = 6144;
constexpr int COL_Q = 0, COL_K = 1024, COL_V = 2048;
constexpr int SLOT = 16384;
constexpr int L_K = 0, L_V = 2 * SLOT, L_X = 0, XSTRIDE = 17408, L_WS = 4 * XSTRIDE, LDS_BYTES = L_WS + 8 * 256;
constexpr float LOG2E = 1.4426950408889634f;
constexpr float QSCALE = 0.125f * LOG2E;
constexpr float THR = 6.0f;

__device__ __forceinline__ int crow(int r, int hi) { return (r & 3) + 8 * (r >> 2) + 4 * hi; }
__device__ __forceinline__ void glds16(const void* gsrc, unsigned lds_dst) { unsigned keep;
    asm volatile("s_mov_b32 %0, m0\n\ts_mov_b32 m0, %2\n\ts_nop 0\n\tglobal_load_lds_dwordx4 %1, off\n\ts_mov_b32 m0, %0" : "=&s"(keep) : "v"(gsrc), "s"(lds_dst) : "memory"); }
__device__ __forceinline__ unsigned cvtpk_s(float lo, float hi) { f32x2_t v = {lo, hi}; bf16x2_t b = __builtin_convertvector(v, bf16x2_t); return __builtin_bit_cast(unsigned, b); }
__device__ __forceinline__ s16x4 vtr(lds_cptr p) { return __builtin_bit_cast(s16x4, __builtin_amdgcn_ds_read_tr16_b64_v4i16((__attribute__((address_space(3))) v4i16_t*)p)); }

struct Tensors { const __hip_bfloat16* proj; __hip_bfloat16* ycat; const float* g_subln; float lam; };

__device__ __forceinline__ float xhalf(float v) { return __shfl_xor(v, 32); }

__device__ __forceinline__ void attn_unit(int h, int qb, const Tensors& T, lds_ptr shm) {
    typedef __hip_bfloat16 bf16;
    const int tid = threadIdx.x, lane = tid & 63, r32 = lane & 31, hi = lane >> 5; const int wid = __builtin_amdgcn_readfirstlane(tid >> 6);
    const int rb = wid & 3, mp = wid >> 2;
    const int q0 = qb * 128 + rb * 32;
    const int cw = q0 >> 6;
    const int NT = 2 * qb + 2;
    const bf16* Qw = T.proj + (size_t)q0 * PITCH + COL_Q + h * 128 + mp * 64;
    const bf16* Kh = T.proj + COL_K + h * 128; const bf16* Vh = T.proj + COL_V + h * 128;
    const unsigned lds0 = (unsigned)(uintptr_t)shm;
    lds_ptr wsf_b = shm + L_WS + wid * 256; __attribute__((address_space(3))) float* wsf = (__attribute__((address_space(3))) float*)wsf_b;
    const bf16* ksrc0 = Kh + (size_t)lane * PITCH + wid * 8;
    const bf16* ksrc1 = ksrc0 + 64;
    const bf16* vsrc0 = Vh + (size_t)(16 * (wid & 3) + (lane >> 2)) * PITCH + (wid >> 2) * 32 + (lane & 3) * 8;
    const bf16* vsrc1 = vsrc0 + 64;
    const unsigned kdst = lds0 + L_K + wid * 1024, vdst = lds0 + L_V + wid * 1024;
#define ATT_DMA(t, slot) do { const size_t toff_ = (size_t)(t) * 64 * PITCH; const unsigned so_ = (unsigned)(slot) * SLOT; \
        glds16(ksrc0 + toff_, (unsigned)__builtin_amdgcn_readfirstlane(kdst + so_)); glds16(ksrc1 + toff_, (unsigned)__builtin_amdgcn_readfirstlane(kdst + so_ + 8192)); \
        glds16(vsrc0 + toff_, (unsigned)__builtin_amdgcn_readfirstlane(vdst + so_)); glds16(vsrc1 + toff_, (unsigned)__builtin_amdgcn_readfirstlane(vdst + so_ + 8192)); } while (0)
    ATT_DMA(0, 0);
    bf16x8 qr[4];
#pragma unroll
    for (int d0 = 0; d0 < 4; ++d0) qr[d0] = *reinterpret_cast<const bf16x8*>(&Qw[(size_t)r32 * PITCH + d0 * 16 + hi * 8]);
    const float slope2 = exp2f(-(float)(h + 1)) * LOG2E;
    float mhat = 0.f, l_reg = 0.f; f32x16 o[4];
#pragma unroll
    for (int d = 0; d < 4; ++d) o[d] = f32x16{};
    const lds_cptr kp0 = (lds_cptr)shm + L_K + (mp * 8 + hi) * 1024 + r32 * 16;
    const lds_cptr vp0 = (lds_cptr)shm + L_V + ((lane >> 4) & 1) * 32 + (lane & 3) * 8 + (4 * hi + ((lane & 15) >> 2)) * 64;
    const int qpos = q0 + r32;
    for (int t = 0; t < NT; ++t) {
        const int slot = t & 1;
        if (t + 1 < NT) { ATT_DMA(t + 1, slot ^ 1); asm volatile("s_waitcnt vmcnt(4)" ::: "memory"); }
        else { asm volatile("s_waitcnt vmcnt(0)" ::: "memory"); }
        __builtin_amdgcn_s_barrier(); asm volatile("" ::: "memory");
        if (t <= cw) {
            const lds_cptr kp = kp0 + slot * SLOT;
            f32x16 p0, p1;
            { const float dq = (float)(qpos - t * 64 - 4 * hi);
#pragma unroll
              for (int r = 0; r < 16; ++r) { const float d0_ = dq - (float)((r & 3) + 8 * (r >> 2)); p0[r] = -slope2 * fabsf(d0_) - mhat; p1[r] = -slope2 * fabsf(d0_ - 32.f) - mhat; } }
#pragma unroll
            for (int d0 = 0; d0 < 4; ++d0) {
                const bf16x8 b0 = *(const __attribute__((address_space(3))) bf16x8*)(kp + d0 * 2048);
                const bf16x8 b1 = *(const __attribute__((address_space(3))) bf16x8*)(kp + d0 * 2048 + 512);
                p0 = __builtin_amdgcn_mfma_f32_32x32x16_bf16(b0, qr[d0], p0, 0, 0, 0);
                p1 = __builtin_amdgcn_mfma_f32_32x32x16_bf16(b1, qr[d0], p1, 0, 0, 0);
            }
            float rm = fmaxf(p0[0], p1[0]);
#pragma unroll
            for (int r = 1; r < 16; ++r) rm = fmaxf(rm, fmaxf(p0[r], p1[r]));
            rm = fmaxf(rm, xhalf(rm));
            const bool first = (t == 0);
            if (first || __any(rm > THR)) {
                const float dl = first ? rm : fmaxf(rm, 0.f);
                mhat += dl;
#pragma unroll
                for (int r = 0; r < 16; ++r) { p0[r] -= dl; p1[r] -= dl; }
                if (!first) {
                    const float f = __builtin_amdgcn_exp2f(-dl); l_reg *= f;
                    if (hi == 0) wsf[r32] = f;
                    asm volatile("s_waitcnt lgkmcnt(0)" ::: "memory");
                    float fr_[16];
#pragma unroll
                    for (int r = 0; r < 16; ++r) fr_[r] = wsf[crow(r, hi)];
#pragma unroll
                    for (int d = 0; d < 4; ++d)
#pragma unroll
                        for (int r = 0; r < 16; ++r) o[d][r] *= fr_[r];
                }
            }
            float sacc = 0.f;
#pragma unroll
            for (int r = 0; r < 16; ++r) { p0[r] = __builtin_amdgcn_exp2f(p0[r]); p1[r] = __builtin_amdgcn_exp2f(p1[r]); sacc += p0[r] + p1[r]; }
            l_reg += sacc;
            u32x4 pw0, pw1, pw2, pw3;
            pw0 = (u32x4){cvtpk_s(p0[0], p0[1]), cvtpk_s(p0[2], p0[3]), cvtpk_s(p0[4], p0[5]), cvtpk_s(p0[6], p0[7])};
            pw1 = (u32x4){cvtpk_s(p0[8], p0[9]), cvtpk_s(p0[10], p0[11]), cvtpk_s(p0[12], p0[13]), cvtpk_s(p0[14], p0[15])};
            pw2 = (u32x4){cvtpk_s(p1[0], p1[1]), cvtpk_s(p1[2], p1[3]), cvtpk_s(p1[4], p1[5]), cvtpk_s(p1[6], p1[7])};
            pw3 = (u32x4){cvtpk_s(p1[8], p1[9]), cvtpk_s(p1[10], p1[11]), cvtpk_s(p1[12], p1[13]), cvtpk_s(p1[14], p1[15])};
            const lds_cptr vp = vp0 + slot * SLOT;
#pragma unroll
            for (int db = 0; db < 4; ++db) {
                s16x4 lo[4], hh[4];
#pragma unroll
                for (int ks = 0; ks < 4; ++ks) { lo[ks] = vtr(vp + db * 4096 + ks * 1024); hh[ks] = vtr(vp + db * 4096 + ks * 1024 + 512); }
#define ATT_PK(k) (bf16x8){lo[k][0], lo[k][1], lo[k][2], lo[k][3], hh[k][0], hh[k][1], hh[k][2], hh[k][3]}
                o[db] = __builtin_amdgcn_mfma_f32_32x32x16_bf16(__builtin_bit_cast(bf16x8, pw0), ATT_PK(0), o[db], 0, 0, 0);
                o[db] = __builtin_amdgcn_mfma_f32_32x32x16_bf16(__builtin_bit_cast(bf16x8, pw1), ATT_PK(1), o[db], 0, 0, 0);
                o[db] = __builtin_amdgcn_mfma_f32_32x32x16_bf16(__builtin_bit_cast(bf16x8, pw2), ATT_PK(2), o[db], 0, 0, 0);
                o[db] = __builtin_amdgcn_mfma_f32_32x32x16_bf16(__builtin_bit_cast(bf16x8, pw3), ATT_PK(3), o[db], 0, 0, 0);
#undef ATT_PK
            }
        }
        asm volatile("s_waitcnt lgkmcnt(0)" ::: "memory"); __builtin_amdgcn_s_barrier(); asm volatile("" ::: "memory");
    }
#undef ATT_DMA
    l_reg += xhalf(l_reg);
    if (hi == 0) wsf[32 + r32] = l_reg;
    asm volatile("s_waitcnt lgkmcnt(0)" ::: "memory");
    float rli[16];
#pragma unroll
    for (int r = 0; r < 16; ++r) rli[r] = 1.0f / wsf[32 + crow(r, hi)];
    __attribute__((address_space(3))) float* X = (__attribute__((address_space(3))) float*)(shm + L_X + rb * XSTRIDE);
    if (mp == 1) {
#pragma unroll
        for (int d = 0; d < 4; ++d)
#pragma unroll
            for (int r = 0; r < 16; ++r) X[(d * 16 + r) * 64 + lane] = o[d][r] * rli[r];
    }
    asm volatile("s_waitcnt lgkmcnt(0)" ::: "memory"); __builtin_amdgcn_s_barrier(); asm volatile("" ::: "memory");
    if (mp == 0) {
        const float lam = T.lam;
#pragma unroll
        for (int d = 0; d < 4; ++d)
#pragma unroll
            for (int r = 0; r < 16; ++r) o[d][r] = o[d][r] * rli[r] - lam * X[(d * 16 + r) * 64 + lane];
        asm volatile("s_waitcnt lgkmcnt(0)" ::: "memory");
#pragma unroll
        for (int d = 0; d < 4; ++d)
#pragma unroll
            for (int r = 0; r < 16; ++r) X[crow(r, hi) * 132 + d * 32 + r32] = o[d][r];
        asm volatile("s_waitcnt lgkmcnt(0)" ::: "memory");
        f32x4 v[16]; float ss = 0.f;
#pragma unroll
        for (int i = 0; i < 16; ++i) { v[i] = *(const __attribute__((address_space(3))) f32x4*)(X + r32 * 132 + hi * 64 + 4 * i); ss += (v[i].x * v[i].x + v[i].y * v[i].y) + (v[i].z * v[i].z + v[i].w * v[i].w); }
        ss += xhalf(ss);
        const float rstd = 0.8f / sqrtf(ss * (1.0f / 128.0f) + 1e-5f);
        bf16* Ow = T.ycat + (size_t)(q0 + r32) * 2048 + h * 128 + hi * 64;
        const float* gs = T.g_subln + hi * 64;
#pragma unroll
        for (int i = 0; i < 8; ++i) {
            const f32x4 g0 = *(const f32x4*)(gs + 8 * i), g1 = *(const f32x4*)(gs + 8 * i + 4); const f32x4 a = v[2 * i] * rstd * g0, b = v[2 * i + 1] * rstd * g1;
            u32x4 w; w.x = cvtpk_s(a.x, a.y); w.y = cvtpk_s(a.z, a.w); w.z = cvtpk_s(b.x, b.y); w.w = cvtpk_s(b.z, b.w);
            *(u32x4*)(Ow + 8 * i) = w;
        }
    }
    asm volatile("s_waitcnt lgkmcnt(0)" ::: "memory"); __builtin_amdgcn_s_barrier(); asm volatile("" ::: "memory");
}
}

constexpr int NWAVES = 8;
constexpr int SEQ = 16384, DM = 2048, NPROJ = 6144, NHEAD = 8, NEXP = 32, DEXP = 512, CAP = 16384;
constexpr float NORM_EPS = 1e-6f;
#ifndef MK_N_LAUNCHES
#define MK_N_LAUNCHES 9
#endif
constexpr int N_PHASES = 9;
constexpr int N_LAUNCHES = MK_N_LAUNCHES;

constexpr size_t MiB = 1u << 20;
constexpr size_t WS_CTL = 0, CTL_ZERO_BYTES = 1 * MiB;
constexpr size_t WS_WRT = 1 * MiB;
constexpr size_t WS_GATES = 2 * MiB;
constexpr size_t WS_LIST = 3 * MiB;
constexpr size_t WS_WIN = 6 * MiB;
constexpr size_t WS_WOUT = 30 * MiB;
constexpr size_t WS_W1 = 38 * MiB;
constexpr size_t WS_W2 = 166 * MiB;
constexpr size_t WS_B = 230 * MiB;
constexpr size_t WS_A = 294 * MiB;
constexpr size_t WS_END = 486 * MiB;
constexpr int CW_BAR = 4096;
constexpr int CW_CNT = 8192;
constexpr int CW_MOD = 16384;

constexpr int RING_OFF = 0, RING_BYTES = 131072;
constexpr int LDSCTL_OFF = RING_BYTES;
constexpr int LDS_BYTES = 147456;
constexpr int LT_PRE = LDSCTL_OFF + 256, LT_CNT = LT_PRE + 34 * 4;

#define GAS __attribute__((address_space(1)))
#define LAS __attribute__((address_space(3)))
typedef unsigned short bf16;
typedef unsigned v4u __attribute__((ext_vector_type(4)));
typedef unsigned v2u __attribute__((ext_vector_type(2)));
typedef float f32x4 __attribute__((ext_vector_type(4)));
typedef GAS unsigned gu32;
#define RLX_AGENT __ATOMIC_RELAXED, __HIP_MEMORY_SCOPE_AGENT
#define LDS_WAIT() asm volatile("s_waitcnt lgkmcnt(0)" ::: "memory")
#define VM_WAIT() asm volatile("s_waitcnt vmcnt(0)" ::: "memory")
__device__ __forceinline__ unsigned f2bf(float f) { unsigned u = __builtin_bit_cast(unsigned, f); return (u + 0x7fffu + ((u >> 16) & 1u)) >> 16; }
__device__ __forceinline__ unsigned pk2(float lo, float hi) { return f2bf(lo) | (f2bf(hi) << 16); }
__device__ __forceinline__ float bf_lo(unsigned w) { return __builtin_bit_cast(float, w << 16); }
__device__ __forceinline__ float bf_hi(unsigned w) { return __builtin_bit_cast(float, w & 0xffff0000u); }

#define XB_TMO      128
#define XB_XCNT(j)  (256  + 64 * (j))
#define XB_XSUB(j)  (1280 + 64 * (j))
#define XB_XGEN(j)  (2304 + 64 * (j))
#define XB_TOP      3328
#define XB_TOPGEN   3392
#define XCD_BAR_WORDS 3456
#define XB_SPIN_CAP (1u << 18)

__device__ __forceinline__ unsigned xb_ld(unsigned* p)              { return __hip_atomic_load(p, __ATOMIC_RELAXED, __HIP_MEMORY_SCOPE_AGENT); }
__device__ __forceinline__ unsigned xb_add(unsigned* p, unsigned v) { return __hip_atomic_fetch_add(p, v, __ATOMIC_RELAXED, __HIP_MEMORY_SCOPE_AGENT); }
__device__ __forceinline__ unsigned xb_xcc_id() { return (unsigned)__builtin_amdgcn_s_getreg((3 << 11) | 20) & 0xFu; }
#define XB_SPIN(cond, bar) do { unsigned _sp = 0; while (cond) { __builtin_amdgcn_s_sleep(1); \
    if ((++_sp & 255u) == 0u) { if (xb_ld(&(bar)[XB_TMO])) break; if (_sp > XB_SPIN_CAP) { atomicAdd(&(bar)[XB_TMO], 1u); break; } } } } while (0)

struct XcdBarrier {
    unsigned* bar; unsigned x;
    volatile LAS unsigned* st;
};

__device__ __forceinline__ XcdBarrier xcd_barrier_post(unsigned* bar, volatile LAS unsigned* st) {
    XcdBarrier b; b.bar = bar; b.x = xb_xcc_id(); b.st = st;
    if (threadIdx.x == 0) (void)xb_add(&bar[XB_XCNT(b.x)], 1u);
    return b;
}
__device__ __forceinline__ void xcd_barrier_complete(unsigned* bar, unsigned x, unsigned& nloc, unsigned& nx) {
    const unsigned G = gridDim.x * gridDim.y * gridDim.z;
    unsigned sum, cnt, mine, sp = 0u;
    for (;;) {
        sum = 0u; cnt = 0u; mine = 0u;
#pragma unroll
        for (unsigned j = 0; j < 16; ++j) { const unsigned c = xb_ld(&bar[XB_XCNT(j)]); sum += c; cnt += (c > 0u) ? 1u : 0u; mine = (j == x) ? c : mine; }
        if (sum == G) break;
        __builtin_amdgcn_s_sleep(1);
        if ((++sp & 255u) == 0u) { if (xb_ld(&bar[XB_TMO])) break; if (sp > XB_SPIN_CAP) { atomicAdd(&bar[XB_TMO], 1u); break; } }
    }
    nloc = mine > 0u ? mine : 1u; nx = cnt > 0u ? cnt : 1u;
}

__device__ __forceinline__ void xcd_barrier(const XcdBarrier& b) {
    asm volatile("s_waitcnt vmcnt(0)" ::: "memory");
    __syncthreads();
    if (threadIdx.x == 0) {
        unsigned* bar = b.bar;
        __builtin_amdgcn_s_waitcnt(0);
        unsigned nloc = b.st[0], nx = b.st[1];
        if (nloc == 0u) { xcd_barrier_complete(bar, b.x, nloc, nx); b.st[0] = nloc; b.st[1] = nx; }
        const unsigned old = xb_add(&bar[XB_XSUB(b.x)], 1u);
        const unsigned gen = old / nloc;
        if (old + 1u == (gen + 1u) * nloc) {
            __builtin_amdgcn_fence(__ATOMIC_RELEASE, "agent");
            asm volatile("s_waitcnt vmcnt(0)" ::: "memory");
            const unsigned og = xb_add(&bar[XB_TOP], 1u);
            const unsigned tg = og / nx;
            if (og + 1u == (tg + 1u) * nx) xb_add(&bar[XB_TOPGEN], 1u);
            else XB_SPIN(xb_ld(&bar[XB_TOPGEN]) == tg, bar);
            __builtin_amdgcn_fence(__ATOMIC_ACQUIRE, "agent");
            xb_add(&bar[XB_XGEN(b.x)], 1u);
            asm volatile("s_waitcnt vmcnt(0)" ::: "memory");
        } else {
            XB_SPIN(xb_ld(&bar[XB_XGEN(b.x)]) == gen, bar);
            __builtin_amdgcn_fence(__ATOMIC_ACQUIRE, "agent");
            asm volatile("s_waitcnt vmcnt(0)" ::: "memory");
        }
    }
    __syncthreads();
}

struct Frame {
    LAS unsigned char* lds;
    gu32* ctl;
    int tid, lane, wave;
    int vcu, G;
    const float* in[23]; float* out; unsigned char* ws;
};
enum { I_X = 0, I_C, I_WADA, I_BADA, I_GPRE1, I_WIN, I_LQ1, I_LK1, I_LQ2, I_LK2, I_GSUB, I_WCONV, I_WOUT, I_GPOST1, I_GPRE2, I_WRG, I_BRG, I_WRE, I_BRE, I_WGATE, I_WUP, I_WDOWN, I_GPOST2 };

__device__ __forceinline__ float wave_sum(float v) {
#pragma unroll
    for (int o = 1; o < 64; o <<= 1) v += __shfl_xor(v, o);
    return v;
}
__device__ __forceinline__ float modval(const Frame& F, int n) {
    const long long a = ((const long long*)(F.ctl + CW_MOD))[n];
    return F.in[I_BADA][n] + (float)a * 9.094947017729282e-13f;
}

__device__ __forceinline__ void p0_transpose_item(const float* W, int K, int N, bf16* WT, int k0, int n0, int dst_row0, LAS float* scr, int lane) {
#pragma unroll 8
    for (int i = 0; i < 32; ++i) { const int kk = 2 * i + (lane >> 5); scr[kk * 33 + (lane & 31)] = W[(size_t)(k0 + kk) * N + n0 + (lane & 31)]; }
    LDS_WAIT(); asm volatile("" ::: "memory");
    const int c = lane & 7;
#pragma unroll
    for (int j = 0; j < 4; ++j) { const int n = (lane >> 3) + 8 * j; const LAS float* s = scr + (8 * c) * 33 + n;
        v4u o; o.x = pk2(s[0 * 33], s[1 * 33]); o.y = pk2(s[2 * 33], s[3 * 33]); o.z = pk2(s[4 * 33], s[5 * 33]); o.w = pk2(s[6 * 33], s[7 * 33]);
        *(GAS v4u*)(WT + (size_t)(dst_row0 + n) * K + k0 + 8 * c) = o; }
    LDS_WAIT(); asm volatile("" ::: "memory");
}

__device__ __forceinline__ void p0_prologue(Frame& F) {
    const int gw = F.vcu * NWAVES + F.wave, NGW = F.G * NWAVES;
    {
        const float* c = F.in[I_C]; const float* W = F.in[I_WADA];
        unsigned long long* acc = (unsigned long long*)(F.ctl + CW_MOD);
        for (int it = gw; it < 48 * 32; it += NGW) {
            const int cg = it % 48, ks = it / 48, k0 = ks * 64, col = cg * 256 + F.lane * 4;
            f32x4 a = {0.f, 0.f, 0.f, 0.f};
#pragma unroll 8
            for (int kk = 0; kk < 64; ++kk) { const float cv = c[k0 + kk]; const float s = cv / (1.0f + __expf(-cv)); const f32x4 w = *(const f32x4*)(W + (size_t)(k0 + kk) * 12288 + col); a += w * s; }
#pragma unroll
            for (int i = 0; i < 4; ++i) { const long long q = __float2ll_rn(a[i] * 1099511627776.0f); atomicAdd(acc + col + i, (unsigned long long)q); }
        }
    }
    {
        float* WrT = (float*)(F.ws + WS_WRT);
        for (int idx = blockIdx.x * 512 + F.tid; idx < 36 * 2048; idx += F.G * 512) { const int j = idx >> 11, k = idx & 2047;
            WrT[idx] = (j < 4) ? F.in[I_WRG][k * 4 + j] : F.in[I_WRE][k * 32 + (j - 4)]; }
    }
    LAS float* scr = (LAS float*)(F.lds + RING_OFF + F.wave * 16384);
    constexpr int I_IN = 32 * 192, I_OUT = 32 * 64, I_G = 32 * 32 * 16, I_D = 32 * 8 * 64;
    constexpr int NITEMS = I_IN + I_OUT + 2 * I_G + I_D;
    for (int it = gw; it < NITEMS; it += NGW) {
        int r = it;
        if (r < I_IN) { const int kb = r / 192, nb = r % 192; p0_transpose_item(F.in[I_WIN], 2048, 6144, (bf16*)(F.ws + WS_WIN), 64 * kb, 32 * nb, 32 * nb, scr, F.lane); continue; } r -= I_IN;
        if (r < I_OUT) { const int kb = r / 64, nb = r % 64; p0_transpose_item(F.in[I_WOUT], 2048, 2048, (bf16*)(F.ws + WS_WOUT), 64 * kb, 32 * nb, 32 * nb, scr, F.lane); continue; } r -= I_OUT;
        if (r < 2 * I_G) { const int up = r / I_G; r -= up * I_G; const int e = r / 512, q = r % 512, kb = q / 16, nb = q % 16, n0 = 32 * nb;
            p0_transpose_item(F.in[up ? I_WUP : I_WGATE] + (size_t)e * 2048 * 512, 2048, 512, (bf16*)(F.ws + WS_W1), 64 * kb, n0, e * 1024 + (n0 >> 7) * 256 + up * 128 + (n0 & 127), scr, F.lane); continue; } r -= 2 * I_G;
        { const int e = r / 512, q = r % 512, kb = q / 64, nb = q % 64;
            p0_transpose_item(F.in[I_WDOWN] + (size_t)e * 512 * 2048, 512, 2048, (bf16*)(F.ws + WS_W2), 64 * kb, 32 * nb, e * 2048 + 32 * nb, scr, F.lane); }
    }
}

__device__ __forceinline__ void p1_norm(Frame& F) {
    LAS float* tA = (LAS float*)(F.lds + RING_OFF); LAS float* tB = tA + 2048;
    for (int i = F.tid; i < 2048; i += 512) { tA[i] = F.in[I_GPRE1][i] * (1.0f + modval(F, 2048 + i)); tB[i] = modval(F, i); }
    __syncthreads();
    const int gw = F.vcu * NWAVES + F.wave, NGW = F.G * NWAVES;
    bf16* H1 = (bf16*)(F.ws + WS_B);
    for (int m = gw; m < SEQ; m += NGW) {
        const GAS f32x4* xr = (const GAS f32x4*)(F.in[I_X] + (size_t)m * DM) + F.lane;
        f32x4 v[8]; float s = 0.f;
#pragma unroll
        for (int j = 0; j < 8; ++j) { v[j] = xr[64 * j]; s += (v[j].x * v[j].x + v[j].y * v[j].y) + (v[j].z * v[j].z + v[j].w * v[j].w); }
        const float rstd = 1.0f / sqrtf(wave_sum(s) * (1.0f / DM) + NORM_EPS);
        GAS v2u* o8 = (GAS v2u*)(H1 + (size_t)m * DM) + F.lane;
#pragma unroll
        for (int j = 0; j < 8; ++j) { const f32x4 a = *(const LAS f32x4*)(tA + 256 * j + 4 * F.lane), b = *(const LAS f32x4*)(tB + 256 * j + 4 * F.lane); const f32x4 h = v[j] * rstd * a + b;
            v2u w; w.x = pk2(h.x, h.y); w.y = pk2(h.z, h.w); o8[64 * j] = w; }
    }
    __syncthreads();
}

__device__ __forceinline__ void p3_conv(Frame& F) {
    const int gw = F.vcu * NWAVES + F.wave, NGW = F.G * NWAVES;
    const bf16* P = (const bf16*)(F.ws + WS_A); bf16* Y = (bf16*)(F.ws + WS_B); const float* wc = F.in[I_WCONV];
    for (int it = gw; it < 2048; it += NGW) {
        const int t0 = (it >> 1) * 16, ch = (it & 1) * 512 + F.lane * 8;
        float w0[8], w1[8], w2[8], z1[8], z2[8];
#pragma unroll
        for (int i = 0; i < 8; ++i) { w0[i] = wc[ch + i]; w1[i] = wc[1024 + ch + i]; w2[i] = wc[2048 + ch + i]; z1[i] = 0.f; z2[i] = 0.f; }
        for (int t = t0 - 2; t < t0 + 16; ++t) {
            if (t < 0) continue;
            const bf16* row = P + (size_t)t * NPROJ;
            const v4u cg = *(const GAS v4u*)(row + 4096 + ch), xu = *(const GAS v4u*)(row + 5120 + ch);
            float z[8];
#pragma unroll
            for (int i = 0; i < 4; ++i) { z[2 * i] = bf_lo(cg[i]) * bf_lo(xu[i]); z[2 * i + 1] = bf_hi(cg[i]) * bf_hi(xu[i]); }
            if (t >= t0) {
                const v4u bg = *(const GAS v4u*)(row + 3072 + ch); float y[8];
#pragma unroll
                for (int i = 0; i < 4; ++i) { y[2 * i] = bf_lo(bg[i]) * (w0[2 * i] * z2[2 * i] + w1[2 * i] * z1[2 * i] + w2[2 * i] * z[2 * i]);
                    y[2 * i + 1] = bf_hi(bg[i]) * (w0[2 * i + 1] * z2[2 * i + 1] + w1[2 * i + 1] * z1[2 * i + 1] + w2[2 * i + 1] * z[2 * i + 1]); }
                v4u o; o.x = pk2(y[0], y[1]); o.y = pk2(y[2], y[3]); o.z = pk2(y[4], y[5]); o.w = pk2(y[6], y[7]);
                *(GAS v4u*)(Y + (size_t)t * DM + 1024 + ch) = o;
            }
#pragma unroll
            for (int i = 0; i < 8; ++i) { z2[i] = z1[i]; z1[i] = z[i]; }
        }
    }
}

__device__ __forceinline__ void p5_post_route(Frame& F) {
    LAS float* tG = (LAS float*)(F.lds + RING_OFF); LAS float* tA = tG + 2048; LAS float* tS = tA + 2048;
    for (int i = F.tid; i < 2048; i += 512) { tG[i] = modval(F, 4096 + i) * F.in[I_GPOST1][i]; tA[i] = F.in[I_GPRE2][i] * (1.0f + modval(F, 8192 + i)); tS[i] = modval(F, 6144 + i); }
    __syncthreads();
    const int gw = F.vcu * NWAVES + F.wave, NGW = F.G * NWAVES;
    const bf16* Y1 = (const bf16*)(F.ws + WS_A); bf16* H2 = (bf16*)(F.ws + WS_A + 64 * MiB);
    const float* WrT = (const float*)(F.ws + WS_WRT);
    float* gates = (float*)(F.ws + WS_GATES); int* list = (int*)(F.ws + WS_LIST); unsigned* cnt = (unsigned*)(F.ctl + CW_CNT);
    for (int b = gw; b < SEQ / 4; b += NGW) {
        f32x4 hv[4][8];
#pragma unroll
        for (int r = 0; r < 4; ++r) {
            const int m = 4 * b + r;
            const GAS f32x4* xr = (const GAS f32x4*)(F.in[I_X] + (size_t)m * DM) + F.lane;
            const GAS v2u* yr = (const GAS v2u*)(Y1 + (size_t)m * DM) + F.lane;
            f32x4 xv[8]; v2u yp[8]; float s1 = 0.f;
#pragma unroll
            for (int j = 0; j < 8; ++j) { xv[j] = xr[64 * j]; yp[j] = yr[64 * j]; const f32x4 y = (f32x4){bf_lo(yp[j].x), bf_hi(yp[j].x), bf_lo(yp[j].y), bf_hi(yp[j].y)};
                s1 += (y.x * y.x + y.y * y.y) + (y.z * y.z + y.w * y.w); }
            const float r1 = 1.0f / sqrtf(wave_sum(s1) * (1.0f / DM) + NORM_EPS);
            GAS f32x4* orow = (GAS f32x4*)(F.out + (size_t)m * DM) + F.lane; float s2 = 0.f;
#pragma unroll
            for (int j = 0; j < 8; ++j) { const f32x4 g = *(const LAS f32x4*)(tG + 256 * j + 4 * F.lane); const f32x4 y = (f32x4){bf_lo(yp[j].x), bf_hi(yp[j].x), bf_lo(yp[j].y), bf_hi(yp[j].y)};
                xv[j] = xv[j] + y * r1 * g; orow[64 * j] = xv[j];
                s2 += (xv[j].x * xv[j].x + xv[j].y * xv[j].y) + (xv[j].z * xv[j].z + xv[j].w * xv[j].w); }
            const float r2 = 1.0f / sqrtf(wave_sum(s2) * (1.0f / DM) + NORM_EPS);
            GAS v2u* h8 = (GAS v2u*)(H2 + (size_t)m * DM) + F.lane;
#pragma unroll
            for (int j = 0; j < 8; ++j) { const f32x4 a = *(const LAS f32x4*)(tA + 256 * j + 4 * F.lane), s = *(const LAS f32x4*)(tS + 256 * j + 4 * F.lane); const f32x4 h = xv[j] * r2 * a + s; hv[r][j] = h;
                v2u w; w.x = pk2(h.x, h.y); w.y = pk2(h.z, h.w); h8[64 * j] = w; }
            __builtin_amdgcn_sched_barrier(0);
        }
        LAS float* lg = (LAS float*)(F.lds + RING_OFF + 32768 + F.wave * 1024);
#pragma unroll 1
        for (int j = 0; j < 36; ++j) {
            const GAS f32x4* wr_ = (const GAS f32x4*)(WrT + (size_t)j * DM) + F.lane;
            float a0 = 0.f, a1 = 0.f, a2 = 0.f, a3 = 0.f;
#pragma unroll
            for (int q = 0; q < 8; ++q) { const f32x4 w = wr_[64 * q];
                a0 += (hv[0][q].x * w.x + hv[0][q].y * w.y) + (hv[0][q].z * w.z + hv[0][q].w * w.w);
                a1 += (hv[1][q].x * w.x + hv[1][q].y * w.y) + (hv[1][q].z * w.z + hv[1][q].w * w.w);
                a2 += (hv[2][q].x * w.x + hv[2][q].y * w.y) + (hv[2][q].z * w.z + hv[2][q].w * w.w);
                a3 += (hv[3][q].x * w.x + hv[3][q].y * w.y) + (hv[3][q].z * w.z + hv[3][q].w * w.w); }
            a0 = wave_sum(a0); a1 = wave_sum(a1); a2 = wave_sum(a2); a3 = wave_sum(a3);
            if (F.lane == 0) { lg[j] = a0; lg[36 + j] = a1; lg[72 + j] = a2; lg[108 + j] = a3; }
        }
        LDS_WAIT();
        if (F.lane < 4) {
            const int m = 4 * b + F.lane;
            const LAS float* mine = lg + 36 * F.lane;
            float gl[4]; int gi = 0; float gm;
#pragma unroll
            for (int g = 0; g < 4; ++g) gl[g] = mine[g] + F.in[I_BRG][g];
            gm = gl[0];
#pragma unroll
            for (int g = 1; g < 4; ++g) if (gl[g] > gm) { gm = gl[g]; gi = g; }
            float gs = 0.f;
#pragma unroll
            for (int g = 0; g < 4; ++g) gs += __expf(gl[g] - gm);
            const float gwt = 1.0f / gs;
            float el[8];
#pragma unroll
            for (int e = 0; e < 8; ++e) el[e] = mine[4 + gi * 8 + e] + F.in[I_BRE][gi * 8 + e];
            int i1 = 0; float l1 = el[0];
#pragma unroll
            for (int e = 1; e < 8; ++e) if (el[e] > l1) { l1 = el[e]; i1 = e; }
            int i2 = -1; float l2 = -INFINITY;
#pragma unroll
            for (int e = 0; e < 8; ++e) if (e != i1 && el[e] > l2) { l2 = el[e]; i2 = e; }
            const float w1 = 1.0f / (1.0f + __expf(l2 - l1)), w2 = 1.0f - w1;
            const int e1 = gi * 8 + i1, e2 = gi * 8 + i2;
            const unsigned p1 = atomicAdd(cnt + e1, 1u), p2 = atomicAdd(cnt + e2, 1u);
            list[e1 * CAP + (int)p1] = 2 * m; list[e2 * CAP + (int)p2] = 2 * m + 1;
            gates[2 * m] = gwt * w1; gates[2 * m + 1] = gwt * w2;
        }
    }
    __syncthreads();
}

__device__ __forceinline__ void p8_final(Frame& F) {
    LAS float* tG = (LAS float*)(F.lds + RING_OFF);
    for (int i = F.tid; i < 2048; i += 512) tG[i] = modval(F, 10240 + i) * F.in[I_GPOST2][i];
    __syncthreads();
    const int gw = F.vcu * NWAVES + F.wave, NGW = F.G * NWAVES;
    const bf16* Y2 = (const bf16*)(F.ws + WS_A);
    for (int m = gw; m < SEQ; m += NGW) {
        GAS f32x4* xr = (GAS f32x4*)(F.out + (size_t)m * DM) + F.lane;
        const GAS v2u* ya = (const GAS v2u*)(Y2 + (size_t)(2 * m) * DM) + F.lane; const GAS v2u* yb = (const GAS v2u*)(Y2 + (size_t)(2 * m + 1) * DM) + F.lane;
        f32x4 xv[8], yv[8]; float s = 0.f;
#pragma unroll
        for (int j = 0; j < 8; ++j) { xv[j] = xr[64 * j]; const v2u a = ya[64 * j], b = yb[64 * j];
            yv[j] = (f32x4){bf_lo(a.x) + bf_lo(b.x), bf_hi(a.x) + bf_hi(b.x), bf_lo(a.y) + bf_lo(b.y), bf_hi(a.y) + bf_hi(b.y)};
            s += (yv[j].x * yv[j].x + yv[j].y * yv[j].y) + (yv[j].z * yv[j].z + yv[j].w * yv[j].w); }
        const float rstd = 1.0f / sqrtf(wave_sum(s) * (1.0f / DM) + NORM_EPS);
#pragma unroll
        for (int j = 0; j < 8; ++j) { const f32x4 g = *(const LAS f32x4*)(tG + 256 * j + 4 * F.lane); xr[64 * j] = xv[j] + yv[j] * rstd * g; }
    }
}

template <int NPN, bool TOKEN_ROWS>
struct MoeOrder {
    static constexpr bool GATHER = true;
    const LAS int* pre; const LAS int* cntl; const int* list; int G, c;
    __device__ __forceinline__ bool next(int i, pg8::Unit& u) const {
        const int L = i * G + c; const int total = __builtin_amdgcn_readfirstlane(pre[32]);
        if (L >= total * NPN) return false;
        const int rt = L / NPN, pnl = L % NPN;
        int e = 0;
#pragma unroll 1
        for (int k = 1; k < 32; ++k) if (pre[k] <= rt) e = k;
        e = __builtin_amdgcn_readfirstlane(e);
        u.pm = rt; u.e = e; u.row0 = __builtin_amdgcn_readfirstlane((rt - pre[e]) * 256); const int left = __builtin_amdgcn_readfirstlane(cntl[e]) - u.row0; u.nvalid = left < 256 ? left : 256; u.pn = e * NPN + pnl;
        return true;
    }
    __device__ __forceinline__ void rows(const pg8::Unit& u, const int (&RA)[2], const int (&CA)[2], int K, unsigned (&v)[2][2]) const {
#pragma unroll
        for (int h = 0; h < 2; ++h)
#pragma unroll
            for (int i = 0; i < 2; ++i) { const int r = h * 128 + RA[i]; const int ts = list[u.e * CAP + u.row0 + (r < u.nvalid ? r : 0)];
                const int srow = TOKEN_ROWS ? (ts >> 1) : ts; v[h][i] = (unsigned)((srow * K + CA[i]) * 2); }
    }
};
struct EpiSwiglu {
    static constexpr bool PERM = true;
    bf16* act; const int* list; const float* gates;
    __device__ __forceinline__ void operator()(const pg8::f32x4 (&acc)[2][2][4][2], const pg8::Unit& u, int wr, int wc, int fr, int fq) const {
        const int pnl = u.pn & 3; const int col0 = pnl * 128 + wc * 32 + 8 * fq;
#pragma unroll
        for (int ai = 0; ai < 2; ++ai)
#pragma unroll
            for (int m = 0; m < 4; ++m) { const int r = ai * 128 + wr * 64 + m * 16 + fr;
                if (r < u.nvalid) { const int ts = list[u.e * CAP + u.row0 + r]; const float gt = gates[ts];
                    float o[8];
#pragma unroll
                    for (int n = 0; n < 2; ++n)
#pragma unroll
                        for (int i = 0; i < 4; ++i) { const float g = acc[ai][0][m][n][i], up = acc[ai][1][m][n][i]; o[4 * n + i] = g / (1.0f + __expf(-g)) * up * gt; }
                    pg8::u32x4 w; w.x = pg8::cvt_pk_bf16(o[0], o[1]); w.y = pg8::cvt_pk_bf16(o[2], o[3]); w.z = pg8::cvt_pk_bf16(o[4], o[5]); w.w = pg8::cvt_pk_bf16(o[6], o[7]);
                    *(pg8::u32x4*)(act + (size_t)ts * DEXP + col0) = w; } }
    }
};
struct EpiDown {
    static constexpr bool PERM = true;
    bf16* y2; const int* list;
    __device__ __forceinline__ void operator()(const pg8::f32x4 (&acc)[2][2][4][2], const pg8::Unit& u, int wr, int wc, int fr, int fq) const {
        const int pnl = u.pn & 7; const int col0 = pnl * 256 + wc * 32 + 8 * fq;
#pragma unroll
        for (int ai = 0; ai < 2; ++ai)
#pragma unroll
            for (int m = 0; m < 4; ++m) { const int r = ai * 128 + wr * 64 + m * 16 + fr;
                if (r < u.nvalid) { const int ts = list[u.e * CAP + u.row0 + r]; bf16* rowp = y2 + (size_t)ts * DM + col0;
#pragma unroll
                    for (int bj = 0; bj < 2; ++bj) { const pg8::f32x4 v0 = acc[ai][bj][m][0], v1 = acc[ai][bj][m][1];
                        pg8::u32x4 w; w.x = pg8::cvt_pk_bf16(v0[0], v0[1]); w.y = pg8::cvt_pk_bf16(v0[2], v0[3]); w.z = pg8::cvt_pk_bf16(v1[0], v1[1]); w.w = pg8::cvt_pk_bf16(v1[2], v1[3]);
                        *(pg8::u32x4*)(rowp + bj * 128) = w; } } }
    }
};
__device__ __forceinline__ void moe_tables(Frame& F) {
    LAS int* pre = (LAS int*)(F.lds + LT_PRE); LAS int* cl = (LAS int*)(F.lds + LT_CNT);
    if (F.tid == 0) { int s = 0; const unsigned* cnt = (const unsigned*)(F.ctl + CW_CNT);
        for (int e = 0; e < 32; ++e) { int c = (int)cnt[e]; c = c < 0 ? 0 : (c > CAP ? CAP : c); cl[e] = c; pre[e] = s; s += (c + 255) >> 8; } pre[32] = s; }
    __syncthreads();
}

struct Args { const float* in[23]; float* out; unsigned char* ws; int ph_lo, ph_hi; };
__global__ void __launch_bounds__(NWAVES * 64, 2) mk_fwd(Args args) {
    extern __shared__ __attribute__((aligned(16))) unsigned char lds[];
    Frame F;
    F.lds = (LAS unsigned char*)lds;
    F.tid = threadIdx.x; F.lane = F.tid & 63; F.wave = __builtin_amdgcn_readfirstlane(F.tid >> 6);
    F.G = gridDim.x; { const int bx = blockIdx.x; F.vcu = (F.G % 8 == 0) ? (bx % 8) * (F.G / 8) + bx / 8 : bx; }
    F.ws = args.ws; F.ctl = (gu32*)(args.ws + WS_CTL); F.out = args.out;
#pragma unroll
    for (int i = 0; i < 23; ++i) F.in[i] = args.in[i];
    for (int u = F.tid; u < (LDS_BYTES - LDSCTL_OFF) / 4; u += NWAVES * 64) ((LAS unsigned*)(F.lds + LDSCTL_OFF))[u] = 0u;
    __syncthreads();
    XcdBarrier bar; bar.bar = (unsigned*)(F.ctl + CW_BAR); bar.x = 0; bar.st = nullptr;
    if (N_LAUNCHES == 1) bar = xcd_barrier_post((unsigned*)(F.ctl + CW_BAR), (volatile LAS unsigned*)(F.lds + LDSCTL_OFF));
    const int lo = args.ph_lo, hi = args.ph_hi;
#define IN(k) (lo <= (k) && (k) < hi)
#define SEAM(k) do { if (IN(k) && IN((k) + 1)) xcd_barrier(bar); } while (0)

    if (IN(0)) { p0_prologue(F); } SEAM(0);
    if (IN(1)) { p1_norm(F); } SEAM(1);
    if (IN(2)) {
        pg8::Gemm g{(const pg8::bf16_t*)(F.ws + WS_B), (const pg8::bf16_t*)(F.ws + WS_WIN), SEQ, NPROJ, DM}; pg8::StaticOrder S; S.init(SEQ, NPROJ, F.G, (int)blockIdx.x);
        pg8::EpiBf16 E{(pg8::bf16_t*)(F.ws + WS_A), NPROJ, 1024, att::QSCALE};
        pg8::gemm_phase<pg8::EpiBf16, pg8::StaticOrder, true>(F.lds + RING_OFF, g, S, E);
    } SEAM(2);
    if (IN(3)) {
        p3_conv(F);
        float lam;
        { const float a = wave_sum(F.in[I_LQ1][F.lane] * F.in[I_LK1][F.lane]), b = wave_sum(F.in[I_LQ2][F.lane] * F.in[I_LK2][F.lane]); lam = __expf(a) - __expf(b) + 0.2f; }
        const att::Tensors T{(const __hip_bfloat16*)(F.ws + WS_A), (__hip_bfloat16*)(F.ws + WS_B), F.in[I_GSUB], lam};
        for (int p = F.vcu; p < 512; p += F.G) { const int h = p >> 6, pp = p & 63;
            att::attn_unit(h, 127 - pp, T, (att::lds_ptr)(F.lds + RING_OFF)); att::attn_unit(h, pp, T, (att::lds_ptr)(F.lds + RING_OFF)); }
    } SEAM(3);
    if (IN(4)) {
        pg8::Gemm g{(const pg8::bf16_t*)(F.ws + WS_B), (const pg8::bf16_t*)(F.ws + WS_WOUT), SEQ, DM, DM}; pg8::StaticOrder S; S.init(SEQ, DM, F.G, (int)blockIdx.x);
        pg8::EpiBf16 E{(pg8::bf16_t*)(F.ws + WS_A), DM, 0, 1.0f};
        pg8::gemm_phase<pg8::EpiBf16, pg8::StaticOrder, true>(F.lds + RING_OFF, g, S, E);
    } SEAM(4);
    if (IN(5)) { p5_post_route(F); } SEAM(5);
    if (IN(6)) {
        moe_tables(F);
        pg8::Gemm g{(const pg8::bf16_t*)(F.ws + WS_A + 64 * MiB), (const pg8::bf16_t*)(F.ws + WS_W1), SEQ, 1024, DM};
        MoeOrder<4, true> S{(const LAS int*)(F.lds + LT_PRE), (const LAS int*)(F.lds + LT_CNT), (const int*)(F.ws + WS_LIST), F.G, F.vcu};
        EpiSwiglu E{(bf16*)(F.ws + WS_A + 128 * MiB), (const int*)(F.ws + WS_LIST), (const float*)(F.ws + WS_GATES)};
        pg8::gemm_phase<EpiSwiglu, MoeOrder<4, true>, true>(F.lds + RING_OFF, g, S, E);
    } SEAM(6);
    if (IN(7)) {
        moe_tables(F);
        pg8::Gemm g{(const pg8::bf16_t*)(F.ws + WS_A + 128 * MiB), (const pg8::bf16_t*)(F.ws + WS_W2), 2 * SEQ, DM, DEXP};
        MoeOrder<8, false> S{(const LAS int*)(F.lds + LT_PRE), (const LAS int*)(F.lds + LT_CNT), (const int*)(F.ws + WS_LIST), F.G, F.vcu};
        EpiDown E{(bf16*)(F.ws + WS_A), (const int*)(F.ws + WS_LIST)};
        pg8::gemm_phase<EpiDown, MoeOrder<8, false>, true>(F.lds + RING_OFF, g, S, E);
    } SEAM(7);
    if (IN(8)) { p8_final(F); }
#undef IN
#undef SEAM
}

extern "C" void kernel_launch(void* const* d_in, const int* in_sizes, int n_in, void* d_out, int out_size, void* d_ws, size_t ws_size, hipStream_t stream) {
    static int grid = 0;
    if (grid == 0) {
        if (n_in != 23 || in_sizes[0] != SEQ * DM || out_size != SEQ * DM || ws_size < WS_END) { fprintf(stderr, "kernel_launch: shape/workspace mismatch (n_in %d, in0 %d, out %d, ws %zu < %zu); nothing launched\n", n_in, n_in > 0 ? in_sizes[0] : -1, out_size, ws_size, (size_t)WS_END); grid = -1; return; }
        int dev = 0, cus = 0, per_cu = 0;
        if (hipGetDevice(&dev) != hipSuccess || hipDeviceGetAttribute(&cus, hipDeviceAttributeMultiprocessorCount, dev) != hipSuccess) { fprintf(stderr, "kernel_launch: hipGetDevice / hipDeviceGetAttribute failed\n"); grid = -1; return; }
        if (hipFuncSetAttribute((const void*)mk_fwd, hipFuncAttributeMaxDynamicSharedMemorySize, LDS_BYTES) != hipSuccess) { fprintf(stderr, "kernel_launch: hipFuncSetAttribute failed\n"); grid = -1; return; }
        if (hipOccupancyMaxActiveBlocksPerMultiprocessor(&per_cu, (const void*)mk_fwd, NWAVES * 64, LDS_BYTES) != hipSuccess || per_cu < 1) { fprintf(stderr, "kernel_launch: occupancy query reports %d workgroups per CU\n", per_cu); }
        (void)hipGetLastError();
        grid = cus;
    }
    if (grid < 0) return;
    if (hipMemsetAsync((char*)d_ws + WS_CTL, 0, CTL_ZERO_BYTES, stream) != hipSuccess) { fprintf(stderr, "kernel_launch: hipMemsetAsync failed\n"); return; }
    Args a{};
    for (int i = 0; i < 23; ++i) a.in[i] = (const float*)d_in[i];
    a.out = (float*)d_out; a.ws = (unsigned char*)d_ws;
    for (int li = 0; li < N_LAUNCHES; ++li) {
        a.ph_lo = (N_LAUNCHES == 1) ? 0 : li; a.ph_hi = (N_LAUNCHES == 1) ? N_PHASES : li + 1;
        hipLaunchKernelGGL(mk_fwd, dim3(grid), dim3(NWAVES * 64), LDS_BYTES, stream, a);
        const hipError_t le = hipPeekAtLastError();
        if (le != hipSuccess) { fprintf(stderr, "kernel_launch: launch %d failed: %s\n", li, hipGetErrorName(le)); break; }
    }
}
```

```cpp
#include <hip/hip_runtime.h>
#include <hip/hip_bf16.h>
#include <cstdio>
#include <cstdint>
#include <cmath>

namespace pg8 {
#define PG8_LAS __attribute__((address_space(3)))
typedef unsigned short bf16_t;
typedef short bf16x8 __attribute__((ext_vector_type(8)));
typedef float f32x4 __attribute__((ext_vector_type(4)));
typedef unsigned u32x4 __attribute__((ext_vector_type(4)));
constexpr int BM = 256, BK = 64, HALF = 128, HTB = HALF * BK * 2  , STAGE_BYTES = 8 * HTB, NXCD = 8, WGM = 8;

__host__ __device__ __forceinline__ int lds_byte(int r, int c) { const int st = (r >> 4) * 2 + (c >> 5), rr = r & 15, cc = c & 31, ob = rr * 64 + cc * 2; return st * 1024 + (ob ^ (((ob >> 9) & 1) << 5)); }
__host__ __device__ __forceinline__ void stage_rc(int b, int& R, int& C) { const int st = b / 1024, sb = b % 1024, swz = sb ^ (((sb >> 9) & 1) << 5); R = (st >> 1) * 16 + swz / 64; C = (st & 1) * 32 + (swz % 64) / 2; }
__host__ __device__ __forceinline__ int perm32(int rho) { const int n = rho >> 4, i = rho & 15; return 8 * (i >> 2) + 4 * n + (i & 3); }

struct Unit { int pm, pn; int e, row0, nvalid; };
struct Gemm { const bf16_t* A; const bf16_t* Bt; int M, N, K; };

struct StaticOrder {
    static constexpr bool GATHER = false;
    int nM, nN, nwg, G, c;
    __host__ __device__ void init(int M, int N, int G_, int c_) { nM = M / BM; nN = N / BM; nwg = nM * nN; G = G_; c = c_; }
    __device__ __forceinline__ bool next(int i, Unit& u) const {
        const long L = (long)i * G + c; if (L >= nwg) return false;
        int wgid = (int)L; { const int q = nwg / NXCD, r = nwg % NXCD, xcd = wgid % NXCD, off = wgid / NXCD; wgid = (xcd < r ? xcd * (q + 1) : r * (q + 1) + (xcd - r) * q) + off; }
        const int nig = WGM * nN, gid = wgid / nig, fm = gid * WGM, gsz = (nM - fm) < WGM ? (nM - fm) : WGM;
        u.pm = fm + ((wgid % nig) % gsz); u.pn = (wgid % nig) / gsz; u.e = 0; u.row0 = 0; u.nvalid = 256; return true;
    }
    __device__ __forceinline__ void rows(const Unit& u, const int (&RA)[2], const int (&CA)[2], int K, unsigned (&v)[2][2]) const {
#pragma unroll
        for (int h = 0; h < 2; ++h)
#pragma unroll
            for (int i = 0; i < 2; ++i) v[h][i] = (unsigned)(((u.pm * BM + h * HALF + RA[i]) * K + CA[i]) * 2);
    }
};

__device__ __forceinline__ unsigned cvt_pk_bf16(float lo, float hi) { unsigned r; asm volatile("v_cvt_pk_bf16_f32 %0, %1, %2" : "=v"(r) : "v"(lo), "v"(hi)); return r; }

struct EpiBf16 {
    static constexpr bool PERM = true;
    bf16_t* O; int ldc; int scale_cols; float scale0;
    __device__ __forceinline__ void operator()(const f32x4 (&acc)[2][2][4][2], const Unit& u, int wr, int wc, int fr, int fq) const {
        const int row0 = u.pm * BM + wr * 64 + fr; const int colt = u.pn * BM;
        const float sc = (colt < scale_cols) ? scale0 : 1.f;
        const int col0 = colt + wc * 32 + 8 * fq;
#pragma unroll
        for (int ai = 0; ai < 2; ++ai)
#pragma unroll
            for (int m = 0; m < 4; ++m) { bf16_t* rowp = O + (size_t)(row0 + ai * HALF + m * 16) * ldc + col0;
#pragma unroll
                for (int bj = 0; bj < 2; ++bj) { f32x4 v0 = acc[ai][bj][m][0] * sc, v1 = acc[ai][bj][m][1] * sc;
                    u32x4 w; w.x = cvt_pk_bf16(v0[0], v0[1]); w.y = cvt_pk_bf16(v0[2], v0[3]); w.z = cvt_pk_bf16(v1[0], v1[1]); w.w = cvt_pk_bf16(v1[2], v1[3]);
                    *(u32x4*)(rowp + bj * HALF) = w; } }
    }
};

template <class Epi, class Sched, bool ALIGN_EPI = false>
__device__ __forceinline__ void gemm_phase(PG8_LAS unsigned char* lds, const Gemm g, const Sched& S, const Epi& E) {
    const int tid = threadIdx.x, wid = __builtin_amdgcn_readfirstlane(tid >> 6), lane = tid & 63, wr = wid >> 2, wc = wid & 3, fr = lane & 15, fq = lane >> 4;
    const int K = g.K, nt = K / BK;
    int RA[2], CA[2]; unsigned voffB[2];
#pragma unroll
    for (int i = 0; i < 2; ++i) { int R, C; stage_rc(tid * 16 + i * 8192, R, C); const int Rb = Epi::PERM ? ((R & ~31) + perm32(R & 31)) : R;
        RA[i] = R; CA[i] = C; voffB[i] = (unsigned)(Rb * K + C) * 2u; }
    const size_t kstep = (size_t)(BK * 2);
    const size_t hstep = (size_t)HALF * K * 2;
    const size_t tstep = 2 * hstep;
    const unsigned ldsw = (unsigned)wid * 1024u;
    const int aoff = lds_byte(wr * 64 + fr, fq * 8), boff = lds_byte(wc * 32 + fr, fq * 8);
    const char* const Abase = (const char*)g.A;
#define PG8_SA(b, h) (((b) * 2 + (h)) * HTB)
#define PG8_SB(b, h) ((4 + (b) * 2 + (h)) * HTB)
#define PG8_STAGE(bufoff, gbase, voff) do { _Pragma("unroll") for (int _i = 0; _i < 2; ++_i) \
        __builtin_amdgcn_global_load_lds((const unsigned*)((const char*)(gbase) + (voff)[_i]), (PG8_LAS unsigned*)(lds + (bufoff) + ldsw + _i * 8192), 16, 0, 0); } while (0)
#define PG8_STAGE_A(bufoff, v0, v1, kb) do { \
        __builtin_amdgcn_global_load_lds((const unsigned*)(Abase + (size_t)((v0) + (kb))), (PG8_LAS unsigned*)(lds + (bufoff) + ldsw), 16, 0, 0); \
        __builtin_amdgcn_global_load_lds((const unsigned*)(Abase + (size_t)((v1) + (kb))), (PG8_LAS unsigned*)(lds + (bufoff) + ldsw + 8192), 16, 0, 0); } while (0)
#define PG8_LDA(dst, b, h) do { _Pragma("unroll") for (int m = 0; m < 4; ++m) _Pragma("unroll") for (int k = 0; k < 2; ++k) dst[m][k] = *(const PG8_LAS bf16x8*)(lds + PG8_SA(b, h) + aoff + m * 2048 + k * 1024); } while (0)
#define PG8_LDB(dst, b, h) do { _Pragma("unroll") for (int n = 0; n < 2; ++n) _Pragma("unroll") for (int k = 0; k < 2; ++k) dst[n][k] = *(const PG8_LAS bf16x8*)(lds + PG8_SB(b, h) + boff + n * 2048 + k * 1024); } while (0)
#define PG8_MMA(ai, bj, At, Bt) do { __builtin_amdgcn_s_setprio(1); _Pragma("unroll") for (int m = 0; m < 4; ++m) _Pragma("unroll") for (int n = 0; n < 2; ++n) _Pragma("unroll") for (int k = 0; k < 2; ++k) \
        acc[ai][bj][m][n] = __builtin_amdgcn_mfma_f32_16x16x32_bf16(Bt[n][k], At[m][k], acc[ai][bj][m][n], 0, 0, 0); __builtin_amdgcn_s_setprio(0); } while (0)
#define PG8_WAIT_V(n) asm volatile("s_waitcnt vmcnt(" #n ")" ::: "memory")
#define PG8_WAIT_L(n) asm volatile("s_waitcnt lgkmcnt(" #n ")" ::: "memory")
#define PG8_BAR __builtin_amdgcn_s_barrier()
#define PG8_SCHED __builtin_amdgcn_sched_barrier(0)
    Unit cur, nxt; int ui = 0;
    if (!S.next(0, cur)) return;
    f32x4 acc[2][2][4][2];
#pragma unroll
    for (int a = 0; a < 2; ++a)
#pragma unroll
        for (int b = 0; b < 2; ++b)
#pragma unroll
            for (int m = 0; m < 4; ++m)
#pragma unroll
                for (int n = 0; n < 2; ++n) acc[a][b][m][n] = (f32x4){0.f, 0.f, 0.f, 0.f};
    bf16x8 At[4][2], B0[2][2], B1[2][2];
    unsigned vAc[2][2], vAn[2][2];
    S.rows(cur, RA, CA, K, vAc);
    const char* cB = (const char*)g.Bt + (size_t)cur.pn * tstep;
    PG8_STAGE(PG8_SB(0, 0), cB, voffB); PG8_STAGE(PG8_SB(0, 1), cB + hstep, voffB); PG8_STAGE_A(PG8_SA(0, 0), vAc[0][0], vAc[0][1], 0u); PG8_STAGE_A(PG8_SA(0, 1), vAc[1][0], vAc[1][1], 0u);
    if (wr == 1) PG8_BAR;
    PG8_WAIT_V(2); PG8_BAR;
    PG8_STAGE(PG8_SB(1, 0), cB + kstep, voffB); PG8_STAGE_A(PG8_SA(1, 0), vAc[0][0], vAc[0][1], (unsigned)kstep); PG8_STAGE(PG8_SB(1, 1), cB + hstep + kstep, voffB);
    PG8_WAIT_V(6); PG8_BAR;
    for (;;) {
        const bool has_next = S.next(ui + 1, nxt);
        if (has_next) S.rows(nxt, RA, CA, K, vAn);
        else { vAn[0][0] = vAc[0][0]; vAn[0][1] = vAc[0][1]; vAn[1][0] = vAc[1][0]; vAn[1][1] = vAc[1][1]; }
        const char* nB = has_next ? (const char*)g.Bt + (size_t)nxt.pn * tstep : cB;
        for (int t = 0; t < nt; t += 2) {
            const bool last = (t == nt - 2);
            const unsigned kb1 = (unsigned)(t + 1) * (unsigned)kstep;
            const unsigned kb2 = last ? 0u : (unsigned)(t + 2) * (unsigned)kstep, kb3 = kb2 + (unsigned)kstep;
            const unsigned x00 = last ? vAn[0][0] : vAc[0][0], x01 = last ? vAn[0][1] : vAc[0][1], x10 = last ? vAn[1][0] : vAc[1][0], x11 = last ? vAn[1][1] : vAc[1][1];
            const char* b2 = last ? nB : cB + (size_t)(t + 2) * kstep; const char* b3 = b2 + kstep;
            PG8_LDB(B0, 0, 0); PG8_LDB(B1, 0, 1); PG8_SCHED; PG8_LDA(At, 0, 0); PG8_STAGE_A(PG8_SA(1, 1), vAc[1][0], vAc[1][1], kb1);
            PG8_WAIT_V(8); PG8_WAIT_L(0); PG8_BAR; PG8_MMA(0, 0, At, B0); PG8_MMA(0, 1, At, B1); PG8_BAR; PG8_SCHED;
            PG8_LDA(At, 0, 1); PG8_STAGE(PG8_SB(0, 0), b2, voffB); PG8_STAGE(PG8_SB(0, 1), b2 + hstep, voffB); PG8_STAGE_A(PG8_SA(0, 0), x00, x01, kb2);
            PG8_WAIT_V(8); PG8_WAIT_L(0); PG8_BAR; PG8_MMA(1, 0, At, B0); PG8_MMA(1, 1, At, B1); PG8_BAR; PG8_SCHED;
            PG8_LDB(B0, 1, 0); PG8_LDB(B1, 1, 1); PG8_SCHED; PG8_LDA(At, 1, 0); PG8_STAGE_A(PG8_SA(0, 1), x10, x11, kb2);
            PG8_WAIT_V(8); PG8_WAIT_L(0); PG8_BAR; PG8_MMA(0, 0, At, B0); PG8_MMA(0, 1, At, B1); PG8_BAR; PG8_SCHED;
            PG8_LDA(At, 1, 1); PG8_STAGE(PG8_SB(1, 0), b3, voffB); PG8_STAGE(PG8_SB(1, 1), b3 + hstep, voffB); PG8_STAGE_A(PG8_SA(1, 0), x00, x01, kb3);
            PG8_WAIT_V(8); PG8_WAIT_L(0); PG8_BAR; PG8_MMA(1, 0, At, B0); PG8_MMA(1, 1, At, B1); PG8_BAR; PG8_SCHED;
        }
        if constexpr (ALIGN_EPI) { if (wr == 0) PG8_BAR; }
        E(acc, cur, wr, wc, fr, fq);
        if (!has_next) break;
#pragma unroll
        for (int a = 0; a < 2; ++a)
#pragma unroll
            for (int b = 0; b < 2; ++b)
#pragma unroll
                for (int m = 0; m < 4; ++m)
#pragma unroll
                    for (int n = 0; n < 2; ++n) acc[a][b][m][n] = (f32x4){0.f, 0.f, 0.f, 0.f};
        cur = nxt; cB = nB; ++ui;
        vAc[0][0] = vAn[0][0]; vAc[0][1] = vAn[0][1]; vAc[1][0] = vAn[1][0]; vAc[1][1] = vAn[1][1];
        if constexpr (ALIGN_EPI) { if (wr == 1) PG8_BAR; }
    }
    PG8_WAIT_V(0);
    if constexpr (!ALIGN_EPI) { if (wr == 0) PG8_BAR; }
    PG8_BAR;
#undef PG8_SA
#undef PG8_SB
#undef PG8_STAGE
#undef PG8_STAGE_A
#undef PG8_LDA
#undef PG8_LDB
#undef PG8_MMA
#undef PG8_WAIT_V
#undef PG8_WAIT_L
#undef PG8_BAR
#undef PG8_SCHED
}
}

namespace att {
typedef __attribute__((address_space(3))) const char* lds_cptr;
typedef __attribute__((address_space(3))) char* lds_ptr;
using bf16x8 = __attribute__((ext_vector_type(8))) short;
using s16x4 = __attribute__((ext_vector_type(4))) short;
using f32x16 = __attribute__((ext_vector_type(16))) float;
using f32x4 = __attribute__((ext_vector_type(4))) float;
using u32x4 = __attribute__((ext_vector_type(4))) unsigned;
typedef short v4i16_t __attribute__((ext_vector_type(4)));
typedef float f32x2_t __attribute__((ext_vector_type(2))); typedef __bf16 bf16x2_t __attribute__((ext_vector_type(2)));
constexpr int PITCH = 6144;
constexpr int COL_Q = 0, COL_K = 1024, COL_V = 2048;
constexpr int SLOT = 16384;
constexpr int L_K = 0, L_V = 2 * SLOT, L_X = 0, XSTRIDE = 17408, L_WS = 4 * XSTRIDE, LDS_BYTES = L_WS + 8 * 256;
constexpr float LOG2E = 1.4426950408889634f;
constexpr float QSCALE = 0.125f * LOG2E;
constexpr float THR = 6.0f;

__device__ __forceinline__ int crow(int r, int hi) { return (r & 3) + 8 * (r >> 2) + 4 * hi; }
__device__ __forceinline__ void glds16(const void* gsrc, unsigned lds_dst) { unsigned keep;
    asm volatile("s_mov_b32 %0, m0\n\ts_mov_b32 m0, %2\n\ts_nop 0\n\tglobal_load_lds_dwordx4 %1, off\n\ts_mov_b32 m0, %0" : "=&s"(keep) : "v"(gsrc), "s"(lds_dst) : "memory"); }
__device__ __forceinline__ unsigned cvtpk_s(float lo, float hi) { f32x2_t v = {lo, hi}; bf16x2_t b = __builtin_convertvector(v, bf16x2_t); return __builtin_bit_cast(unsigned, b); }
__device__ __forceinline__ s16x4 vtr(lds_cptr p) { return __builtin_bit_cast(s16x4, __builtin_amdgcn_ds_read_tr16_b64_v4i16((__attribute__((address_space(3))) v4i16_t*)p)); }

struct Tensors { const __hip_bfloat16* proj; __hip_bfloat16* ycat; const float* g_subln; float lam; };

__device__ __forceinline__ float xhalf(float v) { return __shfl_xor(v, 32); }

__device__ __forceinline__ void attn_unit(int h, int qb, const Tensors& T, lds_ptr shm) {
    typedef __hip_bfloat16 bf16;
    const int tid = threadIdx.x, lane = tid & 63, r32 = lane & 31, hi = lane >> 5; const int wid = __builtin_amdgcn_readfirstlane(tid >> 6);
    const int rb = wid & 3, mp = wid >> 2;
    const int q0 = qb * 128 + rb * 32;
    const int cw = q0 >> 6;
    const int NT = 2 * qb + 2;
    const bf16* Qw = T.proj + (size_t)q0 * PITCH + COL_Q + h * 128 + mp * 64;
    const bf16* Kh = T.proj + COL_K + h * 128; const bf16* Vh = T.proj + COL_V + h * 128;
    const unsigned lds0 = (unsigned)(uintptr_t)shm;
    lds_ptr wsf_b = shm + L_WS + wid * 256; __attribute__((address_space(3))) float* wsf = (__attribute__((address_space(3))) float*)wsf_b;
    const bf16* ksrc0 = Kh + (size_t)lane * PITCH + wid * 8;
    const bf16* ksrc1 = ksrc0 + 64;
    const bf16* vsrc0 = Vh + (size_t)(16 * (wid & 3) + (lane >> 2)) * PITCH + (wid >> 2) * 32 + (lane & 3) * 8;
    const bf16* vsrc1 = vsrc0 + 64;
    const unsigned kdst = lds0 + L_K + wid * 1024, vdst = lds0 + L_V + wid * 1024;
#define ATT_DMA(t, slot) do { const size_t toff_ = (size_t)(t) * 64 * PITCH; const unsigned so_ = (unsigned)(slot) * SLOT; \
        glds16(ksrc0 + toff_, (unsigned)__builtin_amdgcn_readfirstlane(kdst + so_)); glds16(ksrc1 + toff_, (unsigned)__builtin_amdgcn_readfirstlane(kdst + so_ + 8192)); \
        glds16(vsrc0 + toff_, (unsigned)__builtin_amdgcn_readfirstlane(vdst + so_)); glds16(vsrc1 + toff_, (unsigned)__builtin_amdgcn_readfirstlane(vdst + so_ + 8192)); } while (0)
    ATT_DMA(0, 0);
    bf16x8 qr[4];
#pragma unroll
    for (int d0 = 0; d0 < 4; ++d0) qr[d0] = *reinterpret_cast<const bf16x8*>(&Qw[(size_t)r32 * PITCH + d0 * 16 + hi * 8]);
    const float slope2 = exp2f(-(float)(h + 1)) * LOG2E;
    float mhat = 0.f, l_reg = 0.f; f32x16 o[4];
#pragma unroll
    for (int d = 0; d < 4; ++d) o[d] = f32x16{};
    const lds_cptr kp0 = (lds_cptr)shm + L_K + (mp * 8 + hi) * 1024 + r32 * 16;
    const lds_cptr vp0 = (lds_cptr)shm + L_V + ((lane >> 4) & 1) * 32 + (lane & 3) * 8 + (4 * hi + ((lane & 15) >> 2)) * 64;
    const int qpos = q0 + r32;
    for (int t = 0; t < NT; ++t) {
        const int slot = t & 1;
        if (t + 1 < NT) { ATT_DMA(t + 1, slot ^ 1); asm volatile("s_waitcnt vmcnt(4)" ::: "memory"); }
        else { asm volatile("s_waitcnt vmcnt(0)" ::: "memory"); }
        __builtin_amdgcn_s_barrier(); asm volatile("" ::: "memory");
        if (t <= cw) {
            const lds_cptr kp = kp0 + slot * SLOT;
            f32x16 p0, p1;
            { const float dq = (float)(qpos - t * 64 - 4 * hi);
#pragma unroll
              for (int r = 0; r < 16; ++r) { const float d0_ = dq - (float)((r & 3) + 8 * (r >> 2)); p0[r] = -slope2 * fabsf(d0_) - mhat; p1[r] = -slope2 * fabsf(d0_ - 32.f) - mhat; } }
#pragma unroll
            for (int d0 = 0; d0 < 4; ++d0) {
                const bf16x8 b0 = *(const __attribute__((address_space(3))) bf16x8*)(kp + d0 * 2048);
                const bf16x8 b1 = *(const __attribute__((address_space(3))) bf16x8*)(kp + d0 * 2048 + 512);
                p0 = __builtin_amdgcn_mfma_f32_32x32x16_bf16(b0, qr[d0], p0, 0, 0, 0);
                p1 = __builtin_amdgcn_mfma_f32_32x32x16_bf16(b1, qr[d0], p1, 0, 0, 0);
            }
            float rm = fmaxf(p0[0], p1[0]);
#pragma unroll
            for (int r = 1; r < 16; ++r) rm = fmaxf(rm, fmaxf(p0[r], p1[r]));
            rm = fmaxf(rm, xhalf(rm));
            const bool first = (t == 0);
            if (first || __any(rm > THR)) {
                const float dl = first ? rm : fmaxf(rm, 0.f);
                mhat += dl;
#pragma unroll
                for (int r = 0; r < 16; ++r) { p0[r] -= dl; p1[r] -= dl; }
                if (!first) {
                    const float f = __builtin_amdgcn_exp2f(-dl); l_reg *= f;
                    if (hi == 0) wsf[r32] = f;
                    asm volatile("s_waitcnt lgkmcnt(0)" ::: "memory");
                    float fr_[16];
#pragma unroll
                    for (int r = 0; r < 16; ++r) fr_[r] = wsf[crow(r, hi)];
#pragma unroll
                    for (int d = 0; d < 4; ++d)
#pragma unroll
                        for (int r = 0; r < 16; ++r) o[d][r] *= fr_[r];
                }
            }
            float sacc = 0.f;
#pragma unroll
            for (int r = 0; r < 16; ++r) { p0[r] = __builtin_amdgcn_exp2f(p0[r]); p1[r] = __builtin_amdgcn_exp2f(p1[r]); sacc += p0[r] + p1[r]; }
            l_reg += sacc;
            u32x4 pw0, pw1, pw2, pw3;
            pw0 = (u32x4){cvtpk_s(p0[0], p0[1]), cvtpk_s(p0[2], p0[3]), cvtpk_s(p0[4], p0[5]), cvtpk_s(p0[6], p0[7])};
            pw1 = (u32x4){cvtpk_s(p0[8], p0[9]), cvtpk_s(p0[10], p0[11]), cvtpk_s(p0[12], p0[13]), cvtpk_s(p0[14], p0[15])};
            pw2 = (u32x4){cvtpk_s(p1[0], p1[1]), cvtpk_s(p1[2], p1[3]), cvtpk_s(p1[4], p1[5]), cvtpk_s(p1[6], p1[7])};
            pw3 = (u32x4){cvtpk_s(p1[8], p1[9]), cvtpk_s(p1[10], p1[11]), cvtpk_s(p1[12], p1[13]), cvtpk_s(p1[14], p1[15])};
            const lds_cptr vp = vp0 + slot * SLOT;
#pragma unroll
            for (int db = 0; db < 4; ++db) {
                s16x4 lo[4], hh[4];
#pragma unroll
                for (int ks = 0; ks < 4; ++ks) { lo[ks] = vtr(vp + db * 4096 + ks * 1024); hh[ks] = vtr(vp + db * 4096 + ks * 1024 + 512); }
#define ATT_PK(k) (bf16x8){lo[k][0], lo[k][1], lo[k][2], lo[k][3], hh[k][0], hh[k][1], hh[k][2], hh[k][3]}
                o[db] = __builtin_amdgcn_mfma_f32_32x32x16_bf16(__builtin_bit_cast(bf16x8, pw0), ATT_PK(0), o[db], 0, 0, 0);
                o[db] = __builtin_amdgcn_mfma_f32_32x32x16_bf16(__builtin_bit_cast(bf16x8, pw1), ATT_PK(1), o[db], 0, 0, 0);
                o[db] = __builtin_amdgcn_mfma_f32_32x32x16_bf16(__builtin_bit_cast(bf16x8, pw2), ATT_PK(2), o[db], 0, 0, 0);
                o[db] = __builtin_amdgcn_mfma_f32_32x32x16_bf16(__builtin_bit_cast(bf16x8, pw3), ATT_PK(3), o[db], 0, 0, 0);
#undef ATT_PK
            }
        }
        asm volatile("s_waitcnt lgkmcnt(0)" ::: "memory"); __builtin_amdgcn_s_barrier(); asm volatile("" ::: "memory");
    }
#undef ATT_DMA
    l_reg += xhalf(l_reg);
    if (hi == 0) wsf[32 + r32] = l_reg;
    asm volatile("s_waitcnt lgkmcnt(0)" ::: "memory");
    float rli[16];
#pragma unroll
    for (int r = 0; r < 16; ++r) rli[r] = 1.0f / wsf[32 + crow(r, hi)];
    __attribute__((address_space(3))) float* X = (__attribute__((address_space(3))) float*)(shm + L_X + rb * XSTRIDE);
    if (mp == 1) {
#pragma unroll
        for (int d = 0; d < 4; ++d)
#pragma unroll
            for (int r = 0; r < 16; ++r) X[(d * 16 + r) * 64 + lane] = o[d][r] * rli[r];
    }
    asm volatile("s_waitcnt lgkmcnt(0)" ::: "memory"); __builtin_amdgcn_s_barrier(); asm volatile("" ::: "memory");
    if (mp == 0) {
        const float lam = T.lam;
#pragma unroll
        for (int d = 0; d < 4; ++d)
#pragma unroll
            for (int r = 0; r < 16; ++r) o[d][r] = o[d][r] * rli[r] - lam * X[(d * 16 + r) * 64 + lane];
        asm volatile("s_waitcnt lgkmcnt(0)" ::: "memory");
#pragma unroll
        for (int d = 0; d < 4; ++d)
#pragma unroll
            for (int r = 0; r < 16; ++r) X[crow(r, hi) * 132 + d * 32 + r32] = o[d][r];
        asm volatile("s_waitcnt lgkmcnt(0)" ::: "memory");
        f32x4 v[16]; float ss = 0.f;
#pragma unroll
        for (int i = 0; i < 16; ++i) { v[i] = *(const __attribute__((address_space(3))) f32x4*)(X + r32 * 132 + hi * 64 + 4 * i); ss += (v[i].x * v[i].x + v[i].y * v[i].y) + (v[i].z * v[i].z + v[i].w * v[i].w); }
        ss += xhalf(ss);
        const float rstd = 0.8f / sqrtf(ss * (1.0f / 128.0f) + 1e-5f);
        bf16* Ow = T.ycat + (size_t)(q0 + r32) * 2048 + h * 128 + hi * 64;
        const float* gs = T.g_subln + hi * 64;
#pragma unroll
        for (int i = 0; i < 8; ++i) {
            const f32x4 g0 = *(const f32x4*)(gs + 8 * i), g1 = *(const f32x4*)(gs + 8 * i + 4); const f32x4 a = v[2 * i] * rstd * g0, b = v[2 * i + 1] * rstd * g1;
            u32x4 w; w.x = cvtpk_s(a.x, a.y); w.y = cvtpk_s(a.z, a.w); w.z = cvtpk_s(b.x, b.y); w.w = cvtpk_s(b.z, b.w);
            *(u32x4*)(Ow + 8 * i) = w;
        }
    }
    asm volatile("s_waitcnt lgkmcnt(0)" ::: "memory"); __builtin_amdgcn_s_barrier(); asm volatile("" ::: "memory");
}
}

constexpr int NWAVES = 8;
constexpr int SEQ = 16384, DM = 2048, NPROJ = 6144, NHEAD = 8, NEXP = 32, DEXP = 512, CAP = 16384;
constexpr float NORM_EPS = 1e-6f;
#ifndef MK_N_LAUNCHES
#define MK_N_LAUNCHES 1
#endif
constexpr int N_PHASES = 9;
constexpr int N_LAUNCHES = MK_N_LAUNCHES;

constexpr size_t MiB = 1u << 20;
constexpr size_t WS_CTL = 0, CTL_ZERO_BYTES = 1 * MiB;
constexpr size_t WS_WRT = 1 * MiB;
constexpr size_t WS_GATES = 2 * MiB;
constexpr size_t WS_LIST = 3 * MiB;
constexpr size_t WS_WIN = 6 * MiB;
constexpr size_t WS_WOUT = 30 * MiB;
constexpr size_t WS_W1 = 38 * MiB;
constexpr size_t WS_W2 = 166 * MiB;
constexpr size_t WS_B = 230 * MiB;
constexpr size_t WS_A = 294 * MiB;
constexpr size_t WS_END = 486 * MiB;
constexpr int CW_BAR = 4096;
constexpr int CW_CNT = 8192;
constexpr int CW_MOD = 16384;

constexpr int RING_OFF = 0, RING_BYTES = 131072;
constexpr int LDSCTL_OFF = RING_BYTES;
constexpr int LDS_BYTES = 147456;
constexpr int LT_PRE = LDSCTL_OFF + 256, LT_CNT = LT_PRE + 34 * 4;

#define GAS __attribute__((address_space(1)))
#define LAS __attribute__((address_space(3)))
typedef unsigned short bf16;
typedef unsigned v4u __attribute__((ext_vector_type(4)));
typedef unsigned v2u __attribute__((ext_vector_type(2)));
typedef float f32x4 __attribute__((ext_vector_type(4)));
typedef GAS unsigned gu32;
#define RLX_AGENT __ATOMIC_RELAXED, __HIP_MEMORY_SCOPE_AGENT
#define LDS_WAIT() asm volatile("s_waitcnt lgkmcnt(0)" ::: "memory")
#define VM_WAIT() asm volatile("s_waitcnt vmcnt(0)" ::: "memory")
__device__ __forceinline__ unsigned f2bf(float f) { unsigned u = __builtin_bit_cast(unsigned, f); return (u + 0x7fffu + ((u >> 16) & 1u)) >> 16; }
__device__ __forceinline__ unsigned pk2(float lo, float hi) { return f2bf(lo) | (f2bf(hi) << 16); }
__device__ __forceinline__ float bf_lo(unsigned w) { return __builtin_bit_cast(float, w << 16); }
__device__ __forceinline__ float bf_hi(unsigned w) { return __builtin_bit_cast(float, w & 0xffff0000u); }

#define XB_TMO      128
#define XB_XCNT(j)  (256  + 64 * (j))
#define XB_XSUB(j)  (1280 + 64 * (j))
#define XB_XGEN(j)  (2304 + 64 * (j))
#define XB_TOP      3328
#define XB_TOPGEN   3392
#define XCD_BAR_WORDS 3456
#define XB_SPIN_CAP (1u << 18)

__device__ __forceinline__ unsigned xb_ld(unsigned* p)              { return __hip_atomic_load(p, __ATOMIC_RELAXED, __HIP_MEMORY_SCOPE_AGENT); }
__device__ __forceinline__ unsigned xb_add(unsigned* p, unsigned v) { return __hip_atomic_fetch_add(p, v, __ATOMIC_RELAXED, __HIP_MEMORY_SCOPE_AGENT); }
__device__ __forceinline__ unsigned xb_xcc_id() { return (unsigned)__builtin_amdgcn_s_getreg((3 << 11) | 20) & 0xFu; }
#define XB_SPIN(cond, bar) do { unsigned _sp = 0; while (cond) { __builtin_amdgcn_s_sleep(1); \
    if ((++_sp & 255u) == 0u) { if (xb_ld(&(bar)[XB_TMO])) break; if (_sp > XB_SPIN_CAP) { atomicAdd(&(bar)[XB_TMO], 1u); break; } } } } while (0)

struct XcdBarrier {
    unsigned* bar; unsigned x;
    volatile LAS unsigned* st;
};

__device__ __forceinline__ XcdBarrier xcd_barrier_post(unsigned* bar, volatile LAS unsigned* st) {
    XcdBarrier b; b.bar = bar; b.x = xb_xcc_id(); b.st = st;
    if (threadIdx.x == 0) (void)xb_add(&bar[XB_XCNT(b.x)], 1u);
    return b;
}
__device__ __forceinline__ void xcd_barrier_complete(unsigned* bar, unsigned x, unsigned& nloc, unsigned& nx) {
    const unsigned G = gridDim.x * gridDim.y * gridDim.z;
    unsigned sum, cnt, mine, sp = 0u;
    for (;;) {
        sum = 0u; cnt = 0u; mine = 0u;
#pragma unroll
        for (unsigned j = 0; j < 16; ++j) { const unsigned c = xb_ld(&bar[XB_XCNT(j)]); sum += c; cnt += (c > 0u) ? 1u : 0u; mine = (j == x) ? c : mine; }
        if (sum == G) break;
        __builtin_amdgcn_s_sleep(1);
        if ((++sp & 255u) == 0u) { if (xb_ld(&bar[XB_TMO])) break; if (sp > XB_SPIN_CAP) { atomicAdd(&bar[XB_TMO], 1u); break; } }
    }
    nloc = mine > 0u ? mine : 1u; nx = cnt > 0u ? cnt : 1u;
}

__device__ __forceinline__ void xcd_barrier(const XcdBarrier& b) {
    asm volatile("s_waitcnt vmcnt(0)" ::: "memory");
    __syncthreads();
    if (threadIdx.x == 0) {
        unsigned* bar = b.bar;
        __builtin_amdgcn_s_waitcnt(0);
        unsigned nloc = b.st[0], nx = b.st[1];
        if (nloc == 0u) { xcd_barrier_complete(bar, b.x, nloc, nx); b.st[0] = nloc; b.st[1] = nx; }
        const unsigned old = xb_add(&bar[XB_XSUB(b.x)], 1u);
        const unsigned gen = old / nloc;
        if (old + 1u == (gen + 1u) * nloc) {
            __builtin_amdgcn_fence(__ATOMIC_RELEASE, "agent");
            asm volatile("s_waitcnt vmcnt(0)" ::: "memory");
            const unsigned og = xb_add(&bar[XB_TOP], 1u);
            const unsigned tg = og / nx;
            if (og + 1u == (tg + 1u) * nx) xb_add(&bar[XB_TOPGEN], 1u);
            else XB_SPIN(xb_ld(&bar[XB_TOPGEN]) == tg, bar);
            __builtin_amdgcn_fence(__ATOMIC_ACQUIRE, "agent");
            xb_add(&bar[XB_XGEN(b.x)], 1u);
            asm volatile("s_waitcnt vmcnt(0)" ::: "memory");
        } else {
            XB_SPIN(xb_ld(&bar[XB_XGEN(b.x)]) == gen, bar);
            __builtin_amdgcn_fence(__ATOMIC_ACQUIRE, "agent");
            asm volatile("s_waitcnt vmcnt(0)" ::: "memory");
        }
    }
    __syncthreads();
}

struct Frame {
    LAS unsigned char* lds;
    gu32* ctl;
    int tid, lane, wave;
    int vcu, G;
    const float* in[23]; float* out; unsigned char* ws;
};
enum { I_X = 0, I_C, I_WADA, I_BADA, I_GPRE1, I_WIN, I_LQ1, I_LK1, I_LQ2, I_LK2, I_GSUB, I_WCONV, I_WOUT, I_GPOST1, I_GPRE2, I_WRG, I_BRG, I_WRE, I_BRE, I_WGATE, I_WUP, I_WDOWN, I_GPOST2 };

__device__ __forceinline__ float wave_sum(float v) {
#pragma unroll
    for (int o = 1; o < 64; o <<= 1) v += __shfl_xor(v, o);
    return v;
}
__device__ __forceinline__ float modval(const Frame& F, int n) {
    const long long a = ((const long long*)(F.ctl + CW_MOD))[n];
    return F.in[I_BADA][n] + (float)a * 9.094947017729282e-13f;
}

__device__ __forceinline__ void p0_transpose_item(const float* W, int K, int N, bf16* WT, int k0, int n0, int dst_row0, LAS float* scr, int lane) {
#pragma unroll 8
    for (int i = 0; i < 32; ++i) { const int kk = 2 * i + (lane >> 5); scr[kk * 33 + (lane & 31)] = W[(size_t)(k0 + kk) * N + n0 + (lane & 31)]; }
    LDS_WAIT(); asm volatile("" ::: "memory");
    const int c = lane & 7;
#pragma unroll
    for (int j = 0; j < 4; ++j) { const int n = (lane >> 3) + 8 * j; const LAS float* s = scr + (8 * c) * 33 + n;
        v4u o; o.x = pk2(s[0 * 33], s[1 * 33]); o.y = pk2(s[2 * 33], s[3 * 33]); o.z = pk2(s[4 * 33], s[5 * 33]); o.w = pk2(s[6 * 33], s[7 * 33]);
        *(GAS v4u*)(WT + (size_t)(dst_row0 + n) * K + k0 + 8 * c) = o; }
    LDS_WAIT(); asm volatile("" ::: "memory");
}

__device__ __forceinline__ void p0_prologue(Frame& F) {
    const int gw = F.vcu * NWAVES + F.wave, NGW = F.G * NWAVES;
    {
        const float* c = F.in[I_C]; const float* W = F.in[I_WADA];
        unsigned long long* acc = (unsigned long long*)(F.ctl + CW_MOD);
        for (int it = gw; it < 48 * 32; it += NGW) {
            const int cg = it % 48, ks = it / 48, k0 = ks * 64, col = cg * 256 + F.lane * 4;
            f32x4 a = {0.f, 0.f, 0.f, 0.f};
#pragma unroll 8
            for (int kk = 0; kk < 64; ++kk) { const float cv = c[k0 + kk]; const float s = cv / (1.0f + __expf(-cv)); const f32x4 w = *(const f32x4*)(W + (size_t)(k0 + kk) * 12288 + col); a += w * s; }
#pragma unroll
            for (int i = 0; i < 4; ++i) { const long long q = __float2ll_rn(a[i] * 1099511627776.0f); atomicAdd(acc + col + i, (unsigned long long)q); }
        }
    }
    {
        float* WrT = (float*)(F.ws + WS_WRT);
        for (int idx = blockIdx.x * 512 + F.tid; idx < 36 * 2048; idx += F.G * 512) { const int j = idx >> 11, k = idx & 2047;
            WrT[idx] = (j < 4) ? F.in[I_WRG][k * 4 + j] : F.in[I_WRE][k * 32 + (j - 4)]; }
    }
    LAS float* scr = (LAS float*)(F.lds + RING_OFF + F.wave * 16384);
    constexpr int I_IN = 32 * 192, I_OUT = 32 * 64, I_G = 32 * 32 * 16, I_D = 32 * 8 * 64;
    constexpr int NITEMS = I_IN + I_OUT + 2 * I_G + I_D;
    for (int it = gw; it < NITEMS; it += NGW) {
        int r = it;
        if (r < I_IN) { const int kb = r / 192, nb = r % 192; p0_transpose_item(F.in[I_WIN], 2048, 6144, (bf16*)(F.ws + WS_WIN), 64 * kb, 32 * nb, 32 * nb, scr, F.lane); continue; } r -= I_IN;
        if (r < I_OUT) { const int kb = r / 64, nb = r % 64; p0_transpose_item(F.in[I_WOUT], 2048, 2048, (bf16*)(F.ws + WS_WOUT), 64 * kb, 32 * nb, 32 * nb, scr, F.lane); continue; } r -= I_OUT;
        if (r < 2 * I_G) { const int up = r / I_G; r -= up * I_G; const int e = r / 512, q = r % 512, kb = q / 16, nb = q % 16, n0 = 32 * nb;
            p0_transpose_item(F.in[up ? I_WUP : I_WGATE] + (size_t)e * 2048 * 512, 2048, 512, (bf16*)(F.ws + WS_W1), 64 * kb, n0, e * 1024 + (n0 >> 7) * 256 + up * 128 + (n0 & 127), scr, F.lane); continue; } r -= 2 * I_G;
        { const int e = r / 512, q = r % 512, kb = q / 64, nb = q % 64;
            p0_transpose_item(F.in[I_WDOWN] + (size_t)e * 512 * 2048, 512, 2048, (bf16*)(F.ws + WS_W2), 64 * kb, 32 * nb, e * 2048 + 32 * nb, scr, F.lane); }
    }
}

__device__ __forceinline__ void p1_norm(Frame& F) {
    LAS float* tA = (LAS float*)(F.lds + RING_OFF); LAS float* tB = tA + 2048;
    for (int i = F.tid; i < 2048; i += 512) { tA[i] = F.in[I_GPRE1][i] * (1.0f + modval(F, 2048 + i)); tB[i] = modval(F, i); }
    __syncthreads();
    const int gw = F.vcu * NWAVES + F.wave, NGW = F.G * NWAVES;
    bf16* H1 = (bf16*)(F.ws + WS_B);
    for (int m = gw; m < SEQ; m += NGW) {
        const GAS f32x4* xr = (const GAS f32x4*)(F.in[I_X] + (size_t)m * DM) + F.lane;
        f32x4 v[8]; float s = 0.f;
#pragma unroll
        for (int j = 0; j < 8; ++j) { v[j] = xr[64 * j]; s += (v[j].x * v[j].x + v[j].y * v[j].y) + (v[j].z * v[j].z + v[j].w * v[j].w); }
        const float rstd = 1.0f / sqrtf(wave_sum(s) * (1.0f / DM) + NORM_EPS);
        GAS v2u* o8 = (GAS v2u*)(H1 + (size_t)m * DM) + F.lane;
#pragma unroll
        for (int j = 0; j < 8; ++j) { const f32x4 a = *(const LAS f32x4*)(tA + 256 * j + 4 * F.lane), b = *(const LAS f32x4*)(tB + 256 * j + 4 * F.lane); const f32x4 h = v[j] * rstd * a + b;
            v2u w; w.x = pk2(h.x, h.y); w.y = pk2(h.z, h.w); o8[64 * j] = w; }
    }
    __syncthreads();
}

__device__ __forceinline__ void p3_conv(Frame& F) {
    const int gw = F.vcu * NWAVES + F.wave, NGW = F.G * NWAVES;
    const bf16* P = (const bf16*)(F.ws + WS_A); bf16* Y = (bf16*)(F.ws + WS_B); const float* wc = F.in[I_WCONV];
    for (int it = gw; it < 2048; it += NGW) {
        const int t0 = (it >> 1) * 16, ch = (it & 1) * 512 + F.lane * 8;
        float w0[8], w1[8], w2[8], z1[8], z2[8];
#pragma unroll
        for (int i = 0; i < 8; ++i) { w0[i] = wc[ch + i]; w1[i] = wc[1024 + ch + i]; w2[i] = wc[2048 + ch + i]; z1[i] = 0.f; z2[i] = 0.f; }
        for (int t = t0 - 2; t < t0 + 16; ++t) {
            if (t < 0) continue;
            const bf16* row = P + (size_t)t * NPROJ;
            const v4u cg = *(const GAS v4u*)(row + 4096 + ch), xu = *(const GAS v4u*)(row + 5120 + ch);
            float z[8];
#pragma unroll
            for (int i = 0; i < 4; ++i) { z[2 * i] = bf_lo(cg[i]) * bf_lo(xu[i]); z[2 * i + 1] = bf_hi(cg[i]) * bf_hi(xu[i]); }
            if (t >= t0) {
                const v4u bg = *(const GAS v4u*)(row + 3072 + ch); float y[8];
#pragma unroll
                for (int i = 0; i < 4; ++i) { y[2 * i] = bf_lo(bg[i]) * (w0[2 * i] * z2[2 * i] + w1[2 * i] * z1[2 * i] + w2[2 * i] * z[2 * i]);
                    y[2 * i + 1] = bf_hi(bg[i]) * (w0[2 * i + 1] * z2[2 * i + 1] + w1[2 * i + 1] * z1[2 * i + 1] + w2[2 * i + 1] * z[2 * i + 1]); }
                v4u o; o.x = pk2(y[0], y[1]); o.y = pk2(y[2], y[3]); o.z = pk2(y[4], y[5]); o.w = pk2(y[6], y[7]);
                *(GAS v4u*)(Y + (size_t)t * DM + 1024 + ch) = o;
            }
#pragma unroll
            for (int i = 0; i < 8; ++i) { z2[i] = z1[i]; z1[i] = z[i]; }
        }
    }
}

__device__ __forceinline__ void p5_post_route(Frame& F) {
    LAS float* tG = (LAS float*)(F.lds + RING_OFF); LAS float* tA = tG + 2048; LAS float* tS = tA + 2048;
    for (int i = F.tid; i < 2048; i += 512) { tG[i] = modval(F, 4096 + i) * F.in[I_GPOST1][i]; tA[i] = F.in[I_GPRE2][i] * (1.0f + modval(F, 8192 + i)); tS[i] = modval(F, 6144 + i); }
    __syncthreads();
    const int gw = F.vcu * NWAVES + F.wave, NGW = F.G * NWAVES;
    const bf16* Y1 = (const bf16*)(F.ws + WS_A); bf16* H2 = (bf16*)(F.ws + WS_A + 64 * MiB);
    const float* WrT = (const float*)(F.ws + WS_WRT);
    float* gates = (float*)(F.ws + WS_GATES); int* list = (int*)(F.ws + WS_LIST); unsigned* cnt = (unsigned*)(F.ctl + CW_CNT);
    for (int b = gw; b < SEQ / 4; b += NGW) {
        f32x4 hv[4][8];
#pragma unroll
        for (int r = 0; r < 4; ++r) {
            const int m = 4 * b + r;
            const GAS f32x4* xr = (const GAS f32x4*)(F.in[I_X] + (size_t)m * DM) + F.lane;
            const GAS v2u* yr = (const GAS v2u*)(Y1 + (size_t)m * DM) + F.lane;
            f32x4 xv[8]; v2u yp[8]; float s1 = 0.f;
#pragma unroll
            for (int j = 0; j < 8; ++j) { xv[j] = xr[64 * j]; yp[j] = yr[64 * j]; const f32x4 y = (f32x4){bf_lo(yp[j].x), bf_hi(yp[j].x), bf_lo(yp[j].y), bf_hi(yp[j].y)};
                s1 += (y.x * y.x + y.y * y.y) + (y.z * y.z + y.w * y.w); }
            const float r1 = 1.0f / sqrtf(wave_sum(s1) * (1.0f / DM) + NORM_EPS);
            GAS f32x4* orow = (GAS f32x4*)(F.out + (size_t)m * DM) + F.lane; float s2 = 0.f;
#pragma unroll
            for (int j = 0; j < 8; ++j) { const f32x4 g = *(const LAS f32x4*)(tG + 256 * j + 4 * F.lane); const f32x4 y = (f32x4){bf_lo(yp[j].x), bf_hi(yp[j].x), bf_lo(yp[j].y), bf_hi(yp[j].y)};
                xv[j] = xv[j] + y * r1 * g; orow[64 * j] = xv[j];
                s2 += (xv[j].x * xv[j].x + xv[j].y * xv[j].y) + (xv[j].z * xv[j].z + xv[j].w * xv[j].w); }
            const float r2 = 1.0f / sqrtf(wave_sum(s2) * (1.0f / DM) + NORM_EPS);
            GAS v2u* h8 = (GAS v2u*)(H2 + (size_t)m * DM) + F.lane;
#pragma unroll
            for (int j = 0; j < 8; ++j) { const f32x4 a = *(const LAS f32x4*)(tA + 256 * j + 4 * F.lane), s = *(const LAS f32x4*)(tS + 256 * j + 4 * F.lane); const f32x4 h = xv[j] * r2 * a + s; hv[r][j] = h;
                v2u w; w.x = pk2(h.x, h.y); w.y = pk2(h.z, h.w); h8[64 * j] = w; }
            __builtin_amdgcn_sched_barrier(0);
        }
        LAS float* lg = (LAS float*)(F.lds + RING_OFF + 32768 + F.wave * 1024);
#pragma unroll 1
        for (int j = 0; j < 36; ++j) {
            const GAS f32x4* wr_ = (const GAS f32x4*)(WrT + (size_t)j * DM) + F.lane;
            float a0 = 0.f, a1 = 0.f, a2 = 0.f, a3 = 0.f;
#pragma unroll
            for (int q = 0; q < 8; ++q) { const f32x4 w = wr_[64 * q];
                a0 += (hv[0][q].x * w.x + hv[0][q].y * w.y) + (hv[0][q].z * w.z + hv[0][q].w * w.w);
                a1 += (hv[1][q].x * w.x + hv[1][q].y * w.y) + (hv[1][q].z * w.z + hv[1][q].w * w.w);
                a2 += (hv[2][q].x * w.x + hv[2][q].y * w.y) + (hv[2][q].z * w.z + hv[2][q].w * w.w);
                a3 += (hv[3][q].x * w.x + hv[3][q].y * w.y) + (hv[3][q].z * w.z + hv[3][q].w * w.w); }
            a0 = wave_sum(a0); a1 = wave_sum(a1); a2 = wave_sum(a2); a3 = wave_sum(a3);
            if (F.lane == 0) { lg[j] = a0; lg[36 + j] = a1; lg[72 + j] = a2; lg[108 + j] = a3; }
        }
        LDS_WAIT();
        if (F.lane < 4) {
            const int m = 4 * b + F.lane;
            const LAS float* mine = lg + 36 * F.lane;
            float gl[4]; int gi = 0; float gm;
#pragma unroll
            for (int g = 0; g < 4; ++g) gl[g] = mine[g] + F.in[I_BRG][g];
            gm = gl[0];
#pragma unroll
            for (int g = 1; g < 4; ++g) if (gl[g] > gm) { gm = gl[g]; gi = g; }
            float gs = 0.f;
#pragma unroll
            for (int g = 0; g < 4; ++g) gs += __expf(gl[g] - gm);
            const float gwt = 1.0f / gs;
            float el[8];
#pragma unroll
            for (int e = 0; e < 8; ++e) el[e] = mine[4 + gi * 8 + e] + F.in[I_BRE][gi * 8 + e];
            int i1 = 0; float l1 = el[0];
#pragma unroll
            for (int e = 1; e < 8; ++e) if (el[e] > l1) { l1 = el[e]; i1 = e; }
            int i2 = -1; float l2 = -INFINITY;
#pragma unroll
            for (int e = 0; e < 8; ++e) if (e != i1 && el[e] > l2) { l2 = el[e]; i2 = e; }
            const float w1 = 1.0f / (1.0f + __expf(l2 - l1)), w2 = 1.0f - w1;
            const int e1 = gi * 8 + i1, e2 = gi * 8 + i2;
            const unsigned p1 = atomicAdd(cnt + e1, 1u), p2 = atomicAdd(cnt + e2, 1u);
            list[e1 * CAP + (int)p1] = 2 * m; list[e2 * CAP + (int)p2] = 2 * m + 1;
            gates[2 * m] = gwt * w1; gates[2 * m + 1] = gwt * w2;
        }
    }
    __syncthreads();
}

__device__ __forceinline__ void p8_final(Frame& F) {
    LAS float* tG = (LAS float*)(F.lds + RING_OFF);
    for (int i = F.tid; i < 2048; i += 512) tG[i] = modval(F, 10240 + i) * F.in[I_GPOST2][i];
    __syncthreads();
    const int gw = F.vcu * NWAVES + F.wave, NGW = F.G * NWAVES;
    const bf16* Y2 = (const bf16*)(F.ws + WS_A);
    for (int m = gw; m < SEQ; m += NGW) {
        GAS f32x4* xr = (GAS f32x4*)(F.out + (size_t)m * DM) + F.lane;
        const GAS v2u* ya = (const GAS v2u*)(Y2 + (size_t)(2 * m) * DM) + F.lane; const GAS v2u* yb = (const GAS v2u*)(Y2 + (size_t)(2 * m + 1) * DM) + F.lane;
        f32x4 xv[8], yv[8]; float s = 0.f;
#pragma unroll
        for (int j = 0; j < 8; ++j) { xv[j] = xr[64 * j]; const v2u a = ya[64 * j], b = yb[64 * j];
            yv[j] = (f32x4){bf_lo(a.x) + bf_lo(b.x), bf_hi(a.x) + bf_hi(b.x), bf_lo(a.y) + bf_lo(b.y), bf_hi(a.y) + bf_hi(b.y)};
            s += (yv[j].x * yv[j].x + yv[j].y * yv[j].y) + (yv[j].z * yv[j].z + yv[j].w * yv[j].w); }
        const float rstd = 1.0f / sqrtf(wave_sum(s) * (1.0f / DM) + NORM_EPS);
#pragma unroll
        for (int j = 0; j < 8; ++j) { const f32x4 g = *(const LAS f32x4*)(tG + 256 * j + 4 * F.lane); xr[64 * j] = xv[j] + yv[j] * rstd * g; }
    }
}

template <int NPN, bool TOKEN_ROWS>
struct MoeOrder {
    static constexpr bool GATHER = true;
    const LAS int* pre; const LAS int* cntl; const int* list; int G, c;
    __device__ __forceinline__ bool next(int i, pg8::Unit& u) const {
        const int L = i * G + c; const int total = __builtin_amdgcn_readfirstlane(pre[32]);
        if (L >= total * NPN) return false;
        const int rt = L / NPN, pnl = L % NPN;
        int e = 0;
#pragma unroll 1
        for (int k = 1; k < 32; ++k) if (pre[k] <= rt) e = k;
        e = __builtin_amdgcn_readfirstlane(e);
        u.pm = rt; u.e = e; u.row0 = __builtin_amdgcn_readfirstlane((rt - pre[e]) * 256); const int left = __builtin_amdgcn_readfirstlane(cntl[e]) - u.row0; u.nvalid = left < 256 ? left : 256; u.pn = e * NPN + pnl;
        return true;
    }
    __device__ __forceinline__ void rows(const pg8::Unit& u, const int (&RA)[2], const int (&CA)[2], int K, unsigned (&v)[2][2]) const {
#pragma unroll
        for (int h = 0; h < 2; ++h)
#pragma unroll
            for (int i = 0; i < 2; ++i) { const int r = h * 128 + RA[i]; const int ts = list[u.e * CAP + u.row0 + (r < u.nvalid ? r : 0)];
                const int srow = TOKEN_ROWS ? (ts >> 1) : ts; v[h][i] = (unsigned)((srow * K + CA[i]) * 2); }
    }
};
struct EpiSwiglu {
    static constexpr bool PERM = true;
    bf16* act; const int* list; const float* gates;
    __device__ __forceinline__ void operator()(const pg8::f32x4 (&acc)[2][2][4][2], const pg8::Unit& u, int wr, int wc, int fr, int fq) const {
        const int pnl = u.pn & 3; const int col0 = pnl * 128 + wc * 32 + 8 * fq;
#pragma unroll
        for (int ai = 0; ai < 2; ++ai)
#pragma unroll
            for (int m = 0; m < 4; ++m) { const int r = ai * 128 + wr * 64 + m * 16 + fr;
                if (r < u.nvalid) { const int ts = list[u.e * CAP + u.row0 + r]; const float gt = gates[ts];
                    float o[8];
#pragma unroll
                    for (int n = 0; n < 2; ++n)
#pragma unroll
                        for (int i = 0; i < 4; ++i) { const float g = acc[ai][0][m][n][i], up = acc[ai][1][m][n][i]; o[4 * n + i] = g / (1.0f + __expf(-g)) * up * gt; }
                    pg8::u32x4 w; w.x = pg8::cvt_pk_bf16(o[0], o[1]); w.y = pg8::cvt_pk_bf16(o[2], o[3]); w.z = pg8::cvt_pk_bf16(o[4], o[5]); w.w = pg8::cvt_pk_bf16(o[6], o[7]);
                    *(pg8::u32x4*)(act + (size_t)ts * DEXP + col0) = w; } }
    }
};
struct EpiDown {
    static constexpr bool PERM = true;
    bf16* y2; const int* list;
    __device__ __forceinline__ void operator()(const pg8::f32x4 (&acc)[2][2][4][2], const pg8::Unit& u, int wr, int wc, int fr, int fq) const {
        const int pnl = u.pn & 7; const int col0 = pnl * 256 + wc * 32 + 8 * fq;
#pragma unroll
        for (int ai = 0; ai < 2; ++ai)
#pragma unroll
            for (int m = 0; m < 4; ++m) { const int r = ai * 128 + wr * 64 + m * 16 + fr;
                if (r < u.nvalid) { const int ts = list[u.e * CAP + u.row0 + r]; bf16* rowp = y2 + (size_t)ts * DM + col0;
#pragma unroll
                    for (int bj = 0; bj < 2; ++bj) { const pg8::f32x4 v0 = acc[ai][bj][m][0], v1 = acc[ai][bj][m][1];
                        pg8::u32x4 w; w.x = pg8::cvt_pk_bf16(v0[0], v0[1]); w.y = pg8::cvt_pk_bf16(v0[2], v0[3]); w.z = pg8::cvt_pk_bf16(v1[0], v1[1]); w.w = pg8::cvt_pk_bf16(v1[2], v1[3]);
                        *(pg8::u32x4*)(rowp + bj * 128) = w; } } }
    }
};
__device__ __forceinline__ void moe_tables(Frame& F) {
    LAS int* pre = (LAS int*)(F.lds + LT_PRE); LAS int* cl = (LAS int*)(F.lds + LT_CNT);
    if (F.tid == 0) { int s = 0; const unsigned* cnt = (const unsigned*)(F.ctl + CW_CNT);
        for (int e = 0; e < 32; ++e) { int c = (int)cnt[e]; c = c < 0 ? 0 : (c > CAP ? CAP : c); cl[e] = c; pre[e] = s; s += (c + 255) >> 8; } pre[32] = s; }
    __syncthreads();
}

struct Args { const float* in[23]; float* out; unsigned char* ws; int ph_lo, ph_hi; };
__global__ void __launch_bounds__(NWAVES * 64, 2) mk_fwd(Args args) {
    extern __shared__ __attribute__((aligned(16))) unsigned char lds[];
    Frame F;
    F.lds = (LAS unsigned char*)lds;
    F.tid = threadIdx.x; F.lane = F.tid & 63; F.wave = __builtin_amdgcn_readfirstlane(F.tid >> 6);
    F.G = gridDim.x; { const int bx = blockIdx.x; F.vcu = (F.G % 8 == 0) ? (bx % 8) * (F.G / 8) + bx / 8 : bx; }
    F.ws = args.ws; F.ctl = (gu32*)(args.ws + WS_CTL); F.out = args.out;
#pragma unroll
    for (int i = 0; i < 23; ++i) F.in[i] = args.in[i];
    for (int u = F.tid; u < (LDS_BYTES - LDSCTL_OFF) / 4; u += NWAVES * 64) ((LAS unsigned*)(F.lds + LDSCTL_OFF))[u] = 0u;
    __syncthreads();
    XcdBarrier bar; bar.bar = (unsigned*)(F.ctl + CW_BAR); bar.x = 0; bar.st = nullptr;
    if (N_LAUNCHES == 1) bar = xcd_barrier_post((unsigned*)(F.ctl + CW_BAR), (volatile LAS unsigned*)(F.lds + LDSCTL_OFF));
    const int lo = args.ph_lo, hi = args.ph_hi;
#define IN(k) (lo <= (k) && (k) < hi)
#define SEAM(k) do { if (IN(k) && IN((k) + 1)) xcd_barrier(bar); } while (0)

    if (IN(0)) { p0_prologue(F); } SEAM(0);
    if (IN(1)) { p1_norm(F); } SEAM(1);
    if (IN(2)) {
        pg8::Gemm g{(const pg8::bf16_t*)(F.ws + WS_B), (const pg8::bf16_t*)(F.ws + WS_WIN), SEQ, NPROJ, DM}; pg8::StaticOrder S; S.init(SEQ, NPROJ, F.G, (int)blockIdx.x);
        pg8::EpiBf16 E{(pg8::bf16_t*)(F.ws + WS_A), NPROJ, 1024, att::QSCALE};
        pg8::gemm_phase<pg8::EpiBf16, pg8::StaticOrder, true>(F.lds + RING_OFF, g, S, E);
    } SEAM(2);
    if (IN(3)) {
        p3_conv(F);
        float lam;
        { const float a = wave_sum(F.in[I_LQ1][F.lane] * F.in[I_LK1][F.lane]), b = wave_sum(F.in[I_LQ2][F.lane] * F.in[I_LK2][F.lane]); lam = __expf(a) - __expf(b) + 0.2f; }
        const att::Tensors T{(const __hip_bfloat16*)(F.ws + WS_A), (__hip_bfloat16*)(F.ws + WS_B), F.in[I_GSUB], lam};
        for (int p = F.vcu; p < 512; p += F.G) { const int h = p >> 6, pp = p & 63;
            att::attn_unit(h, 127 - pp, T, (att::lds_ptr)(F.lds + RING_OFF)); att::attn_unit(h, pp, T, (att::lds_ptr)(F.lds + RING_OFF)); }
    } SEAM(3);
    if (IN(4)) {
        pg8::Gemm g{(const pg8::bf16_t*)(F.ws + WS_B), (const pg8::bf16_t*)(F.ws + WS_WOUT), SEQ, DM, DM}; pg8::StaticOrder S; S.init(SEQ, DM, F.G, (int)blockIdx.x);
        pg8::EpiBf16 E{(pg8::bf16_t*)(F.ws + WS_A), DM, 0, 1.0f};
        pg8::gemm_phase<pg8::EpiBf16, pg8::StaticOrder, true>(F.lds + RING_OFF, g, S, E);
    } SEAM(4);
    if (IN(5)) { p5_post_route(F); } SEAM(5);
    if (IN(6)) {
        moe_tables(F);
        pg8::Gemm g{(const pg8::bf16_t*)(F.ws + WS_A + 64 * MiB), (const pg8::bf16_t*)(F.ws + WS_W1), SEQ, 1024, DM};
        MoeOrder<4, true> S{(const LAS int*)(F.lds + LT_PRE), (const LAS int*)(F.lds + LT_CNT), (const int*)(F.ws + WS_LIST), F.G, F.vcu};
        EpiSwiglu E{(bf16*)(F.ws + WS_A + 128 * MiB), (const int*)(F.ws + WS_LIST), (const float*)(F.ws + WS_GATES)};
        pg8::gemm_phase<EpiSwiglu, MoeOrder<4, true>, true>(F.lds + RING_OFF, g, S, E);
    } SEAM(6);
    if (IN(7)) {
        moe_tables(F);
        pg8::Gemm g{(const pg8::bf16_t*)(F.ws + WS_A + 128 * MiB), (const pg8::bf16_t*)(F.ws + WS_W2), 2 * SEQ, DM, DEXP};
        MoeOrder<8, false> S{(const LAS int*)(F.lds + LT_PRE), (const LAS int*)(F.lds + LT_CNT), (const int*)(F.ws + WS_LIST), F.G, F.vcu};
        EpiDown E{(bf16*)(F.ws + WS_A), (const int*)(F.ws + WS_LIST)};
        pg8::gemm_phase<EpiDown, MoeOrder<8, false>, true>(F.lds + RING_OFF, g, S, E);
    } SEAM(7);
    if (IN(8)) { p8_final(F); }
#undef IN
#undef SEAM
}

extern "C" void kernel_launch(void* const* d_in, const int* in_sizes, int n_in, void* d_out, int out_size, void* d_ws, size_t ws_size, hipStream_t stream) {
    static int grid = 0;
    if (grid == 0) {
        if (n_in != 23 || in_sizes[0] != SEQ * DM || out_size != SEQ * DM || ws_size < WS_END) { fprintf(stderr, "kernel_launch: shape/workspace mismatch (n_in %d, in0 %d, out %d, ws %zu < %zu); nothing launched\n", n_in, n_in > 0 ? in_sizes[0] : -1, out_size, ws_size, (size_t)WS_END); grid = -1; return; }
        int dev = 0, cus = 0, per_cu = 0;
        if (hipGetDevice(&dev) != hipSuccess || hipDeviceGetAttribute(&cus, hipDeviceAttributeMultiprocessorCount, dev) != hipSuccess) { fprintf(stderr, "kernel_launch: hipGetDevice / hipDeviceGetAttribute failed\n"); grid = -1; return; }
        if (hipFuncSetAttribute((const void*)mk_fwd, hipFuncAttributeMaxDynamicSharedMemorySize, LDS_BYTES) != hipSuccess) { fprintf(stderr, "kernel_launch: hipFuncSetAttribute failed\n"); grid = -1; return; }
        if (hipOccupancyMaxActiveBlocksPerMultiprocessor(&per_cu, (const void*)mk_fwd, NWAVES * 64, LDS_BYTES) != hipSuccess || per_cu < 1) { fprintf(stderr, "kernel_launch: occupancy query reports %d workgroups per CU\n", per_cu); }
        (void)hipGetLastError();
        grid = cus;
    }
    if (grid < 0) return;
    if (hipMemsetAsync((char*)d_ws + WS_CTL, 0, CTL_ZERO_BYTES, stream) != hipSuccess) { fprintf(stderr, "kernel_launch: hipMemsetAsync failed\n"); return; }
    Args a{};
    for (int i = 0; i < 23; ++i) a.in[i] = (const float*)d_in[i];
    a.out = (float*)d_out; a.ws = (unsigned char*)d_ws;
    for (int li = 0; li < N_LAUNCHES; ++li) {
        a.ph_lo = (N_LAUNCHES == 1) ? 0 : li; a.ph_hi = (N_LAUNCHES == 1) ? N_PHASES : li + 1;
        hipLaunchKernelGGL(mk_fwd, dim3(grid), dim3(NWAVES * 64), LDS_BYTES, stream, a);
        const hipError_t le = hipPeekAtLastError();
        if (le != hipSuccess) { fprintf(stderr, "kernel_launch: launch %d failed: %s\n", li, hipGetErrorName(le)); break; }
    }
}
```

```cpp
#include <hip/hip_runtime.h>
#include <hip/hip_bf16.h>
#include <cstdio>
#include <cstdint>
#include <cmath>

namespace pg8 {
#define PG8_LAS __attribute__((address_space(3)))
typedef unsigned short bf16_t;
typedef short bf16x8 __attribute__((ext_vector_type(8)));
typedef float f32x4 __attribute__((ext_vector_type(4)));
typedef unsigned u32x4 __attribute__((ext_vector_type(4)));
constexpr int BM = 256, BK = 64, HALF = 128, HTB = HALF * BK * 2  , STAGE_BYTES = 8 * HTB, NXCD = 8, WGM = 8;

__host__ __device__ __forceinline__ int lds_byte(int r, int c) { const int st = (r >> 4) * 2 + (c >> 5), rr = r & 15, cc = c & 31, ob = rr * 64 + cc * 2; return st * 1024 + (ob ^ (((ob >> 9) & 1) << 5)); }
__host__ __device__ __forceinline__ void stage_rc(int b, int& R, int& C) { const int st = b / 1024, sb = b % 1024, swz = sb ^ (((sb >> 9) & 1) << 5); R = (st >> 1) * 16 + swz / 64; C = (st & 1) * 32 + (swz % 64) / 2; }
__host__ __device__ __forceinline__ int perm32(int rho) { const int n = rho >> 4, i = rho & 15; return 8 * (i >> 2) + 4 * n + (i & 3); }

struct Unit { int pm, pn; int e, row0, nvalid; };
struct Gemm { const bf16_t* A; const bf16_t* Bt; int M, N, K; };

struct StaticOrder {
    static constexpr bool GATHER = false;
    int nM, nN, nwg, G, c;
    __host__ __device__ void init(int M, int N, int G_, int c_) { nM = M / BM; nN = N / BM; nwg = nM * nN; G = G_; c = c_; }
    __device__ __forceinline__ bool next(int i, Unit& u) const {
        const long L = (long)i * G + c; if (L >= nwg) return false;
        int wgid = (int)L; { const int q = nwg / NXCD, r = nwg % NXCD, xcd = wgid % NXCD, off = wgid / NXCD; wgid = (xcd < r ? xcd * (q + 1) : r * (q + 1) + (xcd - r) * q) + off; }
        const int nig = WGM * nN, gid = wgid / nig, fm = gid * WGM, gsz = (nM - fm) < WGM ? (nM - fm) : WGM;
        u.pm = fm + ((wgid % nig) % gsz); u.pn = (wgid % nig) / gsz; u.e = 0; u.row0 = 0; u.nvalid = 256; return true;
    }
    __device__ __forceinline__ void rows(const Unit& u, const int (&RA)[2], const int (&CA)[2], int K, unsigned (&v)[2][2]) const {
#pragma unroll
        for (int h = 0; h < 2; ++h)
#pragma unroll
            for (int i = 0; i < 2; ++i) v[h][i] = (unsigned)(((u.pm * BM + h * HALF + RA[i]) * K + CA[i]) * 2);
    }
};

__device__ __forceinline__ unsigned cvt_pk_bf16(float lo, float hi) { unsigned r; asm volatile("v_cvt_pk_bf16_f32 %0, %1, %2" : "=v"(r) : "v"(lo), "v"(hi)); return r; }

struct EpiBf16 {
    static constexpr bool PERM = true;
    bf16_t* O; int ldc; int scale_cols; float scale0;
    unsigned* nmax; int nmax_cols;
    __device__ __forceinline__ void operator()(const f32x4 (&acc)[2][2][4][2], const Unit& u, int wr, int wc, int fr, int fq) const {
        const int row0 = u.pm * BM + wr * 64 + fr; const int colt = u.pn * BM;
        const float sc = (colt < scale_cols) ? scale0 : 1.f;
        const int col0 = colt + wc * 32 + 8 * fq;
        const bool donorm = (nmax != nullptr) && (colt < nmax_cols);
        float nm[2] = {0.f, 0.f};
#pragma unroll
        for (int ai = 0; ai < 2; ++ai)
#pragma unroll
            for (int m = 0; m < 4; ++m) { bf16_t* rowp = O + (size_t)(row0 + ai * HALF + m * 16) * ldc + col0;
#pragma unroll
                for (int bj = 0; bj < 2; ++bj) { f32x4 v0 = acc[ai][bj][m][0] * sc, v1 = acc[ai][bj][m][1] * sc;
                    u32x4 w; w.x = cvt_pk_bf16(v0[0], v0[1]); w.y = cvt_pk_bf16(v0[2], v0[3]); w.z = cvt_pk_bf16(v1[0], v1[1]); w.w = cvt_pk_bf16(v1[2], v1[3]);
                    *(u32x4*)(rowp + bj * HALF) = w;
                    if (donorm) { float ss = (v0[0] * v0[0] + v0[1] * v0[1]) + (v0[2] * v0[2] + v0[3] * v0[3]) + (v1[0] * v1[0] + v1[1] * v1[1]) + (v1[2] * v1[2] + v1[3] * v1[3]);
                        ss += __shfl_xor(ss, 16); ss += __shfl_xor(ss, 32); nm[bj] = fmaxf(nm[bj], ss); } } }
        if (donorm) {
#pragma unroll
            for (int bj = 0; bj < 2; ++bj) { float v = nm[bj];
#pragma unroll
                for (int o = 1; o < 16; o <<= 1) v = fmaxf(v, __shfl_xor(v, o));
                if ((threadIdx.x & 63) == 0) atomicMax(nmax + (colt >> 5) + 4 * bj + wc, __float_as_uint(v)); }
        }
    }
};

template <class Epi, class Sched, bool ALIGN_EPI = false>
__device__ __forceinline__ void gemm_phase(PG8_LAS unsigned char* lds, const Gemm g, const Sched& S, const Epi& E) {
    const int tid = threadIdx.x, wid = __builtin_amdgcn_readfirstlane(tid >> 6), lane = tid & 63, wr = wid >> 2, wc = wid & 3, fr = lane & 15, fq = lane >> 4;
    const int K = g.K, nt = K / BK;
    int RA[2], CA[2]; unsigned voffB[2];
#pragma unroll
    for (int i = 0; i < 2; ++i) { int R, C; stage_rc(tid * 16 + i * 8192, R, C); const int Rb = Epi::PERM ? ((R & ~31) + perm32(R & 31)) : R;
        RA[i] = R; CA[i] = C; voffB[i] = (unsigned)(Rb * K + C) * 2u; }
    const size_t kstep = (size_t)(BK * 2);
    const size_t hstep = (size_t)HALF * K * 2;
    const size_t tstep = 2 * hstep;
    const unsigned ldsw = (unsigned)wid * 1024u;
    const int aoff = lds_byte(wr * 64 + fr, fq * 8), boff = lds_byte(wc * 32 + fr, fq * 8);
    const char* const Abase = (const char*)g.A;
#define PG8_SA(b, h) (((b) * 2 + (h)) * HTB)
#define PG8_SB(b, h) ((4 + (b) * 2 + (h)) * HTB)
#define PG8_STAGE(bufoff, gbase, voff) do { _Pragma("unroll") for (int _i = 0; _i < 2; ++_i) \
        __builtin_amdgcn_global_load_lds((const unsigned*)((const char*)(gbase) + (voff)[_i]), (PG8_LAS unsigned*)(lds + (bufoff) + ldsw + _i * 8192), 16, 0, 0); } while (0)
#define PG8_STAGE_A(bufoff, v0, v1, kb) do { \
        __builtin_amdgcn_global_load_lds((const unsigned*)(Abase + (size_t)((v0) + (kb))), (PG8_LAS unsigned*)(lds + (bufoff) + ldsw), 16, 0, 0); \
        __builtin_amdgcn_global_load_lds((const unsigned*)(Abase + (size_t)((v1) + (kb))), (PG8_LAS unsigned*)(lds + (bufoff) + ldsw + 8192), 16, 0, 0); } while (0)
#define PG8_LDA(dst, b, h) do { _Pragma("unroll") for (int m = 0; m < 4; ++m) _Pragma("unroll") for (int k = 0; k < 2; ++k) dst[m][k] = *(const PG8_LAS bf16x8*)(lds + PG8_SA(b, h) + aoff + m * 2048 + k * 1024); } while (0)
#define PG8_LDB(dst, b, h) do { _Pragma("unroll") for (int n = 0; n < 2; ++n) _Pragma("unroll") for (int k = 0; k < 2; ++k) dst[n][k] = *(const PG8_LAS bf16x8*)(lds + PG8_SB(b, h) + boff + n * 2048 + k * 1024); } while (0)
#define PG8_MMA(ai, bj, At, Bt) do { __builtin_amdgcn_s_setprio(1); _Pragma("unroll") for (int m = 0; m < 4; ++m) _Pragma("unroll") for (int n = 0; n < 2; ++n) _Pragma("unroll") for (int k = 0; k < 2; ++k) \
        acc[ai][bj][m][n] = __builtin_amdgcn_mfma_f32_16x16x32_bf16(Bt[n][k], At[m][k], acc[ai][bj][m][n], 0, 0, 0); __builtin_amdgcn_s_setprio(0); } while (0)
#define PG8_WAIT_V(n) asm volatile("s_waitcnt vmcnt(" #n ")" ::: "memory")
#define PG8_WAIT_L(n) asm volatile("s_waitcnt lgkmcnt(" #n ")" ::: "memory")
#define PG8_BAR __builtin_amdgcn_s_barrier()
#define PG8_SCHED __builtin_amdgcn_sched_barrier(0)
    Unit cur, nxt; int ui = 0;
    if (!S.next(0, cur)) return;
    f32x4 acc[2][2][4][2];
#pragma unroll
    for (int a = 0; a < 2; ++a)
#pragma unroll
        for (int b = 0; b < 2; ++b)
#pragma unroll
            for (int m = 0; m < 4; ++m)
#pragma unroll
                for (int n = 0; n < 2; ++n) acc[a][b][m][n] = (f32x4){0.f, 0.f, 0.f, 0.f};
    bf16x8 At[4][2], B0[2][2], B1[2][2];
    unsigned vAc[2][2], vAn[2][2];
    S.rows(cur, RA, CA, K, vAc);
    const char* cB = (const char*)g.Bt + (size_t)cur.pn * tstep;
    PG8_STAGE(PG8_SB(0, 0), cB, voffB); PG8_STAGE(PG8_SB(0, 1), cB + hstep, voffB); PG8_STAGE_A(PG8_SA(0, 0), vAc[0][0], vAc[0][1], 0u); PG8_STAGE_A(PG8_SA(0, 1), vAc[1][0], vAc[1][1], 0u);
    if (wr == 1) PG8_BAR;
    PG8_WAIT_V(2); PG8_BAR;
    PG8_STAGE(PG8_SB(1, 0), cB + kstep, voffB); PG8_STAGE_A(PG8_SA(1, 0), vAc[0][0], vAc[0][1], (unsigned)kstep); PG8_STAGE(PG8_SB(1, 1), cB + hstep + kstep, voffB);
    PG8_WAIT_V(6); PG8_BAR;
    for (;;) {
        const bool has_next = S.next(ui + 1, nxt);
        if (has_next) S.rows(nxt, RA, CA, K, vAn);
        else { vAn[0][0] = vAc[0][0]; vAn[0][1] = vAc[0][1]; vAn[1][0] = vAc[1][0]; vAn[1][1] = vAc[1][1]; }
        const char* nB = has_next ? (const char*)g.Bt + (size_t)nxt.pn * tstep : cB;
        for (int t = 0; t < nt; t += 2) {
            const bool last = (t == nt - 2);
            const unsigned kb1 = (unsigned)(t + 1) * (unsigned)kstep;
            const unsigned kb2 = last ? 0u : (unsigned)(t + 2) * (unsigned)kstep, kb3 = kb2 + (unsigned)kstep;
            const unsigned x00 = last ? vAn[0][0] : vAc[0][0], x01 = last ? vAn[0][1] : vAc[0][1], x10 = last ? vAn[1][0] : vAc[1][0], x11 = last ? vAn[1][1] : vAc[1][1];
            const char* b2 = last ? nB : cB + (size_t)(t + 2) * kstep; const char* b3 = b2 + kstep;
            PG8_LDB(B0, 0, 0); PG8_LDB(B1, 0, 1); PG8_SCHED; PG8_LDA(At, 0, 0); PG8_STAGE_A(PG8_SA(1, 1), vAc[1][0], vAc[1][1], kb1);
            PG8_WAIT_V(8); PG8_WAIT_L(0); PG8_BAR; PG8_MMA(0, 0, At, B0); PG8_MMA(0, 1, At, B1); PG8_BAR; PG8_SCHED;
            PG8_LDA(At, 0, 1); PG8_STAGE(PG8_SB(0, 0), b2, voffB); PG8_STAGE(PG8_SB(0, 1), b2 + hstep, voffB); PG8_STAGE_A(PG8_SA(0, 0), x00, x01, kb2);
            PG8_WAIT_V(8); PG8_WAIT_L(0); PG8_BAR; PG8_MMA(1, 0, At, B0); PG8_MMA(1, 1, At, B1); PG8_BAR; PG8_SCHED;
            PG8_LDB(B0, 1, 0); PG8_LDB(B1, 1, 1); PG8_SCHED; PG8_LDA(At, 1, 0); PG8_STAGE_A(PG8_SA(0, 1), x10, x11, kb2);
            PG8_WAIT_V(8); PG8_WAIT_L(0); PG8_BAR; PG8_MMA(0, 0, At, B0); PG8_MMA(0, 1, At, B1); PG8_BAR; PG8_SCHED;
            PG8_LDA(At, 1, 1); PG8_STAGE(PG8_SB(1, 0), b3, voffB); PG8_STAGE(PG8_SB(1, 1), b3 + hstep, voffB); PG8_STAGE_A(PG8_SA(1, 0), x00, x01, kb3);
            PG8_WAIT_V(8); PG8_WAIT_L(0); PG8_BAR; PG8_MMA(1, 0, At, B0); PG8_MMA(1, 1, At, B1); PG8_BAR; PG8_SCHED;
        }
        if constexpr (ALIGN_EPI) { if (wr == 0) PG8_BAR; }
        E(acc, cur, wr, wc, fr, fq);
        if (!has_next) break;
#pragma unroll
        for (int a = 0; a < 2; ++a)
#pragma unroll
            for (int b = 0; b < 2; ++b)
#pragma unroll
                for (int m = 0; m < 4; ++m)
#pragma unroll
                    for (int n = 0; n < 2; ++n) acc[a][b][m][n] = (f32x4){0.f, 0.f, 0.f, 0.f};
        cur = nxt; cB = nB; ++ui;
        vAc[0][0] = vAn[0][0]; vAc[0][1] = vAn[0][1]; vAc[1][0] = vAn[1][0]; vAc[1][1] = vAn[1][1];
        if constexpr (ALIGN_EPI) { if (wr == 1) PG8_BAR; }
    }
    PG8_WAIT_V(0);
    if constexpr (!ALIGN_EPI) { if (wr == 0) PG8_BAR; }
    PG8_BAR;
#undef PG8_SA
#undef PG8_SB
#undef PG8_STAGE
#undef PG8_STAGE_A
#undef PG8_LDA
#undef PG8_LDB
#undef PG8_MMA
#undef PG8_WAIT_V
#undef PG8_WAIT_L
#undef PG8_BAR
#undef PG8_SCHED
}
}

namespace att {
typedef __attribute__((address_space(3))) const char* lds_cptr;
typedef __attribute__((address_space(3))) char* lds_ptr;
using bf16x8 = __attribute__((ext_vector_type(8))) short;
using s16x4 = __attribute__((ext_vector_type(4))) short;
using f32x16 = __attribute__((ext_vector_type(16))) float;
using f32x4 = __attribute__((ext_vector_type(4))) float;
using u32x4 = __attribute__((ext_vector_type(4))) unsigned;
typedef short v4i16_t __attribute__((ext_vector_type(4)));
typedef float f32x2_t __attribute__((ext_vector_type(2))); typedef __bf16 bf16x2_t __attribute__((ext_vector_type(2)));
constexpr int PITCH = 6144;
constexpr int COL_Q = 0, COL_K = 1024, COL_V = 2048;
constexpr int SLOT = 16384;
constexpr int L_K = 0, L_V = 2 * SLOT, L_X = 0, XSTRIDE = 17408, L_WS = 4 * XSTRIDE, LDS_BYTES = L_WS + 8 * 256;
constexpr float LOG2E = 1.4426950408889634f;
constexpr float QSCALE = 0.125f * LOG2E;
constexpr float THR = 6.0f;

__device__ __forceinline__ int crow(int r, int hi) { return (r & 3) + 8 * (r >> 2) + 4 * hi; }
__device__ __forceinline__ void glds16(const void* gsrc, unsigned lds_dst) { unsigned keep;
    asm volatile("s_mov_b32 %0, m0\n\ts_mov_b32 m0, %2\n\ts_nop 0\n\tglobal_load_lds_dwordx4 %1, off\n\ts_mov_b32 m0, %0" : "=&s"(keep) : "v"(gsrc), "s"(lds_dst) : "memory"); }
__device__ __forceinline__ unsigned cvtpk_s(float lo, float hi) { f32x2_t v = {lo, hi}; bf16x2_t b = __builtin_convertvector(v, bf16x2_t); return __builtin_bit_cast(unsigned, b); }
__device__ __forceinline__ s16x4 vtr(lds_cptr p) { return __builtin_bit_cast(s16x4, __builtin_amdgcn_ds_read_tr16_b64_v4i16((__attribute__((address_space(3))) v4i16_t*)p)); }

struct Tensors { const __hip_bfloat16* proj; __hip_bfloat16* ycat; const float* g_subln; float lam; };

__device__ __forceinline__ float xhalf(float v) { return __shfl_xor(v, 32); }

__device__ __forceinline__ void attn_unit(int h, int qb, int t_lo, const Tensors& T, lds_ptr shm) {
    typedef __hip_bfloat16 bf16;
    const int tid = threadIdx.x, lane = tid & 63, r32 = lane & 31, hi = lane >> 5; const int wid = __builtin_amdgcn_readfirstlane(tid >> 6);
    const int rb = wid & 3, mp = wid >> 2;
    const int q0 = qb * 128 + rb * 32;
    const int cw = q0 >> 6;
    const int NT = 2 * qb + 2;
    const bf16* Qw = T.proj + (size_t)q0 * PITCH + COL_Q + h * 128 + mp * 64;
    const bf16* Kh = T.proj + COL_K + h * 128; const bf16* Vh = T.proj + COL_V + h * 128;
    const unsigned lds0 = (unsigned)(uintptr_t)shm;
    lds_ptr wsf_b = shm + L_WS + wid * 256; __attribute__((address_space(3))) float* wsf = (__attribute__((address_space(3))) float*)wsf_b;
    const bf16* ksrc0 = Kh + (size_t)lane * PITCH + wid * 8;
    const bf16* ksrc1 = ksrc0 + 64;
    const bf16* vsrc0 = Vh + (size_t)(16 * (wid & 3) + (lane >> 2)) * PITCH + (wid >> 2) * 32 + (lane & 3) * 8;
    const bf16* vsrc1 = vsrc0 + 64;
    const unsigned kdst = lds0 + L_K + wid * 1024, vdst = lds0 + L_V + wid * 1024;
#define ATT_DMA(t, slot) do { const size_t toff_ = (size_t)(t) * 64 * PITCH; const unsigned so_ = (unsigned)(slot) * SLOT; \
        glds16(ksrc0 + toff_, (unsigned)__builtin_amdgcn_readfirstlane(kdst + so_)); glds16(ksrc1 + toff_, (unsigned)__builtin_amdgcn_readfirstlane(kdst + so_ + 8192)); \
        glds16(vsrc0 + toff_, (unsigned)__builtin_amdgcn_readfirstlane(vdst + so_)); glds16(vsrc1 + toff_, (unsigned)__builtin_amdgcn_readfirstlane(vdst + so_ + 8192)); } while (0)
    const int n_t = NT - t_lo;
    ATT_DMA(NT - 1, 0);
    bf16x8 qr[4];
#pragma unroll
    for (int d0 = 0; d0 < 4; ++d0) qr[d0] = *reinterpret_cast<const bf16x8*>(&Qw[(size_t)r32 * PITCH + d0 * 16 + hi * 8]);
    const float slope2 = exp2f(-(float)(h + 1)) * LOG2E;
    float mhat = 0.f, l_reg = 0.f; f32x16 o[4];
#pragma unroll
    for (int d = 0; d < 4; ++d) o[d] = f32x16{};
    const lds_cptr kp0 = (lds_cptr)shm + L_K + (mp * 8 + hi) * 1024 + r32 * 16;
    const lds_cptr vp0 = (lds_cptr)shm + L_V + ((lane >> 4) & 1) * 32 + (lane & 3) * 8 + (4 * hi + ((lane & 15) >> 2)) * 64;
    const int qpos = q0 + r32;
    for (int j = 0; j < n_t; ++j) {
        const int t = NT - 1 - j, slot = j & 1;
        if (j + 1 < n_t) { ATT_DMA(t - 1, slot ^ 1); asm volatile("s_waitcnt vmcnt(4)" ::: "memory"); }
        else { asm volatile("s_waitcnt vmcnt(0)" ::: "memory"); }
        __builtin_amdgcn_s_barrier(); asm volatile("" ::: "memory");
        if (t <= cw) {
            const lds_cptr kp = kp0 + slot * SLOT;
            f32x16 p0, p1;
            { const float dq = (float)(qpos - t * 64 - 4 * hi);
#pragma unroll
              for (int r = 0; r < 16; ++r) { const float d0_ = dq - (float)((r & 3) + 8 * (r >> 2)); p0[r] = -slope2 * fabsf(d0_) - mhat; p1[r] = -slope2 * fabsf(d0_ - 32.f) - mhat; } }
#pragma unroll
            for (int d0 = 0; d0 < 4; ++d0) {
                const bf16x8 b0 = *(const __attribute__((address_space(3))) bf16x8*)(kp + d0 * 2048);
                const bf16x8 b1 = *(const __attribute__((address_space(3))) bf16x8*)(kp + d0 * 2048 + 512);
                p0 = __builtin_amdgcn_mfma_f32_32x32x16_bf16(b0, qr[d0], p0, 0, 0, 0);
                p1 = __builtin_amdgcn_mfma_f32_32x32x16_bf16(b1, qr[d0], p1, 0, 0, 0);
            }
            float rm = fmaxf(p0[0], p1[0]);
#pragma unroll
            for (int r = 1; r < 16; ++r) rm = fmaxf(rm, fmaxf(p0[r], p1[r]));
            rm = fmaxf(rm, xhalf(rm));
            const bool first = (t == cw);
            if (first || __any(rm > THR)) {
                const float dl = first ? rm : fmaxf(rm, 0.f);
                mhat += dl;
#pragma unroll
                for (int r = 0; r < 16; ++r) { p0[r] -= dl; p1[r] -= dl; }
                if (!first) {
                    const float f = __builtin_amdgcn_exp2f(-dl); l_reg *= f;
                    if (hi == 0) wsf[r32] = f;
                    asm volatile("s_waitcnt lgkmcnt(0)" ::: "memory");
                    float fr_[16];
#pragma unroll
                    for (int r = 0; r < 16; ++r) fr_[r] = wsf[crow(r, hi)];
#pragma unroll
                    for (int d = 0; d < 4; ++d)
#pragma unroll
                        for (int r = 0; r < 16; ++r) o[d][r] *= fr_[r];
                }
            }
            float sacc = 0.f;
#pragma unroll
            for (int r = 0; r < 16; ++r) { p0[r] = __builtin_amdgcn_exp2f(p0[r]); p1[r] = __builtin_amdgcn_exp2f(p1[r]); sacc += p0[r] + p1[r]; }
            l_reg += sacc;
            u32x4 pw0, pw1, pw2, pw3;
            pw0 = (u32x4){cvtpk_s(p0[0], p0[1]), cvtpk_s(p0[2], p0[3]), cvtpk_s(p0[4], p0[5]), cvtpk_s(p0[6], p0[7])};
            pw1 = (u32x4){cvtpk_s(p0[8], p0[9]), cvtpk_s(p0[10], p0[11]), cvtpk_s(p0[12], p0[13]), cvtpk_s(p0[14], p0[15])};
            pw2 = (u32x4){cvtpk_s(p1[0], p1[1]), cvtpk_s(p1[2], p1[3]), cvtpk_s(p1[4], p1[5]), cvtpk_s(p1[6], p1[7])};
            pw3 = (u32x4){cvtpk_s(p1[8], p1[9]), cvtpk_s(p1[10], p1[11]), cvtpk_s(p1[12], p1[13]), cvtpk_s(p1[14], p1[15])};
            const lds_cptr vp = vp0 + slot * SLOT;
#pragma unroll
            for (int db = 0; db < 4; ++db) {
                s16x4 lo[4], hh[4];
#pragma unroll
                for (int ks = 0; ks < 4; ++ks) { lo[ks] = vtr(vp + db * 4096 + ks * 1024); hh[ks] = vtr(vp + db * 4096 + ks * 1024 + 512); }
#define ATT_PK(k) (bf16x8){lo[k][0], lo[k][1], lo[k][2], lo[k][3], hh[k][0], hh[k][1], hh[k][2], hh[k][3]}
                o[db] = __builtin_amdgcn_mfma_f32_32x32x16_bf16(__builtin_bit_cast(bf16x8, pw0), ATT_PK(0), o[db], 0, 0, 0);
                o[db] = __builtin_amdgcn_mfma_f32_32x32x16_bf16(__builtin_bit_cast(bf16x8, pw1), ATT_PK(1), o[db], 0, 0, 0);
                o[db] = __builtin_amdgcn_mfma_f32_32x32x16_bf16(__builtin_bit_cast(bf16x8, pw2), ATT_PK(2), o[db], 0, 0, 0);
                o[db] = __builtin_amdgcn_mfma_f32_32x32x16_bf16(__builtin_bit_cast(bf16x8, pw3), ATT_PK(3), o[db], 0, 0, 0);
#undef ATT_PK
            }
        }
        asm volatile("s_waitcnt lgkmcnt(0)" ::: "memory"); __builtin_amdgcn_s_barrier(); asm volatile("" ::: "memory");
    }
#undef ATT_DMA
    l_reg += xhalf(l_reg);
    if (hi == 0) wsf[32 + r32] = l_reg;
    asm volatile("s_waitcnt lgkmcnt(0)" ::: "memory");
    float rli[16];
#pragma unroll
    for (int r = 0; r < 16; ++r) rli[r] = 1.0f / wsf[32 + crow(r, hi)];
    __attribute__((address_space(3))) float* X = (__attribute__((address_space(3))) float*)(shm + L_X + rb * XSTRIDE);
    if (mp == 1) {
#pragma unroll
        for (int d = 0; d < 4; ++d)
#pragma unroll
            for (int r = 0; r < 16; ++r) X[(d * 16 + r) * 64 + lane] = o[d][r] * rli[r];
    }
    asm volatile("s_waitcnt lgkmcnt(0)" ::: "memory"); __builtin_amdgcn_s_barrier(); asm volatile("" ::: "memory");
    if (mp == 0) {
        const float lam = T.lam;
#pragma unroll
        for (int d = 0; d < 4; ++d)
#pragma unroll
            for (int r = 0; r < 16; ++r) o[d][r] = o[d][r] * rli[r] - lam * X[(d * 16 + r) * 64 + lane];
        asm volatile("s_waitcnt lgkmcnt(0)" ::: "memory");
#pragma unroll
        for (int d = 0; d < 4; ++d)
#pragma unroll
            for (int r = 0; r < 16; ++r) X[crow(r, hi) * 132 + d * 32 + r32] = o[d][r];
        asm volatile("s_waitcnt lgkmcnt(0)" ::: "memory");
        f32x4 v[16]; float ss = 0.f;
#pragma unroll
        for (int i = 0; i < 16; ++i) { v[i] = *(const __attribute__((address_space(3))) f32x4*)(X + r32 * 132 + hi * 64 + 4 * i); ss += (v[i].x * v[i].x + v[i].y * v[i].y) + (v[i].z * v[i].z + v[i].w * v[i].w); }
        ss += xhalf(ss);
        const float rstd = 0.8f / sqrtf(ss * (1.0f / 128.0f) + 1e-5f);
        bf16* Ow = T.ycat + (size_t)(q0 + r32) * 2048 + h * 128 + hi * 64;
        const float* gs = T.g_subln + hi * 64;
#pragma unroll
        for (int i = 0; i < 8; ++i) {
            const f32x4 g0 = *(const f32x4*)(gs + 8 * i), g1 = *(const f32x4*)(gs + 8 * i + 4); const f32x4 a = v[2 * i] * rstd * g0, b = v[2 * i + 1] * rstd * g1;
            u32x4 w; w.x = cvtpk_s(a.x, a.y); w.y = cvtpk_s(a.z, a.w); w.z = cvtpk_s(b.x, b.y); w.w = cvtpk_s(b.z, b.w);
            *(u32x4*)(Ow + 8 * i) = w;
        }
    }
    asm volatile("s_waitcnt lgkmcnt(0)" ::: "memory"); __builtin_amdgcn_s_barrier(); asm volatile("" ::: "memory");
}
}

constexpr int NWAVES = 8;
constexpr int SEQ = 16384, DM = 2048, NPROJ = 6144, NHEAD = 8, NEXP = 32, DEXP = 512, CAP = 16384;
constexpr float NORM_EPS = 1e-6f;
#ifndef MK_N_LAUNCHES
#define MK_N_LAUNCHES 1
#endif
constexpr int N_PHASES = 9;
constexpr int N_LAUNCHES = MK_N_LAUNCHES;

constexpr size_t MiB = 1u << 20;
constexpr size_t WS_CTL = 0, CTL_ZERO_BYTES = 1 * MiB;
constexpr size_t WS_WRT = 1 * MiB;
constexpr size_t WS_GATES = 2 * MiB;
constexpr size_t WS_LIST = 3 * MiB;
constexpr size_t WS_WIN = 6 * MiB;
constexpr size_t WS_WOUT = 30 * MiB;
constexpr size_t WS_W1 = 38 * MiB;
constexpr size_t WS_W2 = 166 * MiB;
constexpr size_t WS_B = 230 * MiB;
constexpr size_t WS_A = 294 * MiB;
constexpr size_t WS_END = 486 * MiB;
constexpr int CW_BAR = 4096;
constexpr int CW_NMAX = 8448;
constexpr int CW_QUEUE = 8704;
constexpr int CW_CNT = 8192;
constexpr int CW_MOD = 16384;

constexpr int RING_OFF = 0, RING_BYTES = 131072;
constexpr int LDSCTL_OFF = RING_BYTES;
constexpr int LDS_BYTES = 147456;
constexpr int LT_PRE = LDSCTL_OFF + 256, LT_CNT = LT_PRE + 34 * 4;

#define GAS __attribute__((address_space(1)))
#define LAS __attribute__((address_space(3)))
typedef unsigned short bf16;
typedef unsigned v4u __attribute__((ext_vector_type(4)));
typedef unsigned v2u __attribute__((ext_vector_type(2)));
typedef float f32x4 __attribute__((ext_vector_type(4)));
typedef GAS unsigned gu32;
#define RLX_AGENT __ATOMIC_RELAXED, __HIP_MEMORY_SCOPE_AGENT
#define LDS_WAIT() asm volatile("s_waitcnt lgkmcnt(0)" ::: "memory")
#define VM_WAIT() asm volatile("s_waitcnt vmcnt(0)" ::: "memory")
__device__ __forceinline__ unsigned f2bf(float f) { unsigned u = __builtin_bit_cast(unsigned, f); return (u + 0x7fffu + ((u >> 16) & 1u)) >> 16; }
__device__ __forceinline__ unsigned pk2(float lo, float hi) { return f2bf(lo) | (f2bf(hi) << 16); }
__device__ __forceinline__ float bf_lo(unsigned w) { return __builtin_bit_cast(float, w << 16); }
__device__ __forceinline__ float bf_hi(unsigned w) { return __builtin_bit_cast(float, w & 0xffff0000u); }

#define XB_TMO      128
#define XB_XCNT(j)  (256  + 64 * (j))
#define XB_XSUB(j)  (1280 + 64 * (j))
#define XB_XGEN(j)  (2304 + 64 * (j))
#define XB_TOP      3328
#define XB_TOPGEN   3392
#define XCD_BAR_WORDS 3456
#define XB_SPIN_CAP (1u << 18)

__device__ __forceinline__ unsigned xb_ld(unsigned* p)              { return __hip_atomic_load(p, __ATOMIC_RELAXED, __HIP_MEMORY_SCOPE_AGENT); }
__device__ __forceinline__ unsigned xb_add(unsigned* p, unsigned v) { return __hip_atomic_fetch_add(p, v, __ATOMIC_RELAXED, __HIP_MEMORY_SCOPE_AGENT); }
__device__ __forceinline__ unsigned xb_xcc_id() { return (unsigned)__builtin_amdgcn_s_getreg((3 << 11) | 20) & 0xFu; }
#define XB_SPIN(cond, bar) do { unsigned _sp = 0; while (cond) { __builtin_amdgcn_s_sleep(1); \
    if ((++_sp & 255u) == 0u) { if (xb_ld(&(bar)[XB_TMO])) break; if (_sp > XB_SPIN_CAP) { atomicAdd(&(bar)[XB_TMO], 1u); break; } } } } while (0)

struct XcdBarrier {
    unsigned* bar; unsigned x;
    volatile LAS unsigned* st;
};

__device__ __forceinline__ XcdBarrier xcd_barrier_post(unsigned* bar, volatile LAS unsigned* st) {
    XcdBarrier b; b.bar = bar; b.x = xb_xcc_id(); b.st = st;
    if (threadIdx.x == 0) (void)xb_add(&bar[XB_XCNT(b.x)], 1u);
    return b;
}
__device__ __forceinline__ void xcd_barrier_complete(unsigned* bar, unsigned x, unsigned& nloc, unsigned& nx) {
    const unsigned G = gridDim.x * gridDim.y * gridDim.z;
    unsigned sum, cnt, mine, sp = 0u;
    for (;;) {
        sum = 0u; cnt = 0u; mine = 0u;
#pragma unroll
        for (unsigned j = 0; j < 16; ++j) { const unsigned c = xb_ld(&bar[XB_XCNT(j)]); sum += c; cnt += (c > 0u) ? 1u : 0u; mine = (j == x) ? c : mine; }
        if (sum == G) break;
        __builtin_amdgcn_s_sleep(1);
        if ((++sp & 255u) == 0u) { if (xb_ld(&bar[XB_TMO])) break; if (sp > XB_SPIN_CAP) { atomicAdd(&bar[XB_TMO], 1u); break; } }
    }
    nloc = mine > 0u ? mine : 1u; nx = cnt > 0u ? cnt : 1u;
}

__device__ __forceinline__ void xcd_barrier(const XcdBarrier& b) {
    asm volatile("s_waitcnt vmcnt(0)" ::: "memory");
    __syncthreads();
    if (threadIdx.x == 0) {
        unsigned* bar = b.bar;
        __builtin_amdgcn_s_waitcnt(0);
        unsigned nloc = b.st[0], nx = b.st[1];
        if (nloc == 0u) { xcd_barrier_complete(bar, b.x, nloc, nx); b.st[0] = nloc; b.st[1] = nx; }
        const unsigned old = xb_add(&bar[XB_XSUB(b.x)], 1u);
        const unsigned gen = old / nloc;
        if (old + 1u == (gen + 1u) * nloc) {
            __builtin_amdgcn_fence(__ATOMIC_RELEASE, "agent");
            asm volatile("s_waitcnt vmcnt(0)" ::: "memory");
            const unsigned og = xb_add(&bar[XB_TOP], 1u);
            const unsigned tg = og / nx;
            if (og + 1u == (tg + 1u) * nx) xb_add(&bar[XB_TOPGEN], 1u);
            else XB_SPIN(xb_ld(&bar[XB_TOPGEN]) == tg, bar);
            __builtin_amdgcn_fence(__ATOMIC_ACQUIRE, "agent");
            xb_add(&bar[XB_XGEN(b.x)], 1u);
            asm volatile("s_waitcnt vmcnt(0)" ::: "memory");
        } else {
            XB_SPIN(xb_ld(&bar[XB_XGEN(b.x)]) == gen, bar);
            __builtin_amdgcn_fence(__ATOMIC_ACQUIRE, "agent");
            asm volatile("s_waitcnt vmcnt(0)" ::: "memory");
        }
    }
    __syncthreads();
}

struct Frame {
    LAS unsigned char* lds;
    gu32* ctl;
    int tid, lane, wave;
    int vcu, G;
    const float* in[23]; float* out; unsigned char* ws;
};
enum { I_X = 0, I_C, I_WADA, I_BADA, I_GPRE1, I_WIN, I_LQ1, I_LK1, I_LQ2, I_LK2, I_GSUB, I_WCONV, I_WOUT, I_GPOST1, I_GPRE2, I_WRG, I_BRG, I_WRE, I_BRE, I_WGATE, I_WUP, I_WDOWN, I_GPOST2 };

__device__ __forceinline__ float wave_sum(float v) {
#pragma unroll
    for (int o = 1; o < 64; o <<= 1) v += __shfl_xor(v, o);
    return v;
}
__device__ __forceinline__ float modval(const Frame& F, int n) {
    const long long a = ((const long long*)(F.ctl + CW_MOD))[n];
    return F.in[I_BADA][n] + (float)a * 9.094947017729282e-13f;
}

__device__ __forceinline__ void p0_transpose_item(const float* W, int K, int N, bf16* WT, int k0, int n0, int dst_row0, LAS float* scr, int lane) {
#pragma unroll 8
    for (int i = 0; i < 32; ++i) { const int kk = 2 * i + (lane >> 5); scr[kk * 33 + (lane & 31)] = W[(size_t)(k0 + kk) * N + n0 + (lane & 31)]; }
    LDS_WAIT(); asm volatile("" ::: "memory");
    const int c = lane & 7;
#pragma unroll
    for (int j = 0; j < 4; ++j) { const int n = (lane >> 3) + 8 * j; const LAS float* s = scr + (8 * c) * 33 + n;
        v4u o; o.x = pk2(s[0 * 33], s[1 * 33]); o.y = pk2(s[2 * 33], s[3 * 33]); o.z = pk2(s[4 * 33], s[5 * 33]); o.w = pk2(s[6 * 33], s[7 * 33]);
        *(GAS v4u*)(WT + (size_t)(dst_row0 + n) * K + k0 + 8 * c) = o; }
    LDS_WAIT(); asm volatile("" ::: "memory");
}

__device__ __forceinline__ void p0_prologue(Frame& F) {
    const int gw = F.vcu * NWAVES + F.wave, NGW = F.G * NWAVES;
    {
        const float* c = F.in[I_C]; const float* W = F.in[I_WADA];
        unsigned long long* acc = (unsigned long long*)(F.ctl + CW_MOD);
        for (int it = gw; it < 48 * 32; it += NGW) {
            const int cg = it % 48, ks = it / 48, k0 = ks * 64, col = cg * 256 + F.lane * 4;
            f32x4 a = {0.f, 0.f, 0.f, 0.f};
#pragma unroll 8
            for (int kk = 0; kk < 64; ++kk) { const float cv = c[k0 + kk]; const float s = cv / (1.0f + __expf(-cv)); const f32x4 w = *(const f32x4*)(W + (size_t)(k0 + kk) * 12288 + col); a += w * s; }
#pragma unroll
            for (int i = 0; i < 4; ++i) { const long long q = __float2ll_rn(a[i] * 1099511627776.0f); atomicAdd(acc + col + i, (unsigned long long)q); }
        }
    }
    {
        float* WrT = (float*)(F.ws + WS_WRT);
        for (int idx = blockIdx.x * 512 + F.tid; idx < 36 * 2048; idx += F.G * 512) { const int j = idx >> 11, k = idx & 2047;
            WrT[idx] = (j < 4) ? F.in[I_WRG][k * 4 + j] : F.in[I_WRE][k * 32 + (j - 4)]; }
    }
    LAS float* scr = (LAS float*)(F.lds + RING_OFF + F.wave * 16384);
    constexpr int I_IN = 32 * 192, I_OUT = 32 * 64, I_G = 32 * 32 * 16, I_D = 32 * 8 * 64;
    constexpr int NITEMS = I_IN + I_OUT + 2 * I_G + I_D;
    for (int it = gw; it < NITEMS; it += NGW) {
        int r = it;
        if (r < I_IN) { const int kb = r / 192, nb = r % 192; p0_transpose_item(F.in[I_WIN], 2048, 6144, (bf16*)(F.ws + WS_WIN), 64 * kb, 32 * nb, 32 * nb, scr, F.lane); continue; } r -= I_IN;
        if (r < I_OUT) { const int kb = r / 64, nb = r % 64; p0_transpose_item(F.in[I_WOUT], 2048, 2048, (bf16*)(F.ws + WS_WOUT), 64 * kb, 32 * nb, 32 * nb, scr, F.lane); continue; } r -= I_OUT;
        if (r < 2 * I_G) { const int up = r / I_G; r -= up * I_G; const int e = r / 512, q = r % 512, kb = q / 16, nb = q % 16, n0 = 32 * nb;
            p0_transpose_item(F.in[up ? I_WUP : I_WGATE] + (size_t)e * 2048 * 512, 2048, 512, (bf16*)(F.ws + WS_W1), 64 * kb, n0, e * 1024 + (n0 >> 7) * 256 + up * 128 + (n0 & 127), scr, F.lane); continue; } r -= 2 * I_G;
        { const int e = r / 512, q = r % 512, kb = q / 64, nb = q % 64;
            p0_transpose_item(F.in[I_WDOWN] + (size_t)e * 512 * 2048, 512, 2048, (bf16*)(F.ws + WS_W2), 64 * kb, 32 * nb, e * 2048 + 32 * nb, scr, F.lane); }
    }
}

__device__ __forceinline__ void p1_norm(Frame& F) {
    LAS float* tA = (LAS float*)(F.lds + RING_OFF); LAS float* tB = tA + 2048;
    for (int i = F.tid; i < 2048; i += 512) { tA[i] = F.in[I_GPRE1][i] * (1.0f + modval(F, 2048 + i)); tB[i] = modval(F, i); }
    __syncthreads();
    const int gw = F.vcu * NWAVES + F.wave, NGW = F.G * NWAVES;
    bf16* H1 = (bf16*)(F.ws + WS_B);
    for (int m = gw; m < SEQ; m += NGW) {
        const GAS f32x4* xr = (const GAS f32x4*)(F.in[I_X] + (size_t)m * DM) + F.lane;
        f32x4 v[8]; float s = 0.f;
#pragma unroll
        for (int j = 0; j < 8; ++j) { v[j] = xr[64 * j]; s += (v[j].x * v[j].x + v[j].y * v[j].y) + (v[j].z * v[j].z + v[j].w * v[j].w); }
        const float rstd = 1.0f / sqrtf(wave_sum(s) * (1.0f / DM) + NORM_EPS);
        GAS v2u* o8 = (GAS v2u*)(H1 + (size_t)m * DM) + F.lane;
#pragma unroll
        for (int j = 0; j < 8; ++j) { const f32x4 a = *(const LAS f32x4*)(tA + 256 * j + 4 * F.lane), b = *(const LAS f32x4*)(tB + 256 * j + 4 * F.lane); const f32x4 h = v[j] * rstd * a + b;
            v2u w; w.x = pk2(h.x, h.y); w.y = pk2(h.z, h.w); o8[64 * j] = w; }
    }
    __syncthreads();
}

__device__ __forceinline__ void p3_conv(Frame& F) {
    const int gw = F.vcu * NWAVES + F.wave, NGW = F.G * NWAVES;
    const bf16* P = (const bf16*)(F.ws + WS_A); bf16* Y = (bf16*)(F.ws + WS_B); const float* wc = F.in[I_WCONV];
    for (int it = gw; it < 2048; it += NGW) {
        const int t0 = (it >> 1) * 16, ch = (it & 1) * 512 + F.lane * 8;
        float w0[8], w1[8], w2[8], z1[8], z2[8];
#pragma unroll
        for (int i = 0; i < 8; ++i) { w0[i] = wc[ch + i]; w1[i] = wc[1024 + ch + i]; w2[i] = wc[2048 + ch + i]; z1[i] = 0.f; z2[i] = 0.f; }
        for (int t = t0 - 2; t < t0 + 16; ++t) {
            if (t < 0) continue;
            const bf16* row = P + (size_t)t * NPROJ;
            const v4u cg = *(const GAS v4u*)(row + 4096 + ch), xu = *(const GAS v4u*)(row + 5120 + ch);
            float z[8];
#pragma unroll
            for (int i = 0; i < 4; ++i) { z[2 * i] = bf_lo(cg[i]) * bf_lo(xu[i]); z[2 * i + 1] = bf_hi(cg[i]) * bf_hi(xu[i]); }
            if (t >= t0) {
                const v4u bg = *(const GAS v4u*)(row + 3072 + ch); float y[8];
#pragma unroll
                for (int i = 0; i < 4; ++i) { y[2 * i] = bf_lo(bg[i]) * (w0[2 * i] * z2[2 * i] + w1[2 * i] * z1[2 * i] + w2[2 * i] * z[2 * i]);
                    y[2 * i + 1] = bf_hi(bg[i]) * (w0[2 * i + 1] * z2[2 * i + 1] + w1[2 * i + 1] * z1[2 * i + 1] + w2[2 * i + 1] * z[2 * i + 1]); }
                v4u o; o.x = pk2(y[0], y[1]); o.y = pk2(y[2], y[3]); o.z = pk2(y[4], y[5]); o.w = pk2(y[6], y[7]);
                *(GAS v4u*)(Y + (size_t)t * DM + 1024 + ch) = o;
            }
#pragma unroll
            for (int i = 0; i < 8; ++i) { z2[i] = z1[i]; z1[i] = z[i]; }
        }
    }
}

__device__ __forceinline__ void p5_post_route(Frame& F) {
    LAS float* tG = (LAS float*)(F.lds + RING_OFF); LAS float* tA = tG + 2048; LAS float* tS = tA + 2048;
    for (int i = F.tid; i < 2048; i += 512) { tG[i] = modval(F, 4096 + i) * F.in[I_GPOST1][i]; tA[i] = F.in[I_GPRE2][i] * (1.0f + modval(F, 8192 + i)); tS[i] = modval(F, 6144 + i); }
    __syncthreads();
    const int gw = F.vcu * NWAVES + F.wave, NGW = F.G * NWAVES;
    const bf16* Y1 = (const bf16*)(F.ws + WS_A); bf16* H2 = (bf16*)(F.ws + WS_A + 64 * MiB);
    const float* WrT = (const float*)(F.ws + WS_WRT);
    float* gates = (float*)(F.ws + WS_GATES); int* list = (int*)(F.ws + WS_LIST); unsigned* cnt = (unsigned*)(F.ctl + CW_CNT);
    for (int b = gw; b < SEQ / 4; b += NGW) {
        f32x4 hv[4][8];
#pragma unroll
        for (int r = 0; r < 4; ++r) {
            const int m = 4 * b + r;
            const GAS f32x4* xr = (const GAS f32x4*)(F.in[I_X] + (size_t)m * DM) + F.lane;
            const GAS v2u* yr = (const GAS v2u*)(Y1 + (size_t)m * DM) + F.lane;
            f32x4 xv[8]; v2u yp[8]; float s1 = 0.f;
#pragma unroll
            for (int j = 0; j < 8; ++j) { xv[j] = xr[64 * j]; yp[j] = yr[64 * j]; const f32x4 y = (f32x4){bf_lo(yp[j].x), bf_hi(yp[j].x), bf_lo(yp[j].y), bf_hi(yp[j].y)};
                s1 += (y.x * y.x + y.y * y.y) + (y.z * y.z + y.w * y.w); }
            const float r1 = 1.0f / sqrtf(wave_sum(s1) * (1.0f / DM) + NORM_EPS);
            GAS f32x4* orow = (GAS f32x4*)(F.out + (size_t)m * DM) + F.lane; float s2 = 0.f;
#pragma unroll
            for (int j = 0; j < 8; ++j) { const f32x4 g = *(const LAS f32x4*)(tG + 256 * j + 4 * F.lane); const f32x4 y = (f32x4){bf_lo(yp[j].x), bf_hi(yp[j].x), bf_lo(yp[j].y), bf_hi(yp[j].y)};
                xv[j] = xv[j] + y * r1 * g; orow[64 * j] = xv[j];
                s2 += (xv[j].x * xv[j].x + xv[j].y * xv[j].y) + (xv[j].z * xv[j].z + xv[j].w * xv[j].w); }
            const float r2 = 1.0f / sqrtf(wave_sum(s2) * (1.0f / DM) + NORM_EPS);
            GAS v2u* h8 = (GAS v2u*)(H2 + (size_t)m * DM) + F.lane;
#pragma unroll
            for (int j = 0; j < 8; ++j) { const f32x4 a = *(const LAS f32x4*)(tA + 256 * j + 4 * F.lane), s = *(const LAS f32x4*)(tS + 256 * j + 4 * F.lane); const f32x4 h = xv[j] * r2 * a + s; hv[r][j] = h;
                v2u w; w.x = pk2(h.x, h.y); w.y = pk2(h.z, h.w); h8[64 * j] = w; }
            __builtin_amdgcn_sched_barrier(0);
        }
        LAS float* lg = (LAS float*)(F.lds + RING_OFF + 32768 + F.wave * 1024);
#pragma unroll 1
        for (int j = 0; j < 36; ++j) {
            const GAS f32x4* wr_ = (const GAS f32x4*)(WrT + (size_t)j * DM) + F.lane;
            float a0 = 0.f, a1 = 0.f, a2 = 0.f, a3 = 0.f;
#pragma unroll
            for (int q = 0; q < 8; ++q) { const f32x4 w = wr_[64 * q];
                a0 += (hv[0][q].x * w.x + hv[0][q].y * w.y) + (hv[0][q].z * w.z + hv[0][q].w * w.w);
                a1 += (hv[1][q].x * w.x + hv[1][q].y * w.y) + (hv[1][q].z * w.z + hv[1][q].w * w.w);
                a2 += (hv[2][q].x * w.x + hv[2][q].y * w.y) + (hv[2][q].z * w.z + hv[2][q].w * w.w);
                a3 += (hv[3][q].x * w.x + hv[3][q].y * w.y) + (hv[3][q].z * w.z + hv[3][q].w * w.w); }
            a0 = wave_sum(a0); a1 = wave_sum(a1); a2 = wave_sum(a2); a3 = wave_sum(a3);
            if (F.lane == 0) { lg[j] = a0; lg[36 + j] = a1; lg[72 + j] = a2; lg[108 + j] = a3; }
        }
        LDS_WAIT();
        if (F.lane < 4) {
            const int m = 4 * b + F.lane;
            const LAS float* mine = lg + 36 * F.lane;
            float gl[4]; int gi = 0; float gm;
#pragma unroll
            for (int g = 0; g < 4; ++g) gl[g] = mine[g] + F.in[I_BRG][g];
            gm = gl[0];
#pragma unroll
            for (int g = 1; g < 4; ++g) if (gl[g] > gm) { gm = gl[g]; gi = g; }
            float gs = 0.f;
#pragma unroll
            for (int g = 0; g < 4; ++g) gs += __expf(gl[g] - gm);
            const float gwt = 1.0f / gs;
            float el[8];
#pragma unroll
            for (int e = 0; e < 8; ++e) el[e] = mine[4 + gi * 8 + e] + F.in[I_BRE][gi * 8 + e];
            int i1 = 0; float l1 = el[0];
#pragma unroll
            for (int e = 1; e < 8; ++e) if (el[e] > l1) { l1 = el[e]; i1 = e; }
            int i2 = -1; float l2 = -INFINITY;
#pragma unroll
            for (int e = 0; e < 8; ++e) if (e != i1 && el[e] > l2) { l2 = el[e]; i2 = e; }
            const float w1 = 1.0f / (1.0f + __expf(l2 - l1)), w2 = 1.0f - w1;
            const int e1 = gi * 8 + i1, e2 = gi * 8 + i2;
            const unsigned p1 = atomicAdd(cnt + e1, 1u), p2 = atomicAdd(cnt + e2, 1u);
            list[e1 * CAP + (int)p1] = 2 * m; list[e2 * CAP + (int)p2] = 2 * m + 1;
            gates[2 * m] = gwt * w1; gates[2 * m + 1] = gwt * w2;
        }
    }
    __syncthreads();
}

__device__ __forceinline__ void p8_final(Frame& F) {
    LAS float* tG = (LAS float*)(F.lds + RING_OFF);
    for (int i = F.tid; i < 2048; i += 512) tG[i] = modval(F, 10240 + i) * F.in[I_GPOST2][i];
    __syncthreads();
    const int gw = F.vcu * NWAVES + F.wave, NGW = F.G * NWAVES;
    const bf16* Y2 = (const bf16*)(F.ws + WS_A);
    for (int m = gw; m < SEQ; m += NGW) {
        GAS f32x4* xr = (GAS f32x4*)(F.out + (size_t)m * DM) + F.lane;
        const GAS v2u* ya = (const GAS v2u*)(Y2 + (size_t)(2 * m) * DM) + F.lane; const GAS v2u* yb = (const GAS v2u*)(Y2 + (size_t)(2 * m + 1) * DM) + F.lane;
        f32x4 xv[8], yv[8]; float s = 0.f;
#pragma unroll
        for (int j = 0; j < 8; ++j) { xv[j] = xr[64 * j]; const v2u a = ya[64 * j], b = yb[64 * j];
            yv[j] = (f32x4){bf_lo(a.x) + bf_lo(b.x), bf_hi(a.x) + bf_hi(b.x), bf_lo(a.y) + bf_lo(b.y), bf_hi(a.y) + bf_hi(b.y)};
            s += (yv[j].x * yv[j].x + yv[j].y * yv[j].y) + (yv[j].z * yv[j].z + yv[j].w * yv[j].w); }
        const float rstd = 1.0f / sqrtf(wave_sum(s) * (1.0f / DM) + NORM_EPS);
#pragma unroll
        for (int j = 0; j < 8; ++j) { const f32x4 g = *(const LAS f32x4*)(tG + 256 * j + 4 * F.lane); xr[64 * j] = xv[j] + yv[j] * rstd * g; }
    }
}

template <int NPN, bool TOKEN_ROWS>
struct MoeOrder {
    static constexpr bool GATHER = true;
    const LAS int* pre; const LAS int* cntl; const int* list; int G, c;
    __device__ __forceinline__ bool next(int i, pg8::Unit& u) const {
        const int L = i * G + c; const int total = __builtin_amdgcn_readfirstlane(pre[32]);
        if (L >= total * NPN) return false;
        const int rt = L / NPN, pnl = L % NPN;
        int e = 0;
#pragma unroll 1
        for (int k = 1; k < 32; ++k) if (pre[k] <= rt) e = k;
        e = __builtin_amdgcn_readfirstlane(e);
        u.pm = rt; u.e = e; u.row0 = __builtin_amdgcn_readfirstlane((rt - pre[e]) * 256); const int left = __builtin_amdgcn_readfirstlane(cntl[e]) - u.row0; u.nvalid = left < 256 ? left : 256; u.pn = e * NPN + pnl;
        return true;
    }
    __device__ __forceinline__ void rows(const pg8::Unit& u, const int (&RA)[2], const int (&CA)[2], int K, unsigned (&v)[2][2]) const {
#pragma unroll
        for (int h = 0; h < 2; ++h)
#pragma unroll
            for (int i = 0; i < 2; ++i) { const int r = h * 128 + RA[i]; const int ts = list[u.e * CAP + u.row0 + (r < u.nvalid ? r : 0)];
                const int srow = TOKEN_ROWS ? (ts >> 1) : ts; v[h][i] = (unsigned)((srow * K + CA[i]) * 2); }
    }
};
struct EpiSwiglu {
    static constexpr bool PERM = true;
    bf16* act; const int* list; const float* gates;
    __device__ __forceinline__ void operator()(const pg8::f32x4 (&acc)[2][2][4][2], const pg8::Unit& u, int wr, int wc, int fr, int fq) const {
        const int pnl = u.pn & 3; const int col0 = pnl * 128 + wc * 32 + 8 * fq;
#pragma unroll
        for (int ai = 0; ai < 2; ++ai)
#pragma unroll
            for (int m = 0; m < 4; ++m) { const int r = ai * 128 + wr * 64 + m * 16 + fr;
                if (r < u.nvalid) { const int ts = list[u.e * CAP + u.row0 + r]; const float gt = gates[ts];
                    float o[8];
#pragma unroll
                    for (int n = 0; n < 2; ++n)
#pragma unroll
                        for (int i = 0; i < 4; ++i) { const float g = acc[ai][0][m][n][i], up = acc[ai][1][m][n][i]; o[4 * n + i] = g / (1.0f + __expf(-g)) * up * gt; }
                    pg8::u32x4 w; w.x = pg8::cvt_pk_bf16(o[0], o[1]); w.y = pg8::cvt_pk_bf16(o[2], o[3]); w.z = pg8::cvt_pk_bf16(o[4], o[5]); w.w = pg8::cvt_pk_bf16(o[6], o[7]);
                    *(pg8::u32x4*)(act + (size_t)ts * DEXP + col0) = w; } }
    }
};
struct EpiDown {
    static constexpr bool PERM = true;
    bf16* y2; const int* list;
    __device__ __forceinline__ void operator()(const pg8::f32x4 (&acc)[2][2][4][2], const pg8::Unit& u, int wr, int wc, int fr, int fq) const {
        const int pnl = u.pn & 7; const int col0 = pnl * 256 + wc * 32 + 8 * fq;
#pragma unroll
        for (int ai = 0; ai < 2; ++ai)
#pragma unroll
            for (int m = 0; m < 4; ++m) { const int r = ai * 128 + wr * 64 + m * 16 + fr;
                if (r < u.nvalid) { const int ts = list[u.e * CAP + u.row0 + r]; bf16* rowp = y2 + (size_t)ts * DM + col0;
#pragma unroll
                    for (int bj = 0; bj < 2; ++bj) { const pg8::f32x4 v0 = acc[ai][bj][m][0], v1 = acc[ai][bj][m][1];
                        pg8::u32x4 w; w.x = pg8::cvt_pk_bf16(v0[0], v0[1]); w.y = pg8::cvt_pk_bf16(v0[2], v0[3]); w.z = pg8::cvt_pk_bf16(v1[0], v1[1]); w.w = pg8::cvt_pk_bf16(v1[2], v1[3]);
                        *(pg8::u32x4*)(rowp + bj * 128) = w; } } }
    }
};
__device__ __forceinline__ void moe_tables(Frame& F) {
    LAS int* pre = (LAS int*)(F.lds + LT_PRE); LAS int* cl = (LAS int*)(F.lds + LT_CNT);
    if (F.tid == 0) { int s = 0; const unsigned* cnt = (const unsigned*)(F.ctl + CW_CNT);
        for (int e = 0; e < 32; ++e) { int c = (int)cnt[e]; c = c < 0 ? 0 : (c > CAP ? CAP : c); cl[e] = c; pre[e] = s; s += (c + 255) >> 8; } pre[32] = s; }
    __syncthreads();
}

struct Args { const float* in[23]; float* out; unsigned char* ws; int ph_lo, ph_hi; };
__global__ void __launch_bounds__(NWAVES * 64, 2) mk_fwd(Args args) {
    extern __shared__ __attribute__((aligned(16))) unsigned char lds[];
    Frame F;
    F.lds = (LAS unsigned char*)lds;
    F.tid = threadIdx.x; F.lane = F.tid & 63; F.wave = __builtin_amdgcn_readfirstlane(F.tid >> 6);
    F.G = gridDim.x; { const int bx = blockIdx.x; F.vcu = (F.G % 8 == 0) ? (bx % 8) * (F.G / 8) + bx / 8 : bx; }
    F.ws = args.ws; F.ctl = (gu32*)(args.ws + WS_CTL); F.out = args.out;
#pragma unroll
    for (int i = 0; i < 23; ++i) F.in[i] = args.in[i];
    for (int u = F.tid; u < (LDS_BYTES - LDSCTL_OFF) / 4; u += NWAVES * 64) ((LAS unsigned*)(F.lds + LDSCTL_OFF))[u] = 0u;
    __syncthreads();
    XcdBarrier bar; bar.bar = (unsigned*)(F.ctl + CW_BAR); bar.x = 0; bar.st = nullptr;
    if (N_LAUNCHES == 1) bar = xcd_barrier_post((unsigned*)(F.ctl + CW_BAR), (volatile LAS unsigned*)(F.lds + LDSCTL_OFF));
    const int lo = args.ph_lo, hi = args.ph_hi;
#define IN(k) (lo <= (k) && (k) < hi)
#define SEAM(k) do { if (IN(k) && IN((k) + 1)) xcd_barrier(bar); } while (0)
#ifdef PROBE_PHASE
#define REP(k) ((k) == PROBE_PHASE ? 2 : 1)
#else
#define REP(k) 1
#endif

    if (IN(0)) { p0_prologue(F); } SEAM(0);
    if (IN(1)) { p1_norm(F); } SEAM(1);
    if (IN(2)) {
        pg8::Gemm g{(const pg8::bf16_t*)(F.ws + WS_B), (const pg8::bf16_t*)(F.ws + WS_WIN), SEQ, NPROJ, DM}; pg8::StaticOrder S; S.init(SEQ, NPROJ, F.G, (int)blockIdx.x);
        pg8::EpiBf16 E{(pg8::bf16_t*)(F.ws + WS_A), NPROJ, 1024, att::QSCALE, (unsigned*)(F.ctl + CW_NMAX), 2048};
        pg8::gemm_phase<pg8::EpiBf16, pg8::StaticOrder, true>(F.lds + RING_OFF, g, S, E); if (REP(2) == 2) { pg8::gemm_phase<pg8::EpiBf16, pg8::StaticOrder, true>(F.lds + RING_OFF, g, S, E); }
    } SEAM(2);
    if (IN(3)) {
        p3_conv(F);
        float lam;
        { const float a = wave_sum(F.in[I_LQ1][F.lane] * F.in[I_LK1][F.lane]), b = wave_sum(F.in[I_LQ2][F.lane] * F.in[I_LK2][F.lane]); lam = __expf(a) - __expf(b) + 0.2f; }
        const att::Tensors T{(const __hip_bfloat16*)(F.ws + WS_A), (__hip_bfloat16*)(F.ws + WS_B), F.in[I_GSUB], lam};
        const unsigned* nmx = (const unsigned*)(F.ctl + CW_NMAX);
        LAS int* qslot = (LAS int*)(F.lds + LT_CNT + 256);
        for (int rep = 0; rep < REP(3); ++rep)
        for (;;) {
            if (F.tid == 0) qslot[0] = (int)atomicAdd((unsigned*)(F.ctl + CW_QUEUE) + 64 * rep, 1u);
            __syncthreads();
            const int ui = __builtin_amdgcn_readfirstlane(qslot[0]);
            __syncthreads();
            if (ui >= 1024) break;
            const int qb = 127 - (ui >> 3), h = ui & 7;
            float sm = 0.f;
#pragma unroll
            for (int mp = 0; mp < 2; ++mp) { const float qn = __uint_as_float(nmx[4 * h + 2 * mp]) + __uint_as_float(nmx[4 * h + 2 * mp + 1]), kn = __uint_as_float(nmx[32 + 4 * h + 2 * mp]) + __uint_as_float(nmx[32 + 4 * h + 2 * mp + 1]);
                sm = fmaxf(sm, sqrtf(qn * kn)); }
            const float slope2 = exp2f(-(float)(h + 1)) * att::LOG2E;
            const float D = (2.0f * 1.02f * sm + 152.0f) / slope2;
            int t_lo = (int)ceilf(((float)(qb * 128 - 63) - D) * (1.0f / 64.0f)); t_lo = t_lo < 0 ? 0 : t_lo;
            t_lo = __builtin_amdgcn_readfirstlane(t_lo);
            att::attn_unit(h, qb, t_lo, T, (att::lds_ptr)(F.lds + RING_OFF));
        }
    } SEAM(3);
    if (IN(4)) {
        pg8::Gemm g{(const pg8::bf16_t*)(F.ws + WS_B), (const pg8::bf16_t*)(F.ws + WS_WOUT), SEQ, DM, DM}; pg8::StaticOrder S; S.init(SEQ, DM, F.G, (int)blockIdx.x);
        pg8::EpiBf16 E{(pg8::bf16_t*)(F.ws + WS_A), DM, 0, 1.0f, nullptr, 0};
        pg8::gemm_phase<pg8::EpiBf16, pg8::StaticOrder, true>(F.lds + RING_OFF, g, S, E); if (REP(4) == 2) { pg8::gemm_phase<pg8::EpiBf16, pg8::StaticOrder, true>(F.lds + RING_OFF, g, S, E); }
    } SEAM(4);
    if (IN(5)) { p5_post_route(F); } SEAM(5);
    if (IN(6)) {
        moe_tables(F);
        pg8::Gemm g{(const pg8::bf16_t*)(F.ws + WS_A + 64 * MiB), (const pg8::bf16_t*)(F.ws + WS_W1), SEQ, 1024, DM};
        MoeOrder<4, true> S{(const LAS int*)(F.lds + LT_PRE), (const LAS int*)(F.lds + LT_CNT), (const int*)(F.ws + WS_LIST), F.G, F.vcu};
        EpiSwiglu E{(bf16*)(F.ws + WS_A + 128 * MiB), (const int*)(F.ws + WS_LIST), (const float*)(F.ws + WS_GATES)};
        pg8::gemm_phase<EpiSwiglu, MoeOrder<4, true>, true>(F.lds + RING_OFF, g, S, E); if (REP(6) == 2) { pg8::gemm_phase<EpiSwiglu, MoeOrder<4, true>, true>(F.lds + RING_OFF, g, S, E); }
    } SEAM(6);
    if (IN(7)) {
        moe_tables(F);
        pg8::Gemm g{(const pg8::bf16_t*)(F.ws + WS_A + 128 * MiB), (const pg8::bf16_t*)(F.ws + WS_W2), 2 * SEQ, DM, DEXP};
        MoeOrder<8, false> S{(const LAS int*)(F.lds + LT_PRE), (const LAS int*)(F.lds + LT_CNT), (const int*)(F.ws + WS_LIST), F.G, F.vcu};
        EpiDown E{(bf16*)(F.ws + WS_A), (const int*)(F.ws + WS_LIST)};
        pg8::gemm_phase<EpiDown, MoeOrder<8, false>, true>(F.lds + RING_OFF, g, S, E); if (REP(7) == 2) { pg8::gemm_phase<EpiDown, MoeOrder<8, false>, true>(F.lds + RING_OFF, g, S, E); }
    } SEAM(7);
    if (IN(8)) { p8_final(F); }
#undef IN
#undef SEAM
}

extern "C" void kernel_launch(void* const* d_in, const int* in_sizes, int n_in, void* d_out, int out_size, void* d_ws, size_t ws_size, hipStream_t stream) {
    static int grid = 0;
    if (grid == 0) {
        if (n_in != 23 || in_sizes[0] != SEQ * DM || out_size != SEQ * DM || ws_size < WS_END) { fprintf(stderr, "kernel_launch: shape/workspace mismatch (n_in %d, in0 %d, out %d, ws %zu < %zu); nothing launched\n", n_in, n_in > 0 ? in_sizes[0] : -1, out_size, ws_size, (size_t)WS_END); grid = -1; return; }
        int dev = 0, cus = 0, per_cu = 0;
        if (hipGetDevice(&dev) != hipSuccess || hipDeviceGetAttribute(&cus, hipDeviceAttributeMultiprocessorCount, dev) != hipSuccess) { fprintf(stderr, "kernel_launch: hipGetDevice / hipDeviceGetAttribute failed\n"); grid = -1; return; }
        if (hipFuncSetAttribute((const void*)mk_fwd, hipFuncAttributeMaxDynamicSharedMemorySize, LDS_BYTES) != hipSuccess) { fprintf(stderr, "kernel_launch: hipFuncSetAttribute failed\n"); grid = -1; return; }
        if (hipOccupancyMaxActiveBlocksPerMultiprocessor(&per_cu, (const void*)mk_fwd, NWAVES * 64, LDS_BYTES) != hipSuccess || per_cu < 1) { fprintf(stderr, "kernel_launch: occupancy query reports %d workgroups per CU\n", per_cu); }
        (void)hipGetLastError();
        grid = cus;
    }
    if (grid < 0) return;
    if (hipMemsetAsync((char*)d_ws + WS_CTL, 0, CTL_ZERO_BYTES, stream) != hipSuccess) { fprintf(stderr, "kernel_launch: hipMemsetAsync failed\n"); return; }
    Args a{};
    for (int i = 0; i < 23; ++i) a.in[i] = (const float*)d_in[i];
    a.out = (float*)d_out; a.ws = (unsigned char*)d_ws;
    for (int li = 0; li < N_LAUNCHES; ++li) {
        a.ph_lo = (N_LAUNCHES == 1) ? 0 : li; a.ph_hi = (N_LAUNCHES == 1) ? N_PHASES : li + 1;
        hipLaunchKernelGGL(mk_fwd, dim3(grid), dim3(NWAVES * 64), LDS_BYTES, stream, a);
        const hipError_t le = hipPeekAtLastError();
        if (le != hipSuccess) { fprintf(stderr, "kernel_launch: launch %d failed: %s\n", li, hipGetErrorName(le)); break; }
    }
}
```

```cpp
#include <hip/hip_runtime.h>
#include <hip/hip_bf16.h>
#include <cstdio>
#include <cstdint>
#include <cmath>

namespace pg8 {
#define PG8_LAS __attribute__((address_space(3)))
typedef unsigned short bf16_t;
typedef short bf16x8 __attribute__((ext_vector_type(8)));
typedef float f32x4 __attribute__((ext_vector_type(4)));
typedef unsigned u32x4 __attribute__((ext_vector_type(4)));
constexpr int BM = 256, BK = 64, HALF = 128, HTB = HALF * BK * 2  , STAGE_BYTES = 8 * HTB, NXCD = 8, WGM = 8;

__host__ __device__ __forceinline__ int lds_byte(int r, int c) { const int st = (r >> 4) * 2 + (c >> 5), rr = r & 15, cc = c & 31, ob = rr * 64 + cc * 2; return st * 1024 + (ob ^ (((ob >> 9) & 1) << 5)); }
__host__ __device__ __forceinline__ void stage_rc(int b, int& R, int& C) { const int st = b / 1024, sb = b % 1024, swz = sb ^ (((sb >> 9) & 1) << 5); R = (st >> 1) * 16 + swz / 64; C = (st & 1) * 32 + (swz % 64) / 2; }
__host__ __device__ __forceinline__ int perm32(int rho) { const int n = rho >> 4, i = rho & 15; return 8 * (i >> 2) + 4 * n + (i & 3); }

struct Unit { int pm, pn; int e, row0, nvalid; };
struct Gemm { const bf16_t* A; const bf16_t* Bt; int M, N, K; };

struct StaticOrder {
    static constexpr bool GATHER = false;
    int nM, nN, nwg, G, c;
    __host__ __device__ void init(int M, int N, int G_, int c_) { nM = M / BM; nN = N / BM; nwg = nM * nN; G = G_; c = c_; }
    __device__ __forceinline__ bool next(int i, Unit& u) const {
        const long L = (long)i * G + c; if (L >= nwg) return false;
        int wgid = (int)L; { const int q = nwg / NXCD, r = nwg % NXCD, xcd = wgid % NXCD, off = wgid / NXCD; wgid = (xcd < r ? xcd * (q + 1) : r * (q + 1) + (xcd - r) * q) + off; }
        const int nig = WGM * nN, gid = wgid / nig, fm = gid * WGM, gsz = (nM - fm) < WGM ? (nM - fm) : WGM;
        u.pm = fm + ((wgid % nig) % gsz); u.pn = (wgid % nig) / gsz; u.e = 0; u.row0 = 0; u.nvalid = 256; return true;
    }
    __device__ __forceinline__ void rows(const Unit& u, const int (&RA)[2], const int (&CA)[2], int K, unsigned (&v)[2][2]) const {
#pragma unroll
        for (int h = 0; h < 2; ++h)
#pragma unroll
            for (int i = 0; i < 2; ++i) v[h][i] = (unsigned)(((u.pm * BM + h * HALF + RA[i]) * K + CA[i]) * 2);
    }
};

__device__ __forceinline__ unsigned cvt_pk_bf16(float lo, float hi) { unsigned r; asm volatile("v_cvt_pk_bf16_f32 %0, %1, %2" : "=v"(r) : "v"(lo), "v"(hi)); return r; }

struct EpiBf16 {
    static constexpr bool PERM = true;
    bf16_t* O; int ldc; int scale_cols; float scale0;
    unsigned* nmax; int nmax_cols;
    __device__ __forceinline__ void operator()(const f32x4 (&acc)[2][2][4][2], const Unit& u, int wr, int wc, int fr, int fq) const {
        const int row0 = u.pm * BM + wr * 64 + fr; const int colt = u.pn * BM;
        const float sc = (colt < scale_cols) ? scale0 : 1.f;
        const int col0 = colt + wc * 32 + 8 * fq;
        const bool donorm = (nmax != nullptr) && (colt < nmax_cols);
        float nm[2] = {0.f, 0.f};
#pragma unroll
        for (int ai = 0; ai < 2; ++ai)
#pragma unroll
            for (int m = 0; m < 4; ++m) { bf16_t* rowp = O + (size_t)(row0 + ai * HALF + m * 16) * ldc + col0;
#pragma unroll
                for (int bj = 0; bj < 2; ++bj) { f32x4 v0 = acc[ai][bj][m][0] * sc, v1 = acc[ai][bj][m][1] * sc;
                    u32x4 w; w.x = cvt_pk_bf16(v0[0], v0[1]); w.y = cvt_pk_bf16(v0[2], v0[3]); w.z = cvt_pk_bf16(v1[0], v1[1]); w.w = cvt_pk_bf16(v1[2], v1[3]);
                    *(u32x4*)(rowp + bj * HALF) = w;
                    if (donorm) { float ss = (v0[0] * v0[0] + v0[1] * v0[1]) + (v0[2] * v0[2] + v0[3] * v0[3]) + (v1[0] * v1[0] + v1[1] * v1[1]) + (v1[2] * v1[2] + v1[3] * v1[3]);
                        ss += __shfl_xor(ss, 16); ss += __shfl_xor(ss, 32); nm[bj] = fmaxf(nm[bj], ss); } } }
        if (donorm) {
#pragma unroll
            for (int bj = 0; bj < 2; ++bj) { float v = nm[bj];
#pragma unroll
                for (int o = 1; o < 16; o <<= 1) v = fmaxf(v, __shfl_xor(v, o));
                if ((threadIdx.x & 63) == 0) atomicMax(nmax + (colt >> 5) + 4 * bj + wc, __float_as_uint(v)); }
        }
    }
};

template <class Epi, class Sched, bool ALIGN_EPI = false>
__device__ __forceinline__ void gemm_phase(PG8_LAS unsigned char* lds, const Gemm g, const Sched& S, const Epi& E) {
    const int tid = threadIdx.x, wid = __builtin_amdgcn_readfirstlane(tid >> 6), lane = tid & 63, wr = wid >> 2, wc = wid & 3, fr = lane & 15, fq = lane >> 4;
    const int K = g.K, nt = K / BK;
    int RA[2], CA[2]; unsigned voffB[2];
#pragma unroll
    for (int i = 0; i < 2; ++i) { int R, C; stage_rc(tid * 16 + i * 8192, R, C); const int Rb = Epi::PERM ? ((R & ~31) + perm32(R & 31)) : R;
        RA[i] = R; CA[i] = C; voffB[i] = (unsigned)(Rb * K + C) * 2u; }
    const size_t kstep = (size_t)(BK * 2);
    const size_t hstep = (size_t)HALF * K * 2;
    const size_t tstep = 2 * hstep;
    const unsigned ldsw = (unsigned)wid * 1024u;
    const int aoff = lds_byte(wr * 64 + fr, fq * 8), boff = lds_byte(wc * 32 + fr, fq * 8);
    const char* const Abase = (const char*)g.A;
#define PG8_SA(b, h) (((b) * 2 + (h)) * HTB)
#define PG8_SB(b, h) ((4 + (b) * 2 + (h)) * HTB)
#define PG8_STAGE(bufoff, gbase, voff) do { _Pragma("unroll") for (int _i = 0; _i < 2; ++_i) \
        __builtin_amdgcn_global_load_lds((const unsigned*)((const char*)(gbase) + (voff)[_i]), (PG8_LAS unsigned*)(lds + (bufoff) + ldsw + _i * 8192), 16, 0, 0); } while (0)
#define PG8_STAGE_A(bufoff, v0, v1, kb) do { \
        __builtin_amdgcn_global_load_lds((const unsigned*)(Abase + (size_t)((v0) + (kb))), (PG8_LAS unsigned*)(lds + (bufoff) + ldsw), 16, 0, 0); \
        __builtin_amdgcn_global_load_lds((const unsigned*)(Abase + (size_t)((v1) + (kb))), (PG8_LAS unsigned*)(lds + (bufoff) + ldsw + 8192), 16, 0, 0); } while (0)
#define PG8_LDA(dst, b, h) do { _Pragma("unroll") for (int m = 0; m < 4; ++m) _Pragma("unroll") for (int k = 0; k < 2; ++k) dst[m][k] = *(const PG8_LAS bf16x8*)(lds + PG8_SA(b, h) + aoff + m * 2048 + k * 1024); } while (0)
#define PG8_LDB(dst, b, h) do { _Pragma("unroll") for (int n = 0; n < 2; ++n) _Pragma("unroll") for (int k = 0; k < 2; ++k) dst[n][k] = *(const PG8_LAS bf16x8*)(lds + PG8_SB(b, h) + boff + n * 2048 + k * 1024); } while (0)
#define PG8_MMA(ai, bj, At, Bt) do { __builtin_amdgcn_s_setprio(1); _Pragma("unroll") for (int m = 0; m < 4; ++m) _Pragma("unroll") for (int n = 0; n < 2; ++n) _Pragma("unroll") for (int k = 0; k < 2; ++k) \
        acc[ai][bj][m][n] = __builtin_amdgcn_mfma_f32_16x16x32_bf16(Bt[n][k], At[m][k], acc[ai][bj][m][n], 0, 0, 0); __builtin_amdgcn_s_setprio(0); } while (0)
#define PG8_WAIT_V(n) asm volatile("s_waitcnt vmcnt(" #n ")" ::: "memory")
#define PG8_WAIT_L(n) asm volatile("s_waitcnt lgkmcnt(" #n ")" ::: "memory")
#define PG8_BAR __builtin_amdgcn_s_barrier()
#define PG8_SCHED __builtin_amdgcn_sched_barrier(0)
    Unit cur, nxt; int ui = 0;
    if (!S.next(0, cur)) return;
    f32x4 acc[2][2][4][2];
#pragma unroll
    for (int a = 0; a < 2; ++a)
#pragma unroll
        for (int b = 0; b < 2; ++b)
#pragma unroll
            for (int m = 0; m < 4; ++m)
#pragma unroll
                for (int n = 0; n < 2; ++n) acc[a][b][m][n] = (f32x4){0.f, 0.f, 0.f, 0.f};
    bf16x8 At[4][2], B0[2][2], B1[2][2];
    unsigned vAc[2][2], vAn[2][2];
    S.rows(cur, RA, CA, K, vAc);
    const char* cB = (const char*)g.Bt + (size_t)cur.pn * tstep;
    PG8_STAGE(PG8_SB(0, 0), cB, voffB); PG8_STAGE(PG8_SB(0, 1), cB + hstep, voffB); PG8_STAGE_A(PG8_SA(0, 0), vAc[0][0], vAc[0][1], 0u); PG8_STAGE_A(PG8_SA(0, 1), vAc[1][0], vAc[1][1], 0u);
    if (wr == 1) PG8_BAR;
    PG8_WAIT_V(2); PG8_BAR;
    PG8_STAGE(PG8_SB(1, 0), cB + kstep, voffB); PG8_STAGE_A(PG8_SA(1, 0), vAc[0][0], vAc[0][1], (unsigned)kstep); PG8_STAGE(PG8_SB(1, 1), cB + hstep + kstep, voffB);
    PG8_WAIT_V(6); PG8_BAR;
    for (;;) {
        const bool has_next = S.next(ui + 1, nxt);
        if (has_next) S.rows(nxt, RA, CA, K, vAn);
        else { vAn[0][0] = vAc[0][0]; vAn[0][1] = vAc[0][1]; vAn[1][0] = vAc[1][0]; vAn[1][1] = vAc[1][1]; }
        const char* nB = has_next ? (const char*)g.Bt + (size_t)nxt.pn * tstep : cB;
        for (int t = 0; t < nt; t += 2) {
            const bool last = (t == nt - 2);
            const unsigned kb1 = (unsigned)(t + 1) * (unsigned)kstep;
            const unsigned kb2 = last ? 0u : (unsigned)(t + 2) * (unsigned)kstep, kb3 = kb2 + (unsigned)kstep;
            const unsigned x00 = last ? vAn[0][0] : vAc[0][0], x01 = last ? vAn[0][1] : vAc[0][1], x10 = last ? vAn[1][0] : vAc[1][0], x11 = last ? vAn[1][1] : vAc[1][1];
            const char* b2 = last ? nB : cB + (size_t)(t + 2) * kstep; const char* b3 = b2 + kstep;
            PG8_LDB(B0, 0, 0); PG8_LDB(B1, 0, 1); PG8_SCHED; PG8_LDA(At, 0, 0); PG8_STAGE_A(PG8_SA(1, 1), vAc[1][0], vAc[1][1], kb1);
            PG8_WAIT_V(8); PG8_WAIT_L(0); PG8_BAR; PG8_MMA(0, 0, At, B0); PG8_MMA(0, 1, At, B1); PG8_BAR; PG8_SCHED;
            PG8_LDA(At, 0, 1); PG8_STAGE(PG8_SB(0, 0), b2, voffB); PG8_STAGE(PG8_SB(0, 1), b2 + hstep, voffB); PG8_STAGE_A(PG8_SA(0, 0), x00, x01, kb2);
            PG8_WAIT_V(8); PG8_WAIT_L(0); PG8_BAR; PG8_MMA(1, 0, At, B0); PG8_MMA(1, 1, At, B1); PG8_BAR; PG8_SCHED;
            PG8_LDB(B0, 1, 0); PG8_LDB(B1, 1, 1); PG8_SCHED; PG8_LDA(At, 1, 0); PG8_STAGE_A(PG8_SA(0, 1), x10, x11, kb2);
            PG8_WAIT_V(8); PG8_WAIT_L(0); PG8_BAR; PG8_MMA(0, 0, At, B0); PG8_MMA(0, 1, At, B1); PG8_BAR; PG8_SCHED;
            PG8_LDA(At, 1, 1); PG8_STAGE(PG8_SB(1, 0), b3, voffB); PG8_STAGE(PG8_SB(1, 1), b3 + hstep, voffB); PG8_STAGE_A(PG8_SA(1, 0), x00, x01, kb3);
            PG8_WAIT_V(8); PG8_WAIT_L(0); PG8_BAR; PG8_MMA(1, 0, At, B0); PG8_MMA(1, 1, At, B1); PG8_BAR; PG8_SCHED;
        }
        if constexpr (ALIGN_EPI) { if (wr == 0) PG8_BAR; }
        E(acc, cur, wr, wc, fr, fq);
        if (!has_next) break;
#pragma unroll
        for (int a = 0; a < 2; ++a)
#pragma unroll
            for (int b = 0; b < 2; ++b)
#pragma unroll
                for (int m = 0; m < 4; ++m)
#pragma unroll
                    for (int n = 0; n < 2; ++n) acc[a][b][m][n] = (f32x4){0.f, 0.f, 0.f, 0.f};
        cur = nxt; cB = nB; ++ui;
        vAc[0][0] = vAn[0][0]; vAc[0][1] = vAn[0][1]; vAc[1][0] = vAn[1][0]; vAc[1][1] = vAn[1][1];
        if constexpr (ALIGN_EPI) { if (wr == 1) PG8_BAR; }
    }
    PG8_WAIT_V(0);
    if constexpr (!ALIGN_EPI) { if (wr == 0) PG8_BAR; }
    PG8_BAR;
#undef PG8_SA
#undef PG8_SB
#undef PG8_STAGE
#undef PG8_STAGE_A
#undef PG8_LDA
#undef PG8_LDB
#undef PG8_MMA
#undef PG8_WAIT_V
#undef PG8_WAIT_L
#undef PG8_BAR
#undef PG8_SCHED
}
}

namespace att {
typedef __attribute__((address_space(3))) const char* lds_cptr;
typedef __attribute__((address_space(3))) char* lds_ptr;
using bf16x8 = __attribute__((ext_vector_type(8))) short;
using s16x4 = __attribute__((ext_vector_type(4))) short;
using f32x16 = __attribute__((ext_vector_type(16))) float;
using f32x4 = __attribute__((ext_vector_type(4))) float;
using u32x4 = __attribute__((ext_vector_type(4))) unsigned;
typedef short v4i16_t __attribute__((ext_vector_type(4)));
typedef float f32x2_t __attribute__((ext_vector_type(2))); typedef __bf16 bf16x2_t __attribute__((ext_vector_type(2)));
constexpr int PITCH = 6144 + 128;
constexpr int COL_Q = 0, COL_K = 1024, COL_V = 2048;
constexpr int SLOT = 16384;
constexpr int NSLOT = 4, L_K = 0, L_V = NSLOT * SLOT, L_X = 0, XSTRIDE = 17408, L_WS = 131072 + 2048, LDS_BYTES = L_WS + 8 * 256;
constexpr float LOG2E = 1.4426950408889634f;
constexpr float QSCALE = 0.125f * LOG2E;
constexpr float THR = 6.0f;

__device__ __forceinline__ int crow(int r, int hi) { return (r & 3) + 8 * (r >> 2) + 4 * hi; }
__device__ __forceinline__ void glds16(const void* gsrc, unsigned lds_dst) { unsigned keep;
    asm volatile("s_mov_b32 %0, m0\n\ts_mov_b32 m0, %2\n\ts_nop 0\n\tglobal_load_lds_dwordx4 %1, off\n\ts_mov_b32 m0, %0" : "=&s"(keep) : "v"(gsrc), "s"(lds_dst) : "memory"); }
__device__ __forceinline__ float max3f(float a, float b, float c) { float r; asm("v_max3_f32 %0, %1, %2, %3" : "=v"(r) : "v"(a), "v"(b), "v"(c)); return r; }
__device__ __forceinline__ float max2f(float a, float b) { float r; asm("v_max_f32_e32 %0, %1, %2" : "=v"(r) : "v"(a), "v"(b)); return r; }
__device__ __forceinline__ unsigned cvtpk_s(float lo, float hi) { f32x2_t v = {lo, hi}; bf16x2_t b = __builtin_convertvector(v, bf16x2_t); return __builtin_bit_cast(unsigned, b); }
__device__ __forceinline__ s16x4 vtr(lds_cptr p) { return __builtin_bit_cast(s16x4, __builtin_amdgcn_ds_read_tr16_b64_v4i16((__attribute__((address_space(3))) v4i16_t*)p)); }

struct Tensors { const __hip_bfloat16* proj; __hip_bfloat16* ycat; const float* g_subln; float lam; };

__device__ __forceinline__ float xhalf(float v) { return __shfl_xor(v, 32); }

struct WaveState { f32x16 o[4]; float mhat, l_reg; u32x4 pw0, pw1, pw2, pw3; };
__device__ __forceinline__ void att_qksm(WaveState& st, const bf16x8 (&qr)[4], lds_cptr kb, const int (&kof)[4], __attribute__((address_space(3))) float* wsf, const float (&cst)[16],
                                         float slope2, int qpos, int t, bool diag, int r32, int hi) {
    f32x16 p0, p1;
    bf16x8 kf[8];
#pragma unroll
    for (int d0 = 0; d0 < 4; ++d0) { kf[2 * d0] = *(const __attribute__((address_space(3))) bf16x8*)(kb + kof[d0]); kf[2 * d0 + 1] = *(const __attribute__((address_space(3))) bf16x8*)(kb + kof[d0] + 8192); }
    __builtin_amdgcn_sched_barrier(0);
    const float dq = (float)(qpos - t * 64 - 4 * hi);
    if (diag) {
#pragma unroll
        for (int r = 0; r < 16; ++r) { const float d0_ = dq - (float)((r & 3) + 8 * (r >> 2)); p0[r] = -slope2 * fabsf(d0_) - st.mhat; p1[r] = -slope2 * fabsf(d0_ - 32.f) - st.mhat; }
    } else {
        const float A0 = -slope2 * dq - st.mhat, A1 = A0 + 32.f * slope2;
#pragma unroll
        for (int r = 0; r < 16; ++r) { p0[r] = A0 + cst[r]; p1[r] = A1 + cst[r]; }
    }
    __builtin_amdgcn_sched_barrier(0);
#pragma unroll
    for (int d0 = 0; d0 < 4; ++d0) {
        p0 = __builtin_amdgcn_mfma_f32_32x32x16_bf16(kf[2 * d0], qr[d0], p0, 0, 0, 0);
        p1 = __builtin_amdgcn_mfma_f32_32x32x16_bf16(kf[2 * d0 + 1], qr[d0], p1, 0, 0, 0);
    }
    asm volatile("s_nop 15\n\ts_nop 7" : "+v"(p0), "+v"(p1));
    float rm;
    { float a_ = max3f(p0[0], p0[1], p1[0]), b_ = max3f(p0[2], p0[3], p1[1]); a_ = max3f(a_, p1[2], p1[3]);
#pragma unroll
      for (int r = 4; r < 16; r += 4) { a_ = max3f(a_, p0[r], p0[r + 1]); b_ = max3f(b_, p0[r + 2], p0[r + 3]); a_ = max3f(a_, p1[r], p1[r + 1]); b_ = max3f(b_, p1[r + 2], p1[r + 3]); }
      rm = max2f(a_, b_); }
    { auto rr = __builtin_amdgcn_permlane32_swap(__float_as_uint(rm), __float_as_uint(rm), false, false); rm = max2f(__uint_as_float(rr[0]), __uint_as_float(rr[1])); }
    if (diag || __any(rm > THR)) {
        const float dl = diag ? rm : fmaxf(rm, 0.f);
        st.mhat += dl;
#pragma unroll
        for (int r = 0; r < 16; ++r) { p0[r] -= dl; p1[r] -= dl; }
        if (!diag) {
            const float f = __builtin_amdgcn_exp2f(-dl); st.l_reg *= f;
            if (hi == 0) wsf[r32] = f;
            asm volatile("s_waitcnt lgkmcnt(0)" ::: "memory");
            float fr_[16];
#pragma unroll
            for (int r = 0; r < 16; ++r) fr_[r] = wsf[crow(r, hi)];
#pragma unroll
            for (int d = 0; d < 4; ++d)
#pragma unroll
                for (int r = 0; r < 16; ++r) st.o[d][r] *= fr_[r];
        }
    }
    float sacc = 0.f;
#pragma unroll
    for (int r = 0; r < 16; ++r) { p0[r] = __builtin_amdgcn_exp2f(p0[r]); p1[r] = __builtin_amdgcn_exp2f(p1[r]); sacc += p0[r] + p1[r]; }
    st.l_reg += sacc;
    st.pw0 = (u32x4){cvtpk_s(p0[0], p0[1]), cvtpk_s(p0[2], p0[3]), cvtpk_s(p0[4], p0[5]), cvtpk_s(p0[6], p0[7])};
    st.pw1 = (u32x4){cvtpk_s(p0[8], p0[9]), cvtpk_s(p0[10], p0[11]), cvtpk_s(p0[12], p0[13]), cvtpk_s(p0[14], p0[15])};
    st.pw2 = (u32x4){cvtpk_s(p1[0], p1[1]), cvtpk_s(p1[2], p1[3]), cvtpk_s(p1[4], p1[5]), cvtpk_s(p1[6], p1[7])};
    st.pw3 = (u32x4){cvtpk_s(p1[8], p1[9]), cvtpk_s(p1[10], p1[11]), cvtpk_s(p1[12], p1[13]), cvtpk_s(p1[14], p1[15])};
}
__device__ __forceinline__ void att_pv(WaveState& st, lds_cptr vb, const int (&vof)[4][2]) {
    s16x4 alo[4], ahi[4], blo[4], bhi[4];
#define ATT_RD(LO, HI, db) do { _Pragma("unroll") for (int ks = 0; ks < 4; ++ks) { LO[ks] = vtr(vb + vof[db][0] + ks * 4096); HI[ks] = vtr(vb + vof[db][1] + ks * 4096); } } while (0)
#define ATT_PK(LO, HI, k) (bf16x8){LO[k][0], LO[k][1], LO[k][2], LO[k][3], HI[k][0], HI[k][1], HI[k][2], HI[k][3]}
#define ATT_MM(LO, HI, db) do { \
        st.o[db] = __builtin_amdgcn_mfma_f32_32x32x16_bf16(__builtin_bit_cast(bf16x8, st.pw0), ATT_PK(LO, HI, 0), st.o[db], 0, 0, 0); \
        st.o[db] = __builtin_amdgcn_mfma_f32_32x32x16_bf16(__builtin_bit_cast(bf16x8, st.pw1), ATT_PK(LO, HI, 1), st.o[db], 0, 0, 0); \
        st.o[db] = __builtin_amdgcn_mfma_f32_32x32x16_bf16(__builtin_bit_cast(bf16x8, st.pw2), ATT_PK(LO, HI, 2), st.o[db], 0, 0, 0); \
        st.o[db] = __builtin_amdgcn_mfma_f32_32x32x16_bf16(__builtin_bit_cast(bf16x8, st.pw3), ATT_PK(LO, HI, 3), st.o[db], 0, 0, 0); } while (0)
    ATT_RD(alo, ahi, 0); ATT_RD(blo, bhi, 1); __builtin_amdgcn_sched_barrier(0);
    ATT_MM(alo, ahi, 0); __builtin_amdgcn_sched_barrier(0);
    ATT_RD(alo, ahi, 2); __builtin_amdgcn_sched_barrier(0);
    ATT_MM(blo, bhi, 1); __builtin_amdgcn_sched_barrier(0);
    ATT_RD(blo, bhi, 3); __builtin_amdgcn_sched_barrier(0);
    ATT_MM(alo, ahi, 2); __builtin_amdgcn_sched_barrier(0);
    ATT_MM(blo, bhi, 3);
#undef ATT_RD
#undef ATT_PK
#undef ATT_MM
}

template <int VAR>
__device__ __forceinline__ void attn_unit(int h, int qb, int t_lo, const Tensors& T, lds_ptr shm) {
    typedef __hip_bfloat16 bf16;
    const int tid = threadIdx.x, lane = tid & 63, r32 = lane & 31, hi = lane >> 5; const int wid = __builtin_amdgcn_readfirstlane(tid >> 6);
    const int rb = wid & 3, mp = wid >> 2;
    const int q0 = qb * 128 + rb * 32;
    const int cw = q0 >> 6;
    const int NT = 2 * qb + 2;
    const bf16* Qw = T.proj + (size_t)q0 * PITCH + COL_Q + h * 128 + mp * 64;
    const bf16* Kh = T.proj + COL_K + h * 128; const bf16* Vh = T.proj + COL_V + h * 128;
    const unsigned lds0 = (unsigned)(uintptr_t)shm;
    __attribute__((address_space(3))) float* wsf = (__attribute__((address_space(3))) float*)(shm + L_WS + wid * 256);
    const int prow = wid * 4 + (lane >> 4), pch = (lane & 15) ^ (((lane >> 4) << 2) | (wid & 3));
    const bf16* ksrc0 = Kh + (size_t)prow * PITCH + pch * 8;
    const bf16* ksrc1 = ksrc0 + (size_t)32 * PITCH;
    const bf16* vsrc0 = Vh + (size_t)prow * PITCH + pch * 8;
    const bf16* vsrc1 = vsrc0 + (size_t)32 * PITCH;
    const unsigned kdst = lds0 + L_K + wid * 1024, vdst = lds0 + L_V + wid * 1024;
#define ATT_DMA(t, ks, vs) do { const size_t toff_ = (size_t)(t) * 64 * PITCH; const unsigned ko_ = (unsigned)(ks) * SLOT, vo_ = (unsigned)(vs) * SLOT; \
        glds16(ksrc0 + toff_, (unsigned)__builtin_amdgcn_readfirstlane(kdst + ko_)); glds16(ksrc1 + toff_, (unsigned)__builtin_amdgcn_readfirstlane(kdst + ko_ + 8192)); \
        glds16(vsrc0 + toff_, (unsigned)__builtin_amdgcn_readfirstlane(vdst + vo_)); glds16(vsrc1 + toff_, (unsigned)__builtin_amdgcn_readfirstlane(vdst + vo_ + 8192)); } while (0)
    const int n_t = NT - t_lo;
    if (VAR != 1) { ATT_DMA(NT - 1, 0, 0);
    if (n_t > 1) ATT_DMA(NT - 2, 1, 1); }
    bf16x8 qr[4];
#pragma unroll
    for (int d0 = 0; d0 < 4; ++d0) qr[d0] = *reinterpret_cast<const bf16x8*>(&Qw[(size_t)r32 * PITCH + d0 * 16 + hi * 8]);
    const float slope2 = exp2f(-(float)(h + 1)) * LOG2E;
    float cst[16];
#pragma unroll
    for (int r = 0; r < 16; ++r) cst[r] = slope2 * (float)((r & 3) + 8 * (r >> 2));
    WaveState st; st.mhat = 0.f; st.l_reg = 0.f;
#pragma unroll
    for (int d = 0; d < 4; ++d) st.o[d] = f32x16{};
    st.pw0 = st.pw1 = st.pw2 = st.pw3 = (u32x4){0u, 0u, 0u, 0u};
    int kof[4], vof[4][2];
    { const int xr = ((r32 & 3) << 2) | ((r32 >> 2) & 3);
#pragma unroll
      for (int d0 = 0; d0 < 4; ++d0) kof[d0] = 256 * r32 + 16 * ((8 * mp + 2 * d0 + hi) ^ xr);
      const int q_ = (lane & 15) >> 2, p_ = lane & 3, blk = (lane >> 4) & 1;
#pragma unroll
      for (int c = 0; c < 4; ++c)
#pragma unroll
          for (int t_ = 0; t_ < 2; ++t_) { const int row = 8 * t_ + 4 * hi + q_; const int xv = ((row & 3) << 2) | ((row >> 2) & 3);
              vof[c][t_] = 256 * row + 16 * ((4 * c + 2 * blk + (p_ >> 1)) ^ xv) + 8 * (p_ & 1); } }
    const lds_cptr kb0 = (lds_cptr)shm + L_K; const lds_cptr vb0 = (lds_cptr)shm + L_V;
    const int qpos = q0 + r32;
    bool pend = false; int pend_vs = 0;
#pragma unroll 1
    for (int j = 0; j < n_t; ++j) {
        const int t = NT - 1 - j, sl = j & 3;
        if (j + 1 < n_t) asm volatile("s_waitcnt vmcnt(4)" ::: "memory"); else asm volatile("s_waitcnt vmcnt(0)" ::: "memory");
        __builtin_amdgcn_s_barrier(); asm volatile("" ::: "memory");
        if (VAR != 1 && j + 2 < n_t) ATT_DMA(t - 2, (j + 2) & 3, (j + 2) & 3);
        const bool act = (t <= cw);
        if (VAR != 2 && VAR != 3) { if (pend) att_pv(st, vb0 + pend_vs * SLOT, vof); }
        if (VAR != 2 && VAR != 4) { if (act) att_qksm(st, qr, kb0 + sl * SLOT, kof, wsf, cst, slope2, qpos, t, t == cw, r32, hi); }
        if (VAR != 2 && VAR != 3) { if (act && mp == 0) att_pv(st, vb0 + sl * SLOT, vof); }
        pend = act && (mp == 1); pend_vs = sl;
        asm volatile("s_waitcnt lgkmcnt(0)" ::: "memory");
    }
#undef ATT_DMA
    if (VAR != 2 && VAR != 3) { if (pend) att_pv(st, vb0 + pend_vs * SLOT, vof); }
    asm volatile("s_waitcnt lgkmcnt(0)" ::: "memory"); __builtin_amdgcn_s_barrier(); asm volatile("" ::: "memory");
    float l_reg = st.l_reg; f32x16 (&o)[4] = st.o;
    l_reg += xhalf(l_reg);
    if (hi == 0) wsf[32 + r32] = l_reg;
    asm volatile("s_waitcnt lgkmcnt(0)" ::: "memory");
    float rli[16];
#pragma unroll
    for (int r = 0; r < 16; ++r) rli[r] = 1.0f / wsf[32 + crow(r, hi)];
    __attribute__((address_space(3))) float* X = (__attribute__((address_space(3))) float*)(shm + L_X + rb * XSTRIDE);
    if (mp == 1) {
#pragma unroll
        for (int d = 0; d < 4; ++d)
#pragma unroll
            for (int r = 0; r < 16; ++r) X[(d * 16 + r) * 64 + lane] = o[d][r] * rli[r];
    }
    asm volatile("s_waitcnt lgkmcnt(0)" ::: "memory"); __builtin_amdgcn_s_barrier(); asm volatile("" ::: "memory");
    if (mp == 0) {
        const float lam = T.lam;
#pragma unroll
        for (int d = 0; d < 4; ++d)
#pragma unroll
            for (int r = 0; r < 16; ++r) o[d][r] = o[d][r] * rli[r] - lam * X[(d * 16 + r) * 64 + lane];
        asm volatile("s_waitcnt lgkmcnt(0)" ::: "memory");
#pragma unroll
        for (int d = 0; d < 4; ++d)
#pragma unroll
            for (int r = 0; r < 16; ++r) X[crow(r, hi) * 132 + d * 32 + r32] = o[d][r];
        asm volatile("s_waitcnt lgkmcnt(0)" ::: "memory");
        f32x4 v[16]; float ss = 0.f;
#pragma unroll
        for (int i = 0; i < 16; ++i) { v[i] = *(const __attribute__((address_space(3))) f32x4*)(X + r32 * 132 + hi * 64 + 4 * i); ss += (v[i].x * v[i].x + v[i].y * v[i].y) + (v[i].z * v[i].z + v[i].w * v[i].w); }
        ss += xhalf(ss);
        const float rstd = 0.8f / sqrtf(ss * (1.0f / 128.0f) + 1e-5f);
        bf16* Ow = T.ycat + (size_t)(q0 + r32) * 2048 + h * 128 + hi * 64;
        const float* gs = T.g_subln + hi * 64;
#pragma unroll
        for (int i = 0; i < 8; ++i) {
            const f32x4 g0 = *(const f32x4*)(gs + 8 * i), g1 = *(const f32x4*)(gs + 8 * i + 4); const f32x4 a = v[2 * i] * rstd * g0, b = v[2 * i + 1] * rstd * g1;
            u32x4 w; w.x = cvtpk_s(a.x, a.y); w.y = cvtpk_s(a.z, a.w); w.z = cvtpk_s(b.x, b.y); w.w = cvtpk_s(b.z, b.w);
            *(u32x4*)(Ow + 8 * i) = w;
        }
    }
    asm volatile("s_waitcnt lgkmcnt(0)" ::: "memory"); __builtin_amdgcn_s_barrier(); asm volatile("" ::: "memory");
}
}

constexpr int NWAVES = 8;
constexpr int SEQ = 16384, DM = 2048, NPROJ = 6144, NHEAD = 8, NEXP = 32, DEXP = 512, CAP = 16384;
constexpr float NORM_EPS = 1e-6f;
#ifndef MK_N_LAUNCHES
#define MK_N_LAUNCHES 1
#endif
constexpr int N_PHASES = 9;
constexpr int N_LAUNCHES = MK_N_LAUNCHES;

constexpr size_t MiB = 1u << 20;
constexpr size_t WS_CTL = 0, CTL_ZERO_BYTES = 1 * MiB;
constexpr size_t WS_WRT = 1 * MiB;
constexpr size_t WS_GATES = 2 * MiB;
constexpr size_t WS_LIST = 3 * MiB;
constexpr size_t WS_WIN = 6 * MiB;
constexpr size_t WS_WOUT = 30 * MiB;
constexpr size_t WS_W1 = 38 * MiB;
constexpr size_t WS_W2 = 166 * MiB;
constexpr size_t WS_B = 230 * MiB;
constexpr size_t WS_A = 294 * MiB;
constexpr size_t WS_END = 490 * MiB;
constexpr int CW_BAR = 4096;
constexpr int CW_NMAX = 8448;
constexpr int CW_QUEUE = 8704;
constexpr int CW_CNT = 8192;
constexpr int CW_MOD = 16384;

constexpr int RING_OFF = 0, RING_BYTES = 131072;
constexpr int LDSCTL_OFF = RING_BYTES;
constexpr int LDS_BYTES = 147456;
constexpr int LT_PRE = LDSCTL_OFF + 256, LT_CNT = LT_PRE + 34 * 4;

#define GAS __attribute__((address_space(1)))
#define LAS __attribute__((address_space(3)))
typedef unsigned short bf16;
typedef unsigned v4u __attribute__((ext_vector_type(4)));
typedef unsigned v2u __attribute__((ext_vector_type(2)));
typedef float f32x4 __attribute__((ext_vector_type(4)));
typedef GAS unsigned gu32;
#define RLX_AGENT __ATOMIC_RELAXED, __HIP_MEMORY_SCOPE_AGENT
#define LDS_WAIT() asm volatile("s_waitcnt lgkmcnt(0)" ::: "memory")
#define VM_WAIT() asm volatile("s_waitcnt vmcnt(0)" ::: "memory")
__device__ __forceinline__ unsigned f2bf(float f) { unsigned u = __builtin_bit_cast(unsigned, f); return (u + 0x7fffu + ((u >> 16) & 1u)) >> 16; }
__device__ __forceinline__ unsigned pk2(float lo, float hi) { return f2bf(lo) | (f2bf(hi) << 16); }
__device__ __forceinline__ float bf_lo(unsigned w) { return __builtin_bit_cast(float, w << 16); }
__device__ __forceinline__ float bf_hi(unsigned w) { return __builtin_bit_cast(float, w & 0xffff0000u); }

#define XB_TMO      128
#define XB_XCNT(j)  (256  + 64 * (j))
#define XB_XSUB(j)  (1280 + 64 * (j))
#define XB_XGEN(j)  (2304 + 64 * (j))
#define XB_TOP      3328
#define XB_TOPGEN   3392
#define XCD_BAR_WORDS 3456
#define XB_SPIN_CAP (1u << 18)

__device__ __forceinline__ unsigned xb_ld(unsigned* p)              { return __hip_atomic_load(p, __ATOMIC_RELAXED, __HIP_MEMORY_SCOPE_AGENT); }
__device__ __forceinline__ unsigned xb_add(unsigned* p, unsigned v) { return __hip_atomic_fetch_add(p, v, __ATOMIC_RELAXED, __HIP_MEMORY_SCOPE_AGENT); }
__device__ __forceinline__ unsigned xb_xcc_id() { return (unsigned)__builtin_amdgcn_s_getreg((3 << 11) | 20) & 0xFu; }
#define XB_SPIN(cond, bar) do { unsigned _sp = 0; while (cond) { __builtin_amdgcn_s_sleep(1); \
    if ((++_sp & 255u) == 0u) { if (xb_ld(&(bar)[XB_TMO])) break; if (_sp > XB_SPIN_CAP) { atomicAdd(&(bar)[XB_TMO], 1u); break; } } } } while (0)

struct XcdBarrier {
    unsigned* bar; unsigned x;
    volatile LAS unsigned* st;
};

__device__ __forceinline__ XcdBarrier xcd_barrier_post(unsigned* bar, volatile LAS unsigned* st) {
    XcdBarrier b; b.bar = bar; b.x = xb_xcc_id(); b.st = st;
    if (threadIdx.x == 0) (void)xb_add(&bar[XB_XCNT(b.x)], 1u);
    return b;
}
__device__ __forceinline__ void xcd_barrier_complete(unsigned* bar, unsigned x, unsigned& nloc, unsigned& nx) {
    const unsigned G = gridDim.x * gridDim.y * gridDim.z;
    unsigned sum, cnt, mine, sp = 0u;
    for (;;) {
        sum = 0u; cnt = 0u; mine = 0u;
#pragma unroll
        for (unsigned j = 0; j < 16; ++j) { const unsigned c = xb_ld(&bar[XB_XCNT(j)]); sum += c; cnt += (c > 0u) ? 1u : 0u; mine = (j == x) ? c : mine; }
        if (sum == G) break;
        __builtin_amdgcn_s_sleep(1);
        if ((++sp & 255u) == 0u) { if (xb_ld(&bar[XB_TMO])) break; if (sp > XB_SPIN_CAP) { atomicAdd(&bar[XB_TMO], 1u); break; } }
    }
    nloc = mine > 0u ? mine : 1u; nx = cnt > 0u ? cnt : 1u;
}

__device__ __forceinline__ void xcd_barrier(const XcdBarrier& b) {
    asm volatile("s_waitcnt vmcnt(0)" ::: "memory");
    __syncthreads();
    if (threadIdx.x == 0) {
        unsigned* bar = b.bar;
        __builtin_amdgcn_s_waitcnt(0);
        unsigned nloc = b.st[0], nx = b.st[1];
        if (nloc == 0u) { xcd_barrier_complete(bar, b.x, nloc, nx); b.st[0] = nloc; b.st[1] = nx; }
        const unsigned old = xb_add(&bar[XB_XSUB(b.x)], 1u);
        const unsigned gen = old / nloc;
        if (old + 1u == (gen + 1u) * nloc) {
            __builtin_amdgcn_fence(__ATOMIC_RELEASE, "agent");
            asm volatile("s_waitcnt vmcnt(0)" ::: "memory");
            const unsigned og = xb_add(&bar[XB_TOP], 1u);
            const unsigned tg = og / nx;
            if (og + 1u == (tg + 1u) * nx) xb_add(&bar[XB_TOPGEN], 1u);
            else XB_SPIN(xb_ld(&bar[XB_TOPGEN]) == tg, bar);
            __builtin_amdgcn_fence(__ATOMIC_ACQUIRE, "agent");
            xb_add(&bar[XB_XGEN(b.x)], 1u);
            asm volatile("s_waitcnt vmcnt(0)" ::: "memory");
        } else {
            XB_SPIN(xb_ld(&bar[XB_XGEN(b.x)]) == gen, bar);
            __builtin_amdgcn_fence(__ATOMIC_ACQUIRE, "agent");
            asm volatile("s_waitcnt vmcnt(0)" ::: "memory");
        }
    }
    __syncthreads();
}

struct Frame {
    LAS unsigned char* lds;
    gu32* ctl;
    int tid, lane, wave;
    int vcu, G;
    const float* in[23]; float* out; unsigned char* ws;
};
enum { I_X = 0, I_C, I_WADA, I_BADA, I_GPRE1, I_WIN, I_LQ1, I_LK1, I_LQ2, I_LK2, I_GSUB, I_WCONV, I_WOUT, I_GPOST1, I_GPRE2, I_WRG, I_BRG, I_WRE, I_BRE, I_WGATE, I_WUP, I_WDOWN, I_GPOST2 };

__device__ __forceinline__ float wave_sum(float v) {
#pragma unroll
    for (int o = 1; o < 64; o <<= 1) v += __shfl_xor(v, o);
    return v;
}
__device__ __forceinline__ float modval(const Frame& F, int n) {
    const long long a = ((const long long*)(F.ctl + CW_MOD))[n];
    return F.in[I_BADA][n] + (float)a * 9.094947017729282e-13f;
}

__device__ __forceinline__ void p0_transpose_item(const float* W, int K, int N, bf16* WT, int k0, int n0, int dst_row0, LAS float* scr, int lane) {
#pragma unroll 8
    for (int i = 0; i < 32; ++i) { const int kk = 2 * i + (lane >> 5); scr[kk * 33 + (lane & 31)] = W[(size_t)(k0 + kk) * N + n0 + (lane & 31)]; }
    LDS_WAIT(); asm volatile("" ::: "memory");
    const int c = lane & 7;
#pragma unroll
    for (int j = 0; j < 4; ++j) { const int n = (lane >> 3) + 8 * j; const LAS float* s = scr + (8 * c) * 33 + n;
        v4u o; o.x = pk2(s[0 * 33], s[1 * 33]); o.y = pk2(s[2 * 33], s[3 * 33]); o.z = pk2(s[4 * 33], s[5 * 33]); o.w = pk2(s[6 * 33], s[7 * 33]);
        *(GAS v4u*)(WT + (size_t)(dst_row0 + n) * K + k0 + 8 * c) = o; }
    LDS_WAIT(); asm volatile("" ::: "memory");
}

__device__ __forceinline__ void p0_prologue(Frame& F) {
    const int gw = F.vcu * NWAVES + F.wave, NGW = F.G * NWAVES;
    {
        const float* c = F.in[I_C]; const float* W = F.in[I_WADA];
        unsigned long long* acc = (unsigned long long*)(F.ctl + CW_MOD);
        for (int it = gw; it < 48 * 32; it += NGW) {
            const int cg = it % 48, ks = it / 48, k0 = ks * 64, col = cg * 256 + F.lane * 4;
            f32x4 a = {0.f, 0.f, 0.f, 0.f};
#pragma unroll 8
            for (int kk = 0; kk < 64; ++kk) { const float cv = c[k0 + kk]; const float s = cv / (1.0f + __expf(-cv)); const f32x4 w = *(const f32x4*)(W + (size_t)(k0 + kk) * 12288 + col); a += w * s; }
#pragma unroll
            for (int i = 0; i < 4; ++i) { const long long q = __float2ll_rn(a[i] * 1099511627776.0f); atomicAdd(acc + col + i, (unsigned long long)q); }
        }
    }
    {
        float* WrT = (float*)(F.ws + WS_WRT);
        for (int idx = blockIdx.x * 512 + F.tid; idx < 36 * 2048; idx += F.G * 512) { const int j = idx >> 11, k = idx & 2047;
            WrT[idx] = (j < 4) ? F.in[I_WRG][k * 4 + j] : F.in[I_WRE][k * 32 + (j - 4)]; }
    }
    LAS float* scr = (LAS float*)(F.lds + RING_OFF + F.wave * 16384);
    constexpr int I_IN = 32 * 192, I_OUT = 32 * 64, I_G = 32 * 32 * 16, I_D = 32 * 8 * 64;
    constexpr int NITEMS = I_IN + I_OUT + 2 * I_G + I_D;
    for (int it = gw; it < NITEMS; it += NGW) {
        int r = it;
        if (r < I_IN) { const int kb = r / 192, nb = r % 192; p0_transpose_item(F.in[I_WIN], 2048, 6144, (bf16*)(F.ws + WS_WIN), 64 * kb, 32 * nb, 32 * nb, scr, F.lane); continue; } r -= I_IN;
        if (r < I_OUT) { const int kb = r / 64, nb = r % 64; p0_transpose_item(F.in[I_WOUT], 2048, 2048, (bf16*)(F.ws + WS_WOUT), 64 * kb, 32 * nb, 32 * nb, scr, F.lane); continue; } r -= I_OUT;
        if (r < 2 * I_G) { const int up = r / I_G; r -= up * I_G; const int e = r / 512, q = r % 512, kb = q / 16, nb = q % 16, n0 = 32 * nb;
            p0_transpose_item(F.in[up ? I_WUP : I_WGATE] + (size_t)e * 2048 * 512, 2048, 512, (bf16*)(F.ws + WS_W1), 64 * kb, n0, e * 1024 + (n0 >> 7) * 256 + up * 128 + (n0 & 127), scr, F.lane); continue; } r -= 2 * I_G;
        { const int e = r / 512, q = r % 512, kb = q / 64, nb = q % 64;
            p0_transpose_item(F.in[I_WDOWN] + (size_t)e * 512 * 2048, 512, 2048, (bf16*)(F.ws + WS_W2), 64 * kb, 32 * nb, e * 2048 + 32 * nb, scr, F.lane); }
    }
}

__device__ __forceinline__ void p1_norm(Frame& F) {
    LAS float* tA = (LAS float*)(F.lds + RING_OFF); LAS float* tB = tA + 2048;
    for (int i = F.tid; i < 2048; i += 512) { tA[i] = F.in[I_GPRE1][i] * (1.0f + modval(F, 2048 + i)); tB[i] = modval(F, i); }
    __syncthreads();
    const int gw = F.vcu * NWAVES + F.wave, NGW = F.G * NWAVES;
    bf16* H1 = (bf16*)(F.ws + WS_B);
    for (int m = gw; m < SEQ; m += NGW) {
        const GAS f32x4* xr = (const GAS f32x4*)(F.in[I_X] + (size_t)m * DM) + F.lane;
        f32x4 v[8]; float s = 0.f;
#pragma unroll
        for (int j = 0; j < 8; ++j) { v[j] = xr[64 * j]; s += (v[j].x * v[j].x + v[j].y * v[j].y) + (v[j].z * v[j].z + v[j].w * v[j].w); }
        const float rstd = 1.0f / sqrtf(wave_sum(s) * (1.0f / DM) + NORM_EPS);
        GAS v2u* o8 = (GAS v2u*)(H1 + (size_t)m * DM) + F.lane;
#pragma unroll
        for (int j = 0; j < 8; ++j) { const f32x4 a = *(const LAS f32x4*)(tA + 256 * j + 4 * F.lane), b = *(const LAS f32x4*)(tB + 256 * j + 4 * F.lane); const f32x4 h = v[j] * rstd * a + b;
            v2u w; w.x = pk2(h.x, h.y); w.y = pk2(h.z, h.w); o8[64 * j] = w; }
    }
    __syncthreads();
}

__device__ __forceinline__ void p3_conv(Frame& F) {
    const int gw = F.vcu * NWAVES + F.wave, NGW = F.G * NWAVES;
    const bf16* P = (const bf16*)(F.ws + WS_A); bf16* Y = (bf16*)(F.ws + WS_B); const float* wc = F.in[I_WCONV];
    for (int it = gw; it < 2048; it += NGW) {
        const int t0 = (it >> 1) * 16, ch = (it & 1) * 512 + F.lane * 8;
        float w0[8], w1[8], w2[8], z1[8], z2[8];
#pragma unroll
        for (int i = 0; i < 8; ++i) { w0[i] = wc[ch + i]; w1[i] = wc[1024 + ch + i]; w2[i] = wc[2048 + ch + i]; z1[i] = 0.f; z2[i] = 0.f; }
        for (int t = t0 - 2; t < t0 + 16; ++t) {
            if (t < 0) continue;
            const bf16* row = P + (size_t)t * att::PITCH;
            const v4u cg = *(const GAS v4u*)(row + 4096 + ch), xu = *(const GAS v4u*)(row + 5120 + ch);
            float z[8];
#pragma unroll
            for (int i = 0; i < 4; ++i) { z[2 * i] = bf_lo(cg[i]) * bf_lo(xu[i]); z[2 * i + 1] = bf_hi(cg[i]) * bf_hi(xu[i]); }
            if (t >= t0) {
                const v4u bg = *(const GAS v4u*)(row + 3072 + ch); float y[8];
#pragma unroll
                for (int i = 0; i < 4; ++i) { y[2 * i] = bf_lo(bg[i]) * (w0[2 * i] * z2[2 * i] + w1[2 * i] * z1[2 * i] + w2[2 * i] * z[2 * i]);
                    y[2 * i + 1] = bf_hi(bg[i]) * (w0[2 * i + 1] * z2[2 * i + 1] + w1[2 * i + 1] * z1[2 * i + 1] + w2[2 * i + 1] * z[2 * i + 1]); }
                v4u o; o.x = pk2(y[0], y[1]); o.y = pk2(y[2], y[3]); o.z = pk2(y[4], y[5]); o.w = pk2(y[6], y[7]);
                *(GAS v4u*)(Y + (size_t)t * DM + 1024 + ch) = o;
            }
#pragma unroll
            for (int i = 0; i < 8; ++i) { z2[i] = z1[i]; z1[i] = z[i]; }
        }
    }
}

__device__ __forceinline__ void p5_post_route(Frame& F) {
    LAS float* tG = (LAS float*)(F.lds + RING_OFF); LAS float* tA = tG + 2048; LAS float* tS = tA + 2048;
    for (int i = F.tid; i < 2048; i += 512) { tG[i] = modval(F, 4096 + i) * F.in[I_GPOST1][i]; tA[i] = F.in[I_GPRE2][i] * (1.0f + modval(F, 8192 + i)); tS[i] = modval(F, 6144 + i); }
    __syncthreads();
    const int gw = F.vcu * NWAVES + F.wave, NGW = F.G * NWAVES;
    const bf16* Y1 = (const bf16*)(F.ws + WS_A); bf16* H2 = (bf16*)(F.ws + WS_A + 64 * MiB);
    const float* WrT = (const float*)(F.ws + WS_WRT);
    float* gates = (float*)(F.ws + WS_GATES); int* list = (int*)(F.ws + WS_LIST); unsigned* cnt = (unsigned*)(F.ctl + CW_CNT);
    for (int b = gw; b < SEQ / 4; b += NGW) {
        f32x4 hv[4][8];
#pragma unroll
        for (int r = 0; r < 4; ++r) {
            const int m = 4 * b + r;
            const GAS f32x4* xr = (const GAS f32x4*)(F.in[I_X] + (size_t)m * DM) + F.lane;
            const GAS v2u* yr = (const GAS v2u*)(Y1 + (size_t)m * DM) + F.lane;
            f32x4 xv[8]; v2u yp[8]; float s1 = 0.f;
#pragma unroll
            for (int j = 0; j < 8; ++j) { xv[j] = xr[64 * j]; yp[j] = yr[64 * j]; const f32x4 y = (f32x4){bf_lo(yp[j].x), bf_hi(yp[j].x), bf_lo(yp[j].y), bf_hi(yp[j].y)};
                s1 += (y.x * y.x + y.y * y.y) + (y.z * y.z + y.w * y.w); }
            const float r1 = 1.0f / sqrtf(wave_sum(s1) * (1.0f / DM) + NORM_EPS);
            GAS f32x4* orow = (GAS f32x4*)(F.out + (size_t)m * DM) + F.lane; float s2 = 0.f;
#pragma unroll
            for (int j = 0; j < 8; ++j) { const f32x4 g = *(const LAS f32x4*)(tG + 256 * j + 4 * F.lane); const f32x4 y = (f32x4){bf_lo(yp[j].x), bf_hi(yp[j].x), bf_lo(yp[j].y), bf_hi(yp[j].y)};
                xv[j] = xv[j] + y * r1 * g; orow[64 * j] = xv[j];
                s2 += (xv[j].x * xv[j].x + xv[j].y * xv[j].y) + (xv[j].z * xv[j].z + xv[j].w * xv[j].w); }
            const float r2 = 1.0f / sqrtf(wave_sum(s2) * (1.0f / DM) + NORM_EPS);
            GAS v2u* h8 = (GAS v2u*)(H2 + (size_t)m * DM) + F.lane;
#pragma unroll
            for (int j = 0; j < 8; ++j) { const f32x4 a = *(const LAS f32x4*)(tA + 256 * j + 4 * F.lane), s = *(const LAS f32x4*)(tS + 256 * j + 4 * F.lane); const f32x4 h = xv[j] * r2 * a + s; hv[r][j] = h;
                v2u w; w.x = pk2(h.x, h.y); w.y = pk2(h.z, h.w); h8[64 * j] = w; }
            __builtin_amdgcn_sched_barrier(0);
        }
        LAS float* lg = (LAS float*)(F.lds + RING_OFF + 32768 + F.wave * 1024);
#pragma unroll 1
        for (int j = 0; j < 36; ++j) {
            const GAS f32x4* wr_ = (const GAS f32x4*)(WrT + (size_t)j * DM) + F.lane;
            float a0 = 0.f, a1 = 0.f, a2 = 0.f, a3 = 0.f;
#pragma unroll
            for (int q = 0; q < 8; ++q) { const f32x4 w = wr_[64 * q];
                a0 += (hv[0][q].x * w.x + hv[0][q].y * w.y) + (hv[0][q].z * w.z + hv[0][q].w * w.w);
                a1 += (hv[1][q].x * w.x + hv[1][q].y * w.y) + (hv[1][q].z * w.z + hv[1][q].w * w.w);
                a2 += (hv[2][q].x * w.x + hv[2][q].y * w.y) + (hv[2][q].z * w.z + hv[2][q].w * w.w);
                a3 += (hv[3][q].x * w.x + hv[3][q].y * w.y) + (hv[3][q].z * w.z + hv[3][q].w * w.w); }
            a0 = wave_sum(a0); a1 = wave_sum(a1); a2 = wave_sum(a2); a3 = wave_sum(a3);
            if (F.lane == 0) { lg[j] = a0; lg[36 + j] = a1; lg[72 + j] = a2; lg[108 + j] = a3; }
        }
        LDS_WAIT();
        if (F.lane < 4) {
            const int m = 4 * b + F.lane;
            const LAS float* mine = lg + 36 * F.lane;
            float gl[4]; int gi = 0; float gm;
#pragma unroll
            for (int g = 0; g < 4; ++g) gl[g] = mine[g] + F.in[I_BRG][g];
            gm = gl[0];
#pragma unroll
            for (int g = 1; g < 4; ++g) if (gl[g] > gm) { gm = gl[g]; gi = g; }
            float gs = 0.f;
#pragma unroll
            for (int g = 0; g < 4; ++g) gs += __expf(gl[g] - gm);
            const float gwt = 1.0f / gs;
            float el[8];
#pragma unroll
            for (int e = 0; e < 8; ++e) el[e] = mine[4 + gi * 8 + e] + F.in[I_BRE][gi * 8 + e];
            int i1 = 0; float l1 = el[0];
#pragma unroll
            for (int e = 1; e < 8; ++e) if (el[e] > l1) { l1 = el[e]; i1 = e; }
            int i2 = -1; float l2 = -INFINITY;
#pragma unroll
            for (int e = 0; e < 8; ++e) if (e != i1 && el[e] > l2) { l2 = el[e]; i2 = e; }
            const float w1 = 1.0f / (1.0f + __expf(l2 - l1)), w2 = 1.0f - w1;
            const int e1 = gi * 8 + i1, e2 = gi * 8 + i2;
            const unsigned p1 = atomicAdd(cnt + e1, 1u), p2 = atomicAdd(cnt + e2, 1u);
            list[e1 * CAP + (int)p1] = 2 * m; list[e2 * CAP + (int)p2] = 2 * m + 1;
            gates[2 * m] = gwt * w1; gates[2 * m + 1] = gwt * w2;
        }
    }
    __syncthreads();
}

__device__ __forceinline__ void p8_final(Frame& F) {
    LAS float* tG = (LAS float*)(F.lds + RING_OFF);
    for (int i = F.tid; i < 2048; i += 512) tG[i] = modval(F, 10240 + i) * F.in[I_GPOST2][i];
    __syncthreads();
    const int gw = F.vcu * NWAVES + F.wave, NGW = F.G * NWAVES;
    const bf16* Y2 = (const bf16*)(F.ws + WS_A);
    for (int m = gw; m < SEQ; m += NGW) {
        GAS f32x4* xr = (GAS f32x4*)(F.out + (size_t)m * DM) + F.lane;
        const GAS v2u* ya = (const GAS v2u*)(Y2 + (size_t)(2 * m) * DM) + F.lane; const GAS v2u* yb = (const GAS v2u*)(Y2 + (size_t)(2 * m + 1) * DM) + F.lane;
        f32x4 xv[8], yv[8]; float s = 0.f;
#pragma unroll
        for (int j = 0; j < 8; ++j) { xv[j] = xr[64 * j]; const v2u a = ya[64 * j], b = yb[64 * j];
            yv[j] = (f32x4){bf_lo(a.x) + bf_lo(b.x), bf_hi(a.x) + bf_hi(b.x), bf_lo(a.y) + bf_lo(b.y), bf_hi(a.y) + bf_hi(b.y)};
            s += (yv[j].x * yv[j].x + yv[j].y * yv[j].y) + (yv[j].z * yv[j].z + yv[j].w * yv[j].w); }
        const float rstd = 1.0f / sqrtf(wave_sum(s) * (1.0f / DM) + NORM_EPS);
#pragma unroll
        for (int j = 0; j < 8; ++j) { const f32x4 g = *(const LAS f32x4*)(tG + 256 * j + 4 * F.lane); xr[64 * j] = xv[j] + yv[j] * rstd * g; }
    }
}

template <int NPN, bool TOKEN_ROWS>
struct MoeOrder {
    static constexpr bool GATHER = true;
    const LAS int* pre; const LAS int* cntl; const int* list; int G, c;
    __device__ __forceinline__ bool next(int i, pg8::Unit& u) const {
        const int L = i * G + c; const int total = __builtin_amdgcn_readfirstlane(pre[32]);
        if (L >= total * NPN) return false;
        const int rt = L / NPN, pnl = L % NPN;
        int e = 0;
#pragma unroll 1
        for (int k = 1; k < 32; ++k) if (pre[k] <= rt) e = k;
        e = __builtin_amdgcn_readfirstlane(e);
        u.pm = rt; u.e = e; u.row0 = __builtin_amdgcn_readfirstlane((rt - pre[e]) * 256); const int left = __builtin_amdgcn_readfirstlane(cntl[e]) - u.row0; u.nvalid = left < 256 ? left : 256; u.pn = e * NPN + pnl;
        return true;
    }
    __device__ __forceinline__ void rows(const pg8::Unit& u, const int (&RA)[2], const int (&CA)[2], int K, unsigned (&v)[2][2]) const {
#pragma unroll
        for (int h = 0; h < 2; ++h)
#pragma unroll
            for (int i = 0; i < 2; ++i) { const int r = h * 128 + RA[i]; const int ts = list[u.e * CAP + u.row0 + (r < u.nvalid ? r : 0)];
                const int srow = TOKEN_ROWS ? (ts >> 1) : ts; v[h][i] = (unsigned)((srow * K + CA[i]) * 2); }
    }
};
struct EpiSwiglu {
    static constexpr bool PERM = true;
    bf16* act; const int* list; const float* gates;
    __device__ __forceinline__ void operator()(const pg8::f32x4 (&acc)[2][2][4][2], const pg8::Unit& u, int wr, int wc, int fr, int fq) const {
        const int pnl = u.pn & 3; const int col0 = pnl * 128 + wc * 32 + 8 * fq;
#pragma unroll
        for (int ai = 0; ai < 2; ++ai)
#pragma unroll
            for (int m = 0; m < 4; ++m) { const int r = ai * 128 + wr * 64 + m * 16 + fr;
                if (r < u.nvalid) { const int ts = list[u.e * CAP + u.row0 + r]; const float gt = gates[ts];
                    float o[8];
#pragma unroll
                    for (int n = 0; n < 2; ++n)
#pragma unroll
                        for (int i = 0; i < 4; ++i) { const float g = acc[ai][0][m][n][i], up = acc[ai][1][m][n][i]; o[4 * n + i] = g / (1.0f + __expf(-g)) * up * gt; }
                    pg8::u32x4 w; w.x = pg8::cvt_pk_bf16(o[0], o[1]); w.y = pg8::cvt_pk_bf16(o[2], o[3]); w.z = pg8::cvt_pk_bf16(o[4], o[5]); w.w = pg8::cvt_pk_bf16(o[6], o[7]);
                    *(pg8::u32x4*)(act + (size_t)ts * DEXP + col0) = w; } }
    }
};
struct EpiDown {
    static constexpr bool PERM = true;
    bf16* y2; const int* list;
    __device__ __forceinline__ void operator()(const pg8::f32x4 (&acc)[2][2][4][2], const pg8::Unit& u, int wr, int wc, int fr, int fq) const {
        const int pnl = u.pn & 7; const int col0 = pnl * 256 + wc * 32 + 8 * fq;
#pragma unroll
        for (int ai = 0; ai < 2; ++ai)
#pragma unroll
            for (int m = 0; m < 4; ++m) { const int r = ai * 128 + wr * 64 + m * 16 + fr;
                if (r < u.nvalid) { const int ts = list[u.e * CAP + u.row0 + r]; bf16* rowp = y2 + (size_t)ts * DM + col0;
#pragma unroll
                    for (int bj = 0; bj < 2; ++bj) { const pg8::f32x4 v0 = acc[ai][bj][m][0], v1 = acc[ai][bj][m][1];
                        pg8::u32x4 w; w.x = pg8::cvt_pk_bf16(v0[0], v0[1]); w.y = pg8::cvt_pk_bf16(v0[2], v0[3]); w.z = pg8::cvt_pk_bf16(v1[0], v1[1]); w.w = pg8::cvt_pk_bf16(v1[2], v1[3]);
                        *(pg8::u32x4*)(rowp + bj * 128) = w; } } }
    }
};
__device__ __forceinline__ void moe_tables(Frame& F) {
    LAS int* pre = (LAS int*)(F.lds + LT_PRE); LAS int* cl = (LAS int*)(F.lds + LT_CNT);
    if (F.tid == 0) { int s = 0; const unsigned* cnt = (const unsigned*)(F.ctl + CW_CNT);
        for (int e = 0; e < 32; ++e) { int c = (int)cnt[e]; c = c < 0 ? 0 : (c > CAP ? CAP : c); cl[e] = c; pre[e] = s; s += (c + 255) >> 8; } pre[32] = s; }
    __syncthreads();
}

struct Args { const float* in[23]; float* out; unsigned char* ws; int ph_lo, ph_hi; };
__global__ void __launch_bounds__(NWAVES * 64, 2) mk_fwd(Args args) {
    extern __shared__ __attribute__((aligned(16))) unsigned char lds[];
    Frame F;
    F.lds = (LAS unsigned char*)lds;
    F.tid = threadIdx.x; F.lane = F.tid & 63; F.wave = __builtin_amdgcn_readfirstlane(F.tid >> 6);
    F.G = gridDim.x; { const int bx = blockIdx.x; F.vcu = (F.G % 8 == 0) ? (bx % 8) * (F.G / 8) + bx / 8 : bx; }
    F.ws = args.ws; F.ctl = (gu32*)(args.ws + WS_CTL); F.out = args.out;
#pragma unroll
    for (int i = 0; i < 23; ++i) F.in[i] = args.in[i];
    for (int u = F.tid; u < (LDS_BYTES - LDSCTL_OFF) / 4; u += NWAVES * 64) ((LAS unsigned*)(F.lds + LDSCTL_OFF))[u] = 0u;
    __syncthreads();
    XcdBarrier bar; bar.bar = (unsigned*)(F.ctl + CW_BAR); bar.x = 0; bar.st = nullptr;
    if (N_LAUNCHES == 1) bar = xcd_barrier_post((unsigned*)(F.ctl + CW_BAR), (volatile LAS unsigned*)(F.lds + LDSCTL_OFF));
    const int lo = args.ph_lo, hi = args.ph_hi;
#define IN(k) (lo <= (k) && (k) < hi)
#define SEAM(k) do { if (IN(k) && IN((k) + 1)) xcd_barrier(bar); } while (0)
#ifdef PROBE_PHASE
#define REP(k) ((k) == PROBE_PHASE ? 2 : 1)
#else
#define REP(k) 1
#endif

    if (IN(0)) { p0_prologue(F); } SEAM(0);
    if (IN(1)) { p1_norm(F); } SEAM(1);
    if (IN(2)) {
        pg8::Gemm g{(const pg8::bf16_t*)(F.ws + WS_B), (const pg8::bf16_t*)(F.ws + WS_WIN), SEQ, NPROJ, DM}; pg8::StaticOrder S; S.init(SEQ, NPROJ, F.G, (int)blockIdx.x);
        pg8::EpiBf16 E{(pg8::bf16_t*)(F.ws + WS_A), att::PITCH, 1024, att::QSCALE, (unsigned*)(F.ctl + CW_NMAX), 2048};
        pg8::gemm_phase<pg8::EpiBf16, pg8::StaticOrder, true>(F.lds + RING_OFF, g, S, E); if (REP(2) == 2) { pg8::gemm_phase<pg8::EpiBf16, pg8::StaticOrder, true>(F.lds + RING_OFF, g, S, E); }
    } SEAM(2);
    if (IN(3)) {
        p3_conv(F);
        float lam;
        { const float a = wave_sum(F.in[I_LQ1][F.lane] * F.in[I_LK1][F.lane]), b = wave_sum(F.in[I_LQ2][F.lane] * F.in[I_LK2][F.lane]); lam = __expf(a) - __expf(b) + 0.2f; }
        const att::Tensors T{(const __hip_bfloat16*)(F.ws + WS_A), (__hip_bfloat16*)(F.ws + WS_B), F.in[I_GSUB], lam};
        const unsigned* nmx = (const unsigned*)(F.ctl + CW_NMAX);
        LAS int* qslot = (LAS int*)(F.lds + LT_CNT + 256);
#define ATT_QUEUE(VARIANT, TT, QW) for (;;) { \
            if (F.tid == 0) qslot[0] = (int)atomicAdd((unsigned*)(F.ctl + CW_QUEUE) + (QW), 1u); \
            __syncthreads(); \
            const int ui = __builtin_amdgcn_readfirstlane(qslot[0]); \
            __syncthreads(); \
            if (ui >= 1024) break; \
            const int qb = 127 - (ui >> 3), h = ui & 7;             \
            float sm = 0.f; \
            _Pragma("unroll") for (int mp = 0; mp < 2; ++mp) { const float qn = __uint_as_float(nmx[4 * h + 2 * mp]) + __uint_as_float(nmx[4 * h + 2 * mp + 1]), kn = __uint_as_float(nmx[32 + 4 * h + 2 * mp]) + __uint_as_float(nmx[32 + 4 * h + 2 * mp + 1]); \
                sm = fmaxf(sm, sqrtf(qn * kn)); } \
            const float slope2 = exp2f(-(float)(h + 1)) * att::LOG2E; \
            const float D = (2.0f * 1.02f * sm + 152.0f) / slope2; \
            int t_lo = (int)ceilf(((float)(qb * 128 - 63) - D) * (1.0f / 64.0f)); t_lo = t_lo < 0 ? 0 : t_lo; \
            t_lo = __builtin_amdgcn_readfirstlane(t_lo); \
            att::attn_unit<VARIANT>(h, qb, t_lo, TT, (att::lds_ptr)(F.lds + RING_OFF)); }
        ATT_QUEUE(0, T, 0)
#ifdef PROBE_ATT
        { const att::Tensors T2{(const __hip_bfloat16*)(F.ws + WS_A), (__hip_bfloat16*)(F.ws + WS_END), F.in[I_GSUB], lam};
          ATT_QUEUE(PROBE_ATT, T2, 64) }
#endif
#undef ATT_QUEUE
    } SEAM(3);
    if (IN(4)) {
        pg8::Gemm g{(const pg8::bf16_t*)(F.ws + WS_B), (const pg8::bf16_t*)(F.ws + WS_WOUT), SEQ, DM, DM}; pg8::StaticOrder S; S.init(SEQ, DM, F.G, (int)blockIdx.x);
        pg8::EpiBf16 E{(pg8::bf16_t*)(F.ws + WS_A), DM, 0, 1.0f, nullptr, 0};
        pg8::gemm_phase<pg8::EpiBf16, pg8::StaticOrder, true>(F.lds + RING_OFF, g, S, E); if (REP(4) == 2) { pg8::gemm_phase<pg8::EpiBf16, pg8::StaticOrder, true>(F.lds + RING_OFF, g, S, E); }
    } SEAM(4);
    if (IN(5)) { p5_post_route(F); } SEAM(5);
    if (IN(6)) {
        moe_tables(F);
        pg8::Gemm g{(const pg8::bf16_t*)(F.ws + WS_A + 64 * MiB), (const pg8::bf16_t*)(F.ws + WS_W1), SEQ, 1024, DM};
        MoeOrder<4, true> S{(const LAS int*)(F.lds + LT_PRE), (const LAS int*)(F.lds + LT_CNT), (const int*)(F.ws + WS_LIST), F.G, F.vcu};
        EpiSwiglu E{(bf16*)(F.ws + WS_A + 128 * MiB), (const int*)(F.ws + WS_LIST), (const float*)(F.ws + WS_GATES)};
        pg8::gemm_phase<EpiSwiglu, MoeOrder<4, true>, true>(F.lds + RING_OFF, g, S, E); if (REP(6) == 2) { pg8::gemm_phase<EpiSwiglu, MoeOrder<4, true>, true>(F.lds + RING_OFF, g, S, E); }
    } SEAM(6);
    if (IN(7)) {
        moe_tables(F);
        pg8::Gemm g{(const pg8::bf16_t*)(F.ws + WS_A + 128 * MiB), (const pg8::bf16_t*)(F.ws + WS_W2), 2 * SEQ, DM, DEXP};
        MoeOrder<8, false> S{(const LAS int*)(F.lds + LT_PRE), (const LAS int*)(F.lds + LT_CNT), (const int*)(F.ws + WS_LIST), F.G, F.vcu};
        EpiDown E{(bf16*)(F.ws + WS_A), (const int*)(F.ws + WS_LIST)};
        pg8::gemm_phase<EpiDown, MoeOrder<8, false>, true>(F.lds + RING_OFF, g, S, E); if (REP(7) == 2) { pg8::gemm_phase<EpiDown, MoeOrder<8, false>, true>(F.lds + RING_OFF, g, S, E); }
    } SEAM(7);
    if (IN(8)) { p8_final(F); }
#undef IN
#undef SEAM
}

extern "C" void kernel_launch(void* const* d_in, const int* in_sizes, int n_in, void* d_out, int out_size, void* d_ws, size_t ws_size, hipStream_t stream) {
    static int grid = 0;
    if (grid == 0) {
        if (n_in != 23 || in_sizes[0] != SEQ * DM || out_size != SEQ * DM || ws_size < WS_END + 64 * MiB) { fprintf(stderr, "kernel_launch: shape/workspace mismatch (n_in %d, in0 %d, out %d, ws %zu < %zu); nothing launched\n", n_in, n_in > 0 ? in_sizes[0] : -1, out_size, ws_size, (size_t)WS_END); grid = -1; return; }
        int dev = 0, cus = 0, per_cu = 0;
        if (hipGetDevice(&dev) != hipSuccess || hipDeviceGetAttribute(&cus, hipDeviceAttributeMultiprocessorCount, dev) != hipSuccess) { fprintf(stderr, "kernel_launch: hipGetDevice / hipDeviceGetAttribute failed\n"); grid = -1; return; }
        if (hipFuncSetAttribute((const void*)mk_fwd, hipFuncAttributeMaxDynamicSharedMemorySize, LDS_BYTES) != hipSuccess) { fprintf(stderr, "kernel_launch: hipFuncSetAttribute failed\n"); grid = -1; return; }
        if (hipOccupancyMaxActiveBlocksPerMultiprocessor(&per_cu, (const void*)mk_fwd, NWAVES * 64, LDS_BYTES) != hipSuccess || per_cu < 1) { fprintf(stderr, "kernel_launch: occupancy query reports %d workgroups per CU\n", per_cu); }
        (void)hipGetLastError();
        grid = cus;
    }
    if (grid < 0) return;
    if (hipMemsetAsync((char*)d_ws + WS_CTL, 0, CTL_ZERO_BYTES, stream) != hipSuccess) { fprintf(stderr, "kernel_launch: hipMemsetAsync failed\n"); return; }
    Args a{};
    for (int i = 0; i < 23; ++i) a.in[i] = (const float*)d_in[i];
    a.out = (float*)d_out; a.ws = (unsigned char*)d_ws;
    for (int li = 0; li < N_LAUNCHES; ++li) {
        a.ph_lo = (N_LAUNCHES == 1) ? 0 : li; a.ph_hi = (N_LAUNCHES == 1) ? N_PHASES : li + 1;
        hipLaunchKernelGGL(mk_fwd, dim3(grid), dim3(NWAVES * 64), LDS_BYTES, stream, a);
        const hipError_t le = hipPeekAtLastError();
        if (le != hipSuccess) { fprintf(stderr, "kernel_launch: launch %d failed: %s\n", li, hipGetErrorName(le)); break; }
    }
}
```

```cpp
#include <hip/hip_runtime.h>
#include <hip/hip_bf16.h>
#include <cstdio>
#include <cstdint>
#include <cmath>

namespace pg8 {
#define PG8_LAS __attribute__((address_space(3)))
typedef unsigned short bf16_t;
typedef short bf16x8 __attribute__((ext_vector_type(8)));
typedef float f32x4 __attribute__((ext_vector_type(4)));
typedef unsigned u32x4 __attribute__((ext_vector_type(4)));
constexpr int BM = 256, BK = 64, HALF = 128, HTB = HALF * BK * 2  , STAGE_BYTES = 8 * HTB, NXCD = 8, WGM = 8;

__host__ __device__ __forceinline__ int lds_byte(int r, int c) { const int st = (r >> 4) * 2 + (c >> 5), rr = r & 15, cc = c & 31, ob = rr * 64 + cc * 2; return st * 1024 + (ob ^ (((ob >> 9) & 1) << 5)); }
__host__ __device__ __forceinline__ void stage_rc(int b, int& R, int& C) { const int st = b / 1024, sb = b % 1024, swz = sb ^ (((sb >> 9) & 1) << 5); R = (st >> 1) * 16 + swz / 64; C = (st & 1) * 32 + (swz % 64) / 2; }
__host__ __device__ __forceinline__ int perm32(int rho) { const int n = rho >> 4, i = rho & 15; return 8 * (i >> 2) + 4 * n + (i & 3); }

struct Unit { int pm, pn; int e, row0, nvalid; };
struct Gemm { const bf16_t* A; const bf16_t* Bt; int M, N, K; };

struct StaticOrder {
    static constexpr bool GATHER = false;
    int nM, nN, nwg, G, c;
    __host__ __device__ void init(int M, int N, int G_, int c_) { nM = M / BM; nN = N / BM; nwg = nM * nN; G = G_; c = c_; }
    __device__ __forceinline__ bool next(int i, Unit& u) const {
        const long L = (long)i * G + c; if (L >= nwg) return false;
        int wgid = (int)L; { const int q = nwg / NXCD, r = nwg % NXCD, xcd = wgid % NXCD, off = wgid / NXCD; wgid = (xcd < r ? xcd * (q + 1) : r * (q + 1) + (xcd - r) * q) + off; }
        const int nig = WGM * nN, gid = wgid / nig, fm = gid * WGM, gsz = (nM - fm) < WGM ? (nM - fm) : WGM;
        u.pm = fm + ((wgid % nig) % gsz); u.pn = (wgid % nig) / gsz; u.e = 0; u.row0 = 0; u.nvalid = 256; return true;
    }
    __device__ __forceinline__ void rows(const Unit& u, const int (&RA)[2], const int (&CA)[2], int K, unsigned (&v)[2][2]) const {
#pragma unroll
        for (int h = 0; h < 2; ++h)
#pragma unroll
            for (int i = 0; i < 2; ++i) v[h][i] = (unsigned)(((u.pm * BM + h * HALF + RA[i]) * K + CA[i]) * 2);
    }
};

__device__ __forceinline__ unsigned cvt_pk_bf16(float lo, float hi) { unsigned r; asm volatile("v_cvt_pk_bf16_f32 %0, %1, %2" : "=v"(r) : "v"(lo), "v"(hi)); return r; }

struct EpiBf16 {
    static constexpr bool PERM = true;
    bf16_t* O; int ldc; int scale_cols; float scale0;
    unsigned* nmax; int nmax_cols;
    __device__ __forceinline__ void operator()(const f32x4 (&acc)[2][2][4][2], const Unit& u, int wr, int wc, int fr, int fq) const {
        const int row0 = u.pm * BM + wr * 64 + fr; const int colt = u.pn * BM;
        const float sc = (colt < scale_cols) ? scale0 : 1.f;
        const int col0 = colt + wc * 32 + 8 * fq;
        const bool donorm = (nmax != nullptr) && (colt < nmax_cols);
        float nm[2] = {0.f, 0.f};
#pragma unroll
        for (int ai = 0; ai < 2; ++ai)
#pragma unroll
            for (int m = 0; m < 4; ++m) { bf16_t* rowp = O + (size_t)(row0 + ai * HALF + m * 16) * ldc + col0;
#pragma unroll
                for (int bj = 0; bj < 2; ++bj) { f32x4 v0 = acc[ai][bj][m][0] * sc, v1 = acc[ai][bj][m][1] * sc;
                    u32x4 w; w.x = cvt_pk_bf16(v0[0], v0[1]); w.y = cvt_pk_bf16(v0[2], v0[3]); w.z = cvt_pk_bf16(v1[0], v1[1]); w.w = cvt_pk_bf16(v1[2], v1[3]);
                    *(u32x4*)(rowp + bj * HALF) = w;
                    if (donorm) { float ss = (v0[0] * v0[0] + v0[1] * v0[1]) + (v0[2] * v0[2] + v0[3] * v0[3]) + (v1[0] * v1[0] + v1[1] * v1[1]) + (v1[2] * v1[2] + v1[3] * v1[3]);
                        ss += __shfl_xor(ss, 16); ss += __shfl_xor(ss, 32); nm[bj] = fmaxf(nm[bj], ss); } } }
        if (donorm) {
#pragma unroll
            for (int bj = 0; bj < 2; ++bj) { float v = nm[bj];
#pragma unroll
                for (int o = 1; o < 16; o <<= 1) v = fmaxf(v, __shfl_xor(v, o));
                if ((threadIdx.x & 63) == 0) atomicMax(nmax + (colt >> 5) + 4 * bj + wc, __float_as_uint(v)); }
        }
    }
};

template <class Epi, class Sched, bool ALIGN_EPI = false>
__device__ __forceinline__ void gemm_phase(PG8_LAS unsigned char* lds, const Gemm g, const Sched& S, const Epi& E) {
    const int tid = threadIdx.x, wid = __builtin_amdgcn_readfirstlane(tid >> 6), lane = tid & 63, wr = wid >> 2, wc = wid & 3, fr = lane & 15, fq = lane >> 4;
    const int K = g.K, nt = K / BK;
    int RA[2], CA[2]; unsigned voffB[2];
#pragma unroll
    for (int i = 0; i < 2; ++i) { int R, C; stage_rc(tid * 16 + i * 8192, R, C); const int Rb = Epi::PERM ? ((R & ~31) + perm32(R & 31)) : R;
        RA[i] = R; CA[i] = C; voffB[i] = (unsigned)(Rb * K + C) * 2u; }
    const size_t kstep = (size_t)(BK * 2);
    const size_t hstep = (size_t)HALF * K * 2;
    const size_t tstep = 2 * hstep;
    const unsigned ldsw = (unsigned)wid * 1024u;
    const int aoff = lds_byte(wr * 64 + fr, fq * 8), boff = lds_byte(wc * 32 + fr, fq * 8);
    const char* const Abase = (const char*)g.A;
#define PG8_SA(b, h) (((b) * 2 + (h)) * HTB)
#define PG8_SB(b, h) ((4 + (b) * 2 + (h)) * HTB)
#define PG8_STAGE(bufoff, gbase, voff) do { _Pragma("unroll") for (int _i = 0; _i < 2; ++_i) \
        __builtin_amdgcn_global_load_lds((const unsigned*)((const char*)(gbase) + (voff)[_i]), (PG8_LAS unsigned*)(lds + (bufoff) + ldsw + _i * 8192), 16, 0, 0); } while (0)
#define PG8_STAGE_A(bufoff, v0, v1, kb) do { \
        __builtin_amdgcn_global_load_lds((const unsigned*)(Abase + (size_t)((v0) + (kb))), (PG8_LAS unsigned*)(lds + (bufoff) + ldsw), 16, 0, 0); \
        __builtin_amdgcn_global_load_lds((const unsigned*)(Abase + (size_t)((v1) + (kb))), (PG8_LAS unsigned*)(lds + (bufoff) + ldsw + 8192), 16, 0, 0); } while (0)
#define PG8_LDA(dst, b, h) do { _Pragma("unroll") for (int m = 0; m < 4; ++m) _Pragma("unroll") for (int k = 0; k < 2; ++k) dst[m][k] = *(const PG8_LAS bf16x8*)(lds + PG8_SA(b, h) + aoff + m * 2048 + k * 1024); } while (0)
#define PG8_LDB(dst, b, h) do { _Pragma("unroll") for (int n = 0; n < 2; ++n) _Pragma("unroll") for (int k = 0; k < 2; ++k) dst[n][k] = *(const PG8_LAS bf16x8*)(lds + PG8_SB(b, h) + boff + n * 2048 + k * 1024); } while (0)
#define PG8_MMA(ai, bj, At, Bt) do { __builtin_amdgcn_s_setprio(1); _Pragma("unroll") for (int m = 0; m < 4; ++m) _Pragma("unroll") for (int n = 0; n < 2; ++n) _Pragma("unroll") for (int k = 0; k < 2; ++k) \
        acc[ai][bj][m][n] = __builtin_amdgcn_mfma_f32_16x16x32_bf16(Bt[n][k], At[m][k], acc[ai][bj][m][n], 0, 0, 0); __builtin_amdgcn_s_setprio(0); } while (0)
#define PG8_WAIT_V(n) asm volatile("s_waitcnt vmcnt(" #n ")" ::: "memory")
#define PG8_WAIT_L(n) asm volatile("s_waitcnt lgkmcnt(" #n ")" ::: "memory")
#define PG8_BAR __builtin_amdgcn_s_barrier()
#define PG8_SCHED __builtin_amdgcn_sched_barrier(0)
    Unit cur, nxt; int ui = 0;
    if (!S.next(0, cur)) return;
    f32x4 acc[2][2][4][2];
#pragma unroll
    for (int a = 0; a < 2; ++a)
#pragma unroll
        for (int b = 0; b < 2; ++b)
#pragma unroll
            for (int m = 0; m < 4; ++m)
#pragma unroll
                for (int n = 0; n < 2; ++n) acc[a][b][m][n] = (f32x4){0.f, 0.f, 0.f, 0.f};
    bf16x8 At[4][2], B0[2][2], B1[2][2];
    unsigned vAc[2][2], vAn[2][2];
    S.rows(cur, RA, CA, K, vAc);
    const char* cB = (const char*)g.Bt + (size_t)cur.pn * tstep;
    PG8_STAGE(PG8_SB(0, 0), cB, voffB); PG8_STAGE(PG8_SB(0, 1), cB + hstep, voffB); PG8_STAGE_A(PG8_SA(0, 0), vAc[0][0], vAc[0][1], 0u); PG8_STAGE_A(PG8_SA(0, 1), vAc[1][0], vAc[1][1], 0u);
    if (wr == 1) PG8_BAR;
    PG8_WAIT_V(2); PG8_BAR;
    PG8_STAGE(PG8_SB(1, 0), cB + kstep, voffB); PG8_STAGE_A(PG8_SA(1, 0), vAc[0][0], vAc[0][1], (unsigned)kstep); PG8_STAGE(PG8_SB(1, 1), cB + hstep + kstep, voffB);
    PG8_WAIT_V(6); PG8_BAR;
    for (;;) {
        const bool has_next = S.next(ui + 1, nxt);
        if (has_next) S.rows(nxt, RA, CA, K, vAn);
        else { vAn[0][0] = vAc[0][0]; vAn[0][1] = vAc[0][1]; vAn[1][0] = vAc[1][0]; vAn[1][1] = vAc[1][1]; }
        const char* nB = has_next ? (const char*)g.Bt + (size_t)nxt.pn * tstep : cB;
        for (int t = 0; t < nt; t += 2) {
            const bool last = (t == nt - 2);
            const unsigned kb1 = (unsigned)(t + 1) * (unsigned)kstep;
            const unsigned kb2 = last ? 0u : (unsigned)(t + 2) * (unsigned)kstep, kb3 = kb2 + (unsigned)kstep;
            const unsigned x00 = last ? vAn[0][0] : vAc[0][0], x01 = last ? vAn[0][1] : vAc[0][1], x10 = last ? vAn[1][0] : vAc[1][0], x11 = last ? vAn[1][1] : vAc[1][1];
            const char* b2 = last ? nB : cB + (size_t)(t + 2) * kstep; const char* b3 = b2 + kstep;
            PG8_LDB(B0, 0, 0); PG8_LDB(B1, 0, 1); PG8_SCHED; PG8_LDA(At, 0, 0); PG8_STAGE_A(PG8_SA(1, 1), vAc[1][0], vAc[1][1], kb1);
            PG8_WAIT_V(8); PG8_WAIT_L(0); PG8_BAR; PG8_MMA(0, 0, At, B0); PG8_MMA(0, 1, At, B1); PG8_BAR; PG8_SCHED;
            PG8_LDA(At, 0, 1); PG8_STAGE(PG8_SB(0, 0), b2, voffB); PG8_STAGE(PG8_SB(0, 1), b2 + hstep, voffB); PG8_STAGE_A(PG8_SA(0, 0), x00, x01, kb2);
            PG8_WAIT_V(8); PG8_WAIT_L(0); PG8_BAR; PG8_MMA(1, 0, At, B0); PG8_MMA(1, 1, At, B1); PG8_BAR; PG8_SCHED;
            PG8_LDB(B0, 1, 0); PG8_LDB(B1, 1, 1); PG8_SCHED; PG8_LDA(At, 1, 0); PG8_STAGE_A(PG8_SA(0, 1), x10, x11, kb2);
            PG8_WAIT_V(8); PG8_WAIT_L(0); PG8_BAR; PG8_MMA(0, 0, At, B0); PG8_MMA(0, 1, At, B1); PG8_BAR; PG8_SCHED;
            PG8_LDA(At, 1, 1); PG8_STAGE(PG8_SB(1, 0), b3, voffB); PG8_STAGE(PG8_SB(1, 1), b3 + hstep, voffB); PG8_STAGE_A(PG8_SA(1, 0), x00, x01, kb3);
            PG8_WAIT_V(8); PG8_WAIT_L(0); PG8_BAR; PG8_MMA(1, 0, At, B0); PG8_MMA(1, 1, At, B1); PG8_BAR; PG8_SCHED;
        }
        if constexpr (ALIGN_EPI) { if (wr == 0) PG8_BAR; }
        E(acc, cur, wr, wc, fr, fq);
        if (!has_next) break;
#pragma unroll
        for (int a = 0; a < 2; ++a)
#pragma unroll
            for (int b = 0; b < 2; ++b)
#pragma unroll
                for (int m = 0; m < 4; ++m)
#pragma unroll
                    for (int n = 0; n < 2; ++n) acc[a][b][m][n] = (f32x4){0.f, 0.f, 0.f, 0.f};
        cur = nxt; cB = nB; ++ui;
        vAc[0][0] = vAn[0][0]; vAc[0][1] = vAn[0][1]; vAc[1][0] = vAn[1][0]; vAc[1][1] = vAn[1][1];
        if constexpr (ALIGN_EPI) { if (wr == 1) PG8_BAR; }
    }
    PG8_WAIT_V(0);
    if constexpr (!ALIGN_EPI) { if (wr == 0) PG8_BAR; }
    PG8_BAR;
#undef PG8_SA
#undef PG8_SB
#undef PG8_STAGE
#undef PG8_STAGE_A
#undef PG8_LDA
#undef PG8_LDB
#undef PG8_MMA
#undef PG8_WAIT_V
#undef PG8_WAIT_L
#undef PG8_BAR
#undef PG8_SCHED
}
}

namespace att {
typedef __attribute__((address_space(3))) const char* lds_cptr;
typedef __attribute__((address_space(3))) char* lds_ptr;
using bf16x8 = __attribute__((ext_vector_type(8))) short;
using s16x4 = __attribute__((ext_vector_type(4))) short;
using f32x16 = __attribute__((ext_vector_type(16))) float;
using f32x4 = __attribute__((ext_vector_type(4))) float;
using u32x4 = __attribute__((ext_vector_type(4))) unsigned;
typedef short v4i16_t __attribute__((ext_vector_type(4)));
typedef float f32x2_t __attribute__((ext_vector_type(2))); typedef __bf16 bf16x2_t __attribute__((ext_vector_type(2)));
constexpr int PITCH = 6144 + 128;
constexpr int COL_Q = 0, COL_K = 1024, COL_V = 2048;
constexpr int SLOT = 16384;
constexpr int NSLOT = 4, L_K = 0, L_V = NSLOT * SLOT, L_X = 0, XSTRIDE = 17408, L_WS = 131072 + 2048, LDS_BYTES = L_WS + 8 * 256;
constexpr float LOG2E = 1.4426950408889634f;
constexpr float QSCALE = 0.125f * LOG2E;
constexpr float THR = 6.0f;

__device__ __forceinline__ int crow(int r, int hi) { return (r & 3) + 8 * (r >> 2) + 4 * hi; }
__device__ __forceinline__ void glds16(const void* sbase, unsigned voff, unsigned lds_dst) { unsigned keep;
    asm volatile("s_mov_b32 %0, m0\n\ts_mov_b32 m0, %3\n\ts_nop 0\n\tglobal_load_lds_dwordx4 %1, %2\n\ts_mov_b32 m0, %0" : "=&s"(keep) : "v"(voff), "s"(sbase), "s"(lds_dst) : "memory"); }
__device__ __forceinline__ float max3f(float a, float b, float c) { float r; asm("v_max3_f32 %0, %1, %2, %3" : "=v"(r) : "v"(a), "v"(b), "v"(c)); return r; }
__device__ __forceinline__ float max2f(float a, float b) { float r; asm("v_max_f32_e32 %0, %1, %2" : "=v"(r) : "v"(a), "v"(b)); return r; }
__device__ __forceinline__ unsigned cvtpk_s(float lo, float hi) { f32x2_t v = {lo, hi}; bf16x2_t b = __builtin_convertvector(v, bf16x2_t); return __builtin_bit_cast(unsigned, b); }
__device__ __forceinline__ s16x4 vtr(lds_cptr p) { return __builtin_bit_cast(s16x4, __builtin_amdgcn_ds_read_tr16_b64_v4i16((__attribute__((address_space(3))) v4i16_t*)p)); }

struct Tensors { const __hip_bfloat16* proj; __hip_bfloat16* ycat; const float* g_subln; float lam; };

__device__ __forceinline__ float xhalf(float v) { return __shfl_xor(v, 32); }

struct WaveState { f32x16 o[4]; float mhat, l_reg; u32x4 pw0, pw1, pw2, pw3; };
__device__ __forceinline__ void att_qksm(WaveState& st, const bf16x8 (&qr)[4], lds_cptr kb, const int (&kof)[4], __attribute__((address_space(3))) float* wsf, const float (&cst)[16],
                                         float slope2, int qpos, int t, bool diag, int r32, int hi) {
    f32x16 p0, p1;
    bf16x8 kf[8];
#pragma unroll
    for (int d0 = 0; d0 < 4; ++d0) { kf[2 * d0] = *(const __attribute__((address_space(3))) bf16x8*)(kb + kof[d0]); kf[2 * d0 + 1] = *(const __attribute__((address_space(3))) bf16x8*)(kb + kof[d0] + 8192); }
    __builtin_amdgcn_sched_barrier(0);
    const float dq = (float)(qpos - t * 64 - 4 * hi);
    if (diag) {
#pragma unroll
        for (int r = 0; r < 16; ++r) { const float d0_ = dq - (float)((r & 3) + 8 * (r >> 2)); p0[r] = -slope2 * fabsf(d0_) - st.mhat; p1[r] = -slope2 * fabsf(d0_ - 32.f) - st.mhat; }
    } else {
        const float A0 = -slope2 * dq - st.mhat, A1 = A0 + 32.f * slope2;
#pragma unroll
        for (int r = 0; r < 16; ++r) { p0[r] = A0 + cst[r]; p1[r] = A1 + cst[r]; }
    }
    __builtin_amdgcn_sched_barrier(0);
#pragma unroll
    for (int d0 = 0; d0 < 4; ++d0) {
        p0 = __builtin_amdgcn_mfma_f32_32x32x16_bf16(kf[2 * d0], qr[d0], p0, 0, 0, 0);
        p1 = __builtin_amdgcn_mfma_f32_32x32x16_bf16(kf[2 * d0 + 1], qr[d0], p1, 0, 0, 0);
    }
    asm volatile("s_nop 15\n\ts_nop 7" : "+v"(p0), "+v"(p1));
    float rm;
    { float a_ = max3f(p0[0], p0[1], p1[0]), b_ = max3f(p0[2], p0[3], p1[1]); a_ = max3f(a_, p1[2], p1[3]);
#pragma unroll
      for (int r = 4; r < 16; r += 4) { a_ = max3f(a_, p0[r], p0[r + 1]); b_ = max3f(b_, p0[r + 2], p0[r + 3]); a_ = max3f(a_, p1[r], p1[r + 1]); b_ = max3f(b_, p1[r + 2], p1[r + 3]); }
      rm = max2f(a_, b_); }
    { auto rr = __builtin_amdgcn_permlane32_swap(__float_as_uint(rm), __float_as_uint(rm), false, false); rm = max2f(__uint_as_float(rr[0]), __uint_as_float(rr[1])); }
    if (diag || __any(rm > THR)) {
        const float dl = diag ? rm : fmaxf(rm, 0.f);
        st.mhat += dl;
#pragma unroll
        for (int r = 0; r < 16; ++r) { p0[r] -= dl; p1[r] -= dl; }
        if (!diag) {
            const float f = __builtin_amdgcn_exp2f(-dl); st.l_reg *= f;
            if (hi == 0) wsf[r32] = f;
            asm volatile("s_waitcnt lgkmcnt(0)" ::: "memory");
            float fr_[16];
#pragma unroll
            for (int r = 0; r < 16; ++r) fr_[r] = wsf[crow(r, hi)];
#pragma unroll
            for (int d = 0; d < 4; ++d)
#pragma unroll
                for (int r = 0; r < 16; ++r) st.o[d][r] *= fr_[r];
        }
    }
    float sacc = 0.f;
#pragma unroll
    for (int r = 0; r < 16; ++r) { p0[r] = __builtin_amdgcn_exp2f(p0[r]); p1[r] = __builtin_amdgcn_exp2f(p1[r]); sacc += p0[r] + p1[r]; }
    st.l_reg += sacc;
    st.pw0 = (u32x4){cvtpk_s(p0[0], p0[1]), cvtpk_s(p0[2], p0[3]), cvtpk_s(p0[4], p0[5]), cvtpk_s(p0[6], p0[7])};
    st.pw1 = (u32x4){cvtpk_s(p0[8], p0[9]), cvtpk_s(p0[10], p0[11]), cvtpk_s(p0[12], p0[13]), cvtpk_s(p0[14], p0[15])};
    st.pw2 = (u32x4){cvtpk_s(p1[0], p1[1]), cvtpk_s(p1[2], p1[3]), cvtpk_s(p1[4], p1[5]), cvtpk_s(p1[6], p1[7])};
    st.pw3 = (u32x4){cvtpk_s(p1[8], p1[9]), cvtpk_s(p1[10], p1[11]), cvtpk_s(p1[12], p1[13]), cvtpk_s(p1[14], p1[15])};
}
__device__ __forceinline__ void att_pv(WaveState& st, lds_cptr vb, const int (&vof)[2]) {
    s16x4 alo[4], ahi[4], blo[4], bhi[4];
#define ATT_RD(LO, HI, db) do { _Pragma("unroll") for (int ks = 0; ks < 4; ++ks) { LO[ks] = vtr(vb + (vof[0] ^ (64 * (db))) + ks * 4096); HI[ks] = vtr(vb + (vof[1] ^ (64 * (db))) + ks * 4096); } } while (0)
#define ATT_PK(LO, HI, k) (bf16x8){LO[k][0], LO[k][1], LO[k][2], LO[k][3], HI[k][0], HI[k][1], HI[k][2], HI[k][3]}
#define ATT_MM(LO, HI, db) do { \
        st.o[db] = __builtin_amdgcn_mfma_f32_32x32x16_bf16(__builtin_bit_cast(bf16x8, st.pw0), ATT_PK(LO, HI, 0), st.o[db], 0, 0, 0); \
        st.o[db] = __builtin_amdgcn_mfma_f32_32x32x16_bf16(__builtin_bit_cast(bf16x8, st.pw1), ATT_PK(LO, HI, 1), st.o[db], 0, 0, 0); \
        st.o[db] = __builtin_amdgcn_mfma_f32_32x32x16_bf16(__builtin_bit_cast(bf16x8, st.pw2), ATT_PK(LO, HI, 2), st.o[db], 0, 0, 0); \
        st.o[db] = __builtin_amdgcn_mfma_f32_32x32x16_bf16(__builtin_bit_cast(bf16x8, st.pw3), ATT_PK(LO, HI, 3), st.o[db], 0, 0, 0); } while (0)
    ATT_RD(alo, ahi, 0); ATT_RD(blo, bhi, 1); __builtin_amdgcn_sched_barrier(0);
    ATT_MM(alo, ahi, 0); __builtin_amdgcn_sched_barrier(0);
    ATT_RD(alo, ahi, 2); __builtin_amdgcn_sched_barrier(0);
    ATT_MM(blo, bhi, 1); __builtin_amdgcn_sched_barrier(0);
    ATT_RD(blo, bhi, 3); __builtin_amdgcn_sched_barrier(0);
    ATT_MM(alo, ahi, 2); __builtin_amdgcn_sched_barrier(0);
    ATT_MM(blo, bhi, 3);
#undef ATT_RD
#undef ATT_PK
#undef ATT_MM
}

__device__ __forceinline__ void att_step(WaveState& st, bool pend, lds_cptr vbp, const int (&vof)[2], const bf16x8 (&qr)[4], lds_cptr kb, int kof,
                                         __attribute__((address_space(3))) float* wsf, const float (&cst)[16], float slope2, int qpos, int t, bool diag, int r32, int hi) {
    f32x16 p0, p1;
    bf16x8 kf[8];
#pragma unroll
    for (int d0 = 0; d0 < 4; ++d0) { kf[2 * d0] = *(const __attribute__((address_space(3))) bf16x8*)(kb + (kof ^ (32 * d0))); kf[2 * d0 + 1] = *(const __attribute__((address_space(3))) bf16x8*)(kb + (kof ^ (32 * d0)) + 8192); }
    __builtin_amdgcn_sched_barrier(0);
    const float dq = (float)(qpos - t * 64 - 4 * hi);
    if (diag) {
#pragma unroll
        for (int r = 0; r < 16; ++r) { const float d0_ = dq - (float)((r & 3) + 8 * (r >> 2)); p0[r] = -slope2 * fabsf(d0_) - st.mhat; p1[r] = -slope2 * fabsf(d0_ - 32.f) - st.mhat; }
    } else {
        float s2v = slope2; asm volatile("" : "+v"(s2v));
        const float A0 = -s2v * dq - st.mhat, A1 = A0 + 32.f * s2v;
#pragma unroll
        for (int r = 0; r < 16; ++r) { const float cr = (float)((r & 3) + 8 * (r >> 2)); p0[r] = fmaf(cr, s2v, A0); p1[r] = fmaf(cr, s2v, A1); }
    }
    __builtin_amdgcn_sched_barrier(0);
#pragma unroll
    for (int d0 = 0; d0 < 4; ++d0) {
        p0 = __builtin_amdgcn_mfma_f32_32x32x16_bf16(kf[2 * d0], qr[d0], p0, 0, 0, 0);
        p1 = __builtin_amdgcn_mfma_f32_32x32x16_bf16(kf[2 * d0 + 1], qr[d0], p1, 0, 0, 0);
    }
    asm volatile("s_nop 15\n\ts_nop 7" : "+v"(p0), "+v"(p1));
    float rm;
    { float a_ = max3f(p0[0], p0[1], p1[0]), b_ = max3f(p0[2], p0[3], p1[1]); a_ = max3f(a_, p1[2], p1[3]);
#pragma unroll
      for (int r = 4; r < 16; r += 4) { a_ = max3f(a_, p0[r], p0[r + 1]); b_ = max3f(b_, p0[r + 2], p0[r + 3]); a_ = max3f(a_, p1[r], p1[r + 1]); b_ = max3f(b_, p1[r + 2], p1[r + 3]); }
      rm = max2f(a_, b_); }
    { auto rr = __builtin_amdgcn_permlane32_swap(__float_as_uint(rm), __float_as_uint(rm), false, false); rm = max2f(__uint_as_float(rr[0]), __uint_as_float(rr[1])); }
    const bool need = diag || __any(rm > THR);
    float f = 1.0f;
    if (need) {
        const float dl = diag ? rm : fmaxf(rm, 0.f);
        st.mhat += dl;
#pragma unroll
        for (int r = 0; r < 16; ++r) { p0[r] -= dl; p1[r] -= dl; }
        if (!diag) f = __builtin_amdgcn_exp2f(-dl);
    }
    u32x4 nw0, nw1, nw2, nw3; float sacc = 0.f;
    if (pend) {
        s16x4 alo[4], ahi[4], blo[4], bhi[4];
#define ATT_RD(LO, HI, db) do { _Pragma("unroll") for (int ks = 0; ks < 4; ++ks) { LO[ks] = vtr(vbp + (vof[0] ^ (64 * (db))) + ks * 4096); HI[ks] = vtr(vbp + (vof[1] ^ (64 * (db))) + ks * 4096); } } while (0)
#define ATT_PK(LO, HI, k) (bf16x8){LO[k][0], LO[k][1], LO[k][2], LO[k][3], HI[k][0], HI[k][1], HI[k][2], HI[k][3]}
#define ATT_GAP(db, ks, LO, HI, PW, E0, E1, NW) do { \
        st.o[db] = __builtin_amdgcn_mfma_f32_32x32x16_bf16(__builtin_bit_cast(bf16x8, PW), ATT_PK(LO, HI, ks), st.o[db], 0, 0, 0); \
        E0 = __builtin_amdgcn_exp2f(E0); E1 = __builtin_amdgcn_exp2f(E1); sacc += E0; sacc += E1; NW = cvtpk_s(E0, E1); __builtin_amdgcn_sched_barrier(0); } while (0)
        ATT_RD(alo, ahi, 0); ATT_RD(blo, bhi, 1); __builtin_amdgcn_sched_barrier(0);
        ATT_GAP(0, 0, alo, ahi, st.pw0, p0[0], p0[1], nw0.x); ATT_GAP(0, 1, alo, ahi, st.pw1, p0[2], p0[3], nw0.y); ATT_GAP(0, 2, alo, ahi, st.pw2, p0[4], p0[5], nw0.z); ATT_GAP(0, 3, alo, ahi, st.pw3, p0[6], p0[7], nw0.w);
        ATT_RD(alo, ahi, 2); __builtin_amdgcn_sched_barrier(0);
        ATT_GAP(1, 0, blo, bhi, st.pw0, p0[8], p0[9], nw1.x); ATT_GAP(1, 1, blo, bhi, st.pw1, p0[10], p0[11], nw1.y); ATT_GAP(1, 2, blo, bhi, st.pw2, p0[12], p0[13], nw1.z); ATT_GAP(1, 3, blo, bhi, st.pw3, p0[14], p0[15], nw1.w);
        ATT_RD(blo, bhi, 3); __builtin_amdgcn_sched_barrier(0);
        ATT_GAP(2, 0, alo, ahi, st.pw0, p1[0], p1[1], nw2.x); ATT_GAP(2, 1, alo, ahi, st.pw1, p1[2], p1[3], nw2.y); ATT_GAP(2, 2, alo, ahi, st.pw2, p1[4], p1[5], nw2.z); ATT_GAP(2, 3, alo, ahi, st.pw3, p1[6], p1[7], nw2.w);
        ATT_GAP(3, 0, blo, bhi, st.pw0, p1[8], p1[9], nw3.x); ATT_GAP(3, 1, blo, bhi, st.pw1, p1[10], p1[11], nw3.y); ATT_GAP(3, 2, blo, bhi, st.pw2, p1[12], p1[13], nw3.z); ATT_GAP(3, 3, blo, bhi, st.pw3, p1[14], p1[15], nw3.w);
#undef ATT_RD
#undef ATT_PK
#undef ATT_GAP
    } else {
#pragma unroll
        for (int r = 0; r < 16; ++r) { p0[r] = __builtin_amdgcn_exp2f(p0[r]); p1[r] = __builtin_amdgcn_exp2f(p1[r]); sacc += p0[r] + p1[r]; }
        nw0 = (u32x4){cvtpk_s(p0[0], p0[1]), cvtpk_s(p0[2], p0[3]), cvtpk_s(p0[4], p0[5]), cvtpk_s(p0[6], p0[7])};
        nw1 = (u32x4){cvtpk_s(p0[8], p0[9]), cvtpk_s(p0[10], p0[11]), cvtpk_s(p0[12], p0[13]), cvtpk_s(p0[14], p0[15])};
        nw2 = (u32x4){cvtpk_s(p1[0], p1[1]), cvtpk_s(p1[2], p1[3]), cvtpk_s(p1[4], p1[5]), cvtpk_s(p1[6], p1[7])};
        nw3 = (u32x4){cvtpk_s(p1[8], p1[9]), cvtpk_s(p1[10], p1[11]), cvtpk_s(p1[12], p1[13]), cvtpk_s(p1[14], p1[15])};
    }
    st.l_reg = st.l_reg * f + sacc; st.pw0 = nw0; st.pw1 = nw1; st.pw2 = nw2; st.pw3 = nw3;
    if (need && !diag) {
        if (hi == 0) wsf[r32] = f;
        asm volatile("s_waitcnt lgkmcnt(0)" ::: "memory");
        float fr_[16];
#pragma unroll
        for (int r = 0; r < 16; ++r) fr_[r] = wsf[crow(r, hi)];
#pragma unroll
        for (int d = 0; d < 4; ++d)
#pragma unroll
            for (int r = 0; r < 16; ++r) st.o[d][r] *= fr_[r];
    }
}

template <int VAR>
__device__ __forceinline__ void attn_unit(int h, int qb, int t_lo, const Tensors& T, lds_ptr shm) {
    typedef __hip_bfloat16 bf16;
    const int tid = threadIdx.x, lane = tid & 63, r32 = lane & 31, hi = lane >> 5; const int wid = __builtin_amdgcn_readfirstlane(tid >> 6);
    const int rb = wid & 3, mp = wid >> 2;
    const int q0 = qb * 128 + rb * 32;
    const int cw = q0 >> 6;
    const int NT = 2 * qb + 2;
    const bf16* Qw = T.proj + (size_t)q0 * PITCH + COL_Q + h * 128 + mp * 64;
    const bf16* Kh = T.proj + COL_K + h * 128; const bf16* Vh = T.proj + COL_V + h * 128;
    const unsigned lds0 = (unsigned)(uintptr_t)shm;
    __attribute__((address_space(3))) float* wsf = (__attribute__((address_space(3))) float*)(shm + L_WS + wid * 256);
    const unsigned dvoff = (unsigned)(((lane >> 4) * PITCH + ((lane & 15) ^ (((lane >> 4) << 2) | (wid & 3))) * 8) * 2);
    const bf16* kpc = Kh + (size_t)(wid * 4) * PITCH; const bf16* vpc = Vh + (size_t)(wid * 4) * PITCH;
    const unsigned kdst = lds0 + L_K + wid * 1024, vdst = lds0 + L_V + wid * 1024;
#define ATT_DMA(t, ks, vs) do { const size_t toff_ = (size_t)(t) * 64 * PITCH; const unsigned ko_ = (unsigned)(ks) * SLOT, vo_ = (unsigned)(vs) * SLOT; \
        glds16(kpc + toff_, dvoff, (unsigned)__builtin_amdgcn_readfirstlane(kdst + ko_)); glds16(kpc + toff_ + (size_t)32 * PITCH, dvoff, (unsigned)__builtin_amdgcn_readfirstlane(kdst + ko_ + 8192)); \
        glds16(vpc + toff_, dvoff, (unsigned)__builtin_amdgcn_readfirstlane(vdst + vo_)); glds16(vpc + toff_ + (size_t)32 * PITCH, dvoff, (unsigned)__builtin_amdgcn_readfirstlane(vdst + vo_ + 8192)); } while (0)
    const int n_t = NT - t_lo;
    ATT_DMA(NT - 1, 0, 0);
    if (n_t > 1) ATT_DMA(NT - 2, 1, 1);
    bf16x8 qr[4];
#pragma unroll
    for (int d0 = 0; d0 < 4; ++d0) qr[d0] = *reinterpret_cast<const bf16x8*>(&Qw[(size_t)r32 * PITCH + d0 * 16 + hi * 8]);
    const float slope2 = exp2f(-(float)(h + 1)) * LOG2E;
    const float cst[16] = {};
    WaveState st; st.mhat = 0.f; st.l_reg = 0.f;
#pragma unroll
    for (int d = 0; d < 4; ++d) st.o[d] = f32x16{};
    st.pw0 = st.pw1 = st.pw2 = st.pw3 = (u32x4){0u, 0u, 0u, 0u};
    int kof, vof[2];
    { const int xr = ((r32 & 3) << 2) | ((r32 >> 2) & 3);
      kof = 256 * r32 + 16 * ((8 * mp + hi) ^ xr);
      const int q_ = (lane & 15) >> 2, p_ = lane & 3, blk = (lane >> 4) & 1;
#pragma unroll
      for (int t_ = 0; t_ < 2; ++t_) { const int row = 8 * t_ + 4 * hi + q_; const int xv = ((row & 3) << 2) | ((row >> 2) & 3);
          vof[t_] = 256 * row + 16 * ((2 * blk + (p_ >> 1)) ^ xv) + 8 * (p_ & 1); } }
    const lds_cptr kb0 = (lds_cptr)shm + L_K; const lds_cptr vb0 = (lds_cptr)shm + L_V;
    const int qpos = q0 + r32;
    bool pend = false; int pend_vs = 0;
#pragma unroll 1
    for (int j = 0; j < n_t; ++j) {
        const int t = NT - 1 - j, sl = j & 3;
        if (j + 1 < n_t) asm volatile("s_waitcnt vmcnt(4)" ::: "memory"); else asm volatile("s_waitcnt vmcnt(0)" ::: "memory");
        __builtin_amdgcn_s_barrier(); asm volatile("" ::: "memory");
        if (mp == 0 && j + 2 < n_t) ATT_DMA(t - 2, (j + 2) & 3, (j + 2) & 3);
        const bool act = (t <= cw);
        if (VAR != 2) { if (act) { att_step(st, pend, vb0 + pend_vs * SLOT, vof, qr, kb0 + sl * SLOT, kof, wsf, cst, slope2, qpos, t, t == cw, r32, hi); pend = true; pend_vs = sl; } }
        if (mp == 1 && j + 2 < n_t) ATT_DMA(t - 2, (j + 2) & 3, (j + 2) & 3);
        asm volatile("s_waitcnt lgkmcnt(0)" ::: "memory");
    }
#undef ATT_DMA
    if (VAR != 2) { if (pend) att_pv(st, vb0 + pend_vs * SLOT, vof); }
    asm volatile("s_waitcnt vmcnt(0) lgkmcnt(0)" ::: "memory"); __builtin_amdgcn_s_barrier(); asm volatile("" ::: "memory");
    float l_reg = st.l_reg; f32x16 (&o)[4] = st.o;
    l_reg += xhalf(l_reg);
    if (hi == 0) wsf[32 + r32] = l_reg;
    asm volatile("s_waitcnt lgkmcnt(0)" ::: "memory");
    float rli[16];
#pragma unroll
    for (int r = 0; r < 16; ++r) rli[r] = 1.0f / wsf[32 + crow(r, hi)];
    __attribute__((address_space(3))) float* X = (__attribute__((address_space(3))) float*)(shm + L_X + rb * XSTRIDE);
    if (mp == 1) {
#pragma unroll
        for (int d = 0; d < 4; ++d)
#pragma unroll
            for (int r = 0; r < 16; ++r) X[(d * 16 + r) * 64 + lane] = o[d][r] * rli[r];
    }
    asm volatile("s_waitcnt lgkmcnt(0)" ::: "memory"); __builtin_amdgcn_s_barrier(); asm volatile("" ::: "memory");
    if (mp == 0) {
        const float lam = T.lam;
#pragma unroll
        for (int d = 0; d < 4; ++d)
#pragma unroll
            for (int r = 0; r < 16; ++r) o[d][r] = o[d][r] * rli[r] - lam * X[(d * 16 + r) * 64 + lane];
        asm volatile("s_waitcnt lgkmcnt(0)" ::: "memory");
#pragma unroll
        for (int d = 0; d < 4; ++d)
#pragma unroll
            for (int r = 0; r < 16; ++r) X[crow(r, hi) * 132 + d * 32 + r32] = o[d][r];
        asm volatile("s_waitcnt lgkmcnt(0)" ::: "memory");
        f32x4 v[16]; float ss = 0.f;
#pragma unroll
        for (int i = 0; i < 16; ++i) { v[i] = *(const __attribute__((address_space(3))) f32x4*)(X + r32 * 132 + hi * 64 + 4 * i); ss += (v[i].x * v[i].x + v[i].y * v[i].y) + (v[i].z * v[i].z + v[i].w * v[i].w); }
        ss += xhalf(ss);
        const float rstd = 0.8f / sqrtf(ss * (1.0f / 128.0f) + 1e-5f);
        bf16* Ow = T.ycat + (size_t)(q0 + r32) * 2048 + h * 128 + hi * 64;
        const float* gs = T.g_subln + hi * 64;
#pragma unroll
        for (int i = 0; i < 8; ++i) {
            const f32x4 g0 = *(const f32x4*)(gs + 8 * i), g1 = *(const f32x4*)(gs + 8 * i + 4); const f32x4 a = v[2 * i] * rstd * g0, b = v[2 * i + 1] * rstd * g1;
            u32x4 w; w.x = cvtpk_s(a.x, a.y); w.y = cvtpk_s(a.z, a.w); w.z = cvtpk_s(b.x, b.y); w.w = cvtpk_s(b.z, b.w);
            *(u32x4*)(Ow + 8 * i) = w;
        }
    }
    asm volatile("s_waitcnt lgkmcnt(0)" ::: "memory"); __builtin_amdgcn_s_barrier(); asm volatile("" ::: "memory");
}
}

constexpr int NWAVES = 8;
constexpr int SEQ = 16384, DM = 2048, NPROJ = 6144, NHEAD = 8, NEXP = 32, DEXP = 512, CAP = 16384;
constexpr float NORM_EPS = 1e-6f;
#ifndef MK_N_LAUNCHES
#define MK_N_LAUNCHES 1
#endif
constexpr int N_PHASES = 9;
constexpr int N_LAUNCHES = MK_N_LAUNCHES;

constexpr size_t MiB = 1u << 20;
constexpr size_t WS_CTL = 0, CTL_ZERO_BYTES = 1 * MiB;
constexpr size_t WS_WRT = 1 * MiB;
constexpr size_t WS_GATES = 2 * MiB;
constexpr size_t WS_LIST = 3 * MiB;
constexpr size_t WS_WIN = 6 * MiB;
constexpr size_t WS_WOUT = 30 * MiB;
constexpr size_t WS_W1 = 38 * MiB;
constexpr size_t WS_W2 = 166 * MiB;
constexpr size_t WS_B = 230 * MiB;
constexpr size_t WS_A = 294 * MiB;
constexpr size_t WS_END = 490 * MiB;
constexpr int CW_BAR = 4096;
constexpr int CW_NMAX = 8448;
constexpr int CW_QUEUE = 8704;
constexpr int CW_CNT = 8192;
constexpr int CW_MOD = 16384;

constexpr int RING_OFF = 0, RING_BYTES = 131072;
constexpr int LDSCTL_OFF = RING_BYTES;
constexpr int LDS_BYTES = 147456;
constexpr int LT_PRE = LDSCTL_OFF + 256, LT_CNT = LT_PRE + 34 * 4;

#define GAS __attribute__((address_space(1)))
#define LAS __attribute__((address_space(3)))
typedef unsigned short bf16;
typedef unsigned v4u __attribute__((ext_vector_type(4)));
typedef unsigned v2u __attribute__((ext_vector_type(2)));
typedef float f32x4 __attribute__((ext_vector_type(4)));
typedef GAS unsigned gu32;
#define RLX_AGENT __ATOMIC_RELAXED, __HIP_MEMORY_SCOPE_AGENT
#define LDS_WAIT() asm volatile("s_waitcnt lgkmcnt(0)" ::: "memory")
#define VM_WAIT() asm volatile("s_waitcnt vmcnt(0)" ::: "memory")
__device__ __forceinline__ unsigned f2bf(float f) { unsigned u = __builtin_bit_cast(unsigned, f); return (u + 0x7fffu + ((u >> 16) & 1u)) >> 16; }
__device__ __forceinline__ unsigned pk2(float lo, float hi) { return f2bf(lo) | (f2bf(hi) << 16); }
__device__ __forceinline__ float bf_lo(unsigned w) { return __builtin_bit_cast(float, w << 16); }
__device__ __forceinline__ float bf_hi(unsigned w) { return __builtin_bit_cast(float, w & 0xffff0000u); }

#define XB_TMO      128
#define XB_XCNT(j)  (256  + 64 * (j))
#define XB_XSUB(j)  (1280 + 64 * (j))
#define XB_XGEN(j)  (2304 + 64 * (j))
#define XB_TOP      3328
#define XB_TOPGEN   3392
#define XCD_BAR_WORDS 3456
#define XB_SPIN_CAP (1u << 18)

__device__ __forceinline__ unsigned xb_ld(unsigned* p)              { return __hip_atomic_load(p, __ATOMIC_RELAXED, __HIP_MEMORY_SCOPE_AGENT); }
__device__ __forceinline__ unsigned xb_add(unsigned* p, unsigned v) { return __hip_atomic_fetch_add(p, v, __ATOMIC_RELAXED, __HIP_MEMORY_SCOPE_AGENT); }
__device__ __forceinline__ unsigned xb_xcc_id() { return (unsigned)__builtin_amdgcn_s_getreg((3 << 11) | 20) & 0xFu; }
#define XB_SPIN(cond, bar) do { unsigned _sp = 0; while (cond) { __builtin_amdgcn_s_sleep(1); \
    if ((++_sp & 255u) == 0u) { if (xb_ld(&(bar)[XB_TMO])) break; if (_sp > XB_SPIN_CAP) { atomicAdd(&(bar)[XB_TMO], 1u); break; } } } } while (0)

struct XcdBarrier {
    unsigned* bar; unsigned x;
    volatile LAS unsigned* st;
};

__device__ __forceinline__ XcdBarrier xcd_barrier_post(unsigned* bar, volatile LAS unsigned* st) {
    XcdBarrier b; b.bar = bar; b.x = xb_xcc_id(); b.st = st;
    if (threadIdx.x == 0) (void)xb_add(&bar[XB_XCNT(b.x)], 1u);
    return b;
}
__device__ __forceinline__ void xcd_barrier_complete(unsigned* bar, unsigned x, unsigned& nloc, unsigned& nx) {
    const unsigned G = gridDim.x * gridDim.y * gridDim.z;
    unsigned sum, cnt, mine, sp = 0u;
    for (;;) {
        sum = 0u; cnt = 0u; mine = 0u;
#pragma unroll
        for (unsigned j = 0; j < 16; ++j) { const unsigned c = xb_ld(&bar[XB_XCNT(j)]); sum += c; cnt += (c > 0u) ? 1u : 0u; mine = (j == x) ? c : mine; }
        if (sum == G) break;
        __builtin_amdgcn_s_sleep(1);
        if ((++sp & 255u) == 0u) { if (xb_ld(&bar[XB_TMO])) break; if (sp > XB_SPIN_CAP) { atomicAdd(&bar[XB_TMO], 1u); break; } }
    }
    nloc = mine > 0u ? mine : 1u; nx = cnt > 0u ? cnt : 1u;
}

__device__ __forceinline__ void xcd_barrier(const XcdBarrier& b) {
    asm volatile("s_waitcnt vmcnt(0)" ::: "memory");
    __syncthreads();
    if (threadIdx.x == 0) {
        unsigned* bar = b.bar;
        __builtin_amdgcn_s_waitcnt(0);
        unsigned nloc = b.st[0], nx = b.st[1];
        if (nloc == 0u) { xcd_barrier_complete(bar, b.x, nloc, nx); b.st[0] = nloc; b.st[1] = nx; }
        const unsigned old = xb_add(&bar[XB_XSUB(b.x)], 1u);
        const unsigned gen = old / nloc;
        if (old + 1u == (gen + 1u) * nloc) {
            __builtin_amdgcn_fence(__ATOMIC_RELEASE, "agent");
            asm volatile("s_waitcnt vmcnt(0)" ::: "memory");
            const unsigned og = xb_add(&bar[XB_TOP], 1u);
            const unsigned tg = og / nx;
            if (og + 1u == (tg + 1u) * nx) xb_add(&bar[XB_TOPGEN], 1u);
            else XB_SPIN(xb_ld(&bar[XB_TOPGEN]) == tg, bar);
            __builtin_amdgcn_fence(__ATOMIC_ACQUIRE, "agent");
            xb_add(&bar[XB_XGEN(b.x)], 1u);
            asm volatile("s_waitcnt vmcnt(0)" ::: "memory");
        } else {
            XB_SPIN(xb_ld(&bar[XB_XGEN(b.x)]) == gen, bar);
            __builtin_amdgcn_fence(__ATOMIC_ACQUIRE, "agent");
            asm volatile("s_waitcnt vmcnt(0)" ::: "memory");
        }
    }
    __syncthreads();
}

struct Frame {
    LAS unsigned char* lds;
    gu32* ctl;
    int tid, lane, wave;
    int vcu, G;
    const float* in[23]; float* out; unsigned char* ws;
};
enum { I_X = 0, I_C, I_WADA, I_BADA, I_GPRE1, I_WIN, I_LQ1, I_LK1, I_LQ2, I_LK2, I_GSUB, I_WCONV, I_WOUT, I_GPOST1, I_GPRE2, I_WRG, I_BRG, I_WRE, I_BRE, I_WGATE, I_WUP, I_WDOWN, I_GPOST2 };

__device__ __forceinline__ float wave_sum(float v) {
#pragma unroll
    for (int o = 1; o < 64; o <<= 1) v += __shfl_xor(v, o);
    return v;
}
__device__ __forceinline__ float modval(const Frame& F, int n) {
    const long long a = ((const long long*)(F.ctl + CW_MOD))[n];
    return F.in[I_BADA][n] + (float)a * 9.094947017729282e-13f;
}

__device__ __forceinline__ void p0_transpose_item(const float* W, int K, int N, bf16* WT, int k0, int n0, int dst_row0, LAS float* scr, int lane) {
#pragma unroll 8
    for (int i = 0; i < 32; ++i) { const int kk = 2 * i + (lane >> 5); scr[kk * 33 + (lane & 31)] = W[(size_t)(k0 + kk) * N + n0 + (lane & 31)]; }
    LDS_WAIT(); asm volatile("" ::: "memory");
    const int c = lane & 7;
#pragma unroll
    for (int j = 0; j < 4; ++j) { const int n = (lane >> 3) + 8 * j; const LAS float* s = scr + (8 * c) * 33 + n;
        v4u o; o.x = pk2(s[0 * 33], s[1 * 33]); o.y = pk2(s[2 * 33], s[3 * 33]); o.z = pk2(s[4 * 33], s[5 * 33]); o.w = pk2(s[6 * 33], s[7 * 33]);
        *(GAS v4u*)(WT + (size_t)(dst_row0 + n) * K + k0 + 8 * c) = o; }
    LDS_WAIT(); asm volatile("" ::: "memory");
}

__device__ __forceinline__ void p0_prologue(Frame& F) {
    const int gw = F.vcu * NWAVES + F.wave, NGW = F.G * NWAVES;
    {
        const float* c = F.in[I_C]; const float* W = F.in[I_WADA];
        unsigned long long* acc = (unsigned long long*)(F.ctl + CW_MOD);
        for (int it = gw; it < 48 * 32; it += NGW) {
            const int cg = it % 48, ks = it / 48, k0 = ks * 64, col = cg * 256 + F.lane * 4;
            f32x4 a = {0.f, 0.f, 0.f, 0.f};
#pragma unroll 8
            for (int kk = 0; kk < 64; ++kk) { const float cv = c[k0 + kk]; const float s = cv / (1.0f + __expf(-cv)); const f32x4 w = *(const f32x4*)(W + (size_t)(k0 + kk) * 12288 + col); a += w * s; }
#pragma unroll
            for (int i = 0; i < 4; ++i) { const long long q = __float2ll_rn(a[i] * 1099511627776.0f); atomicAdd(acc + col + i, (unsigned long long)q); }
        }
    }
    {
        float* WrT = (float*)(F.ws + WS_WRT);
        for (int idx = blockIdx.x * 512 + F.tid; idx < 36 * 2048; idx += F.G * 512) { const int j = idx >> 11, k = idx & 2047;
            WrT[idx] = (j < 4) ? F.in[I_WRG][k * 4 + j] : F.in[I_WRE][k * 32 + (j - 4)]; }
    }
    LAS float* scr = (LAS float*)(F.lds + RING_OFF + F.wave * 16384);
    constexpr int I_IN = 32 * 192, I_OUT = 32 * 64, I_G = 32 * 32 * 16, I_D = 32 * 8 * 64;
    constexpr int NITEMS = I_IN + I_OUT + 2 * I_G + I_D;
    for (int it = gw; it < NITEMS; it += NGW) {
        int r = it;
        if (r < I_IN) { const int kb = r / 192, nb = r % 192; p0_transpose_item(F.in[I_WIN], 2048, 6144, (bf16*)(F.ws + WS_WIN), 64 * kb, 32 * nb, 32 * nb, scr, F.lane); continue; } r -= I_IN;
        if (r < I_OUT) { const int kb = r / 64, nb = r % 64; p0_transpose_item(F.in[I_WOUT], 2048, 2048, (bf16*)(F.ws + WS_WOUT), 64 * kb, 32 * nb, 32 * nb, scr, F.lane); continue; } r -= I_OUT;
        if (r < 2 * I_G) { const int up = r / I_G; r -= up * I_G; const int e = r / 512, q = r % 512, kb = q / 16, nb = q % 16, n0 = 32 * nb;
            p0_transpose_item(F.in[up ? I_WUP : I_WGATE] + (size_t)e * 2048 * 512, 2048, 512, (bf16*)(F.ws + WS_W1), 64 * kb, n0, e * 1024 + (n0 >> 7) * 256 + up * 128 + (n0 & 127), scr, F.lane); continue; } r -= 2 * I_G;
        { const int e = r / 512, q = r % 512, kb = q / 64, nb = q % 64;
            p0_transpose_item(F.in[I_WDOWN] + (size_t)e * 512 * 2048, 512, 2048, (bf16*)(F.ws + WS_W2), 64 * kb, 32 * nb, e * 2048 + 32 * nb, scr, F.lane); }
    }
}

__device__ __forceinline__ void p1_norm(Frame& F) {
    LAS float* tA = (LAS float*)(F.lds + RING_OFF); LAS float* tB = tA + 2048;
    for (int i = F.tid; i < 2048; i += 512) { tA[i] = F.in[I_GPRE1][i] * (1.0f + modval(F, 2048 + i)); tB[i] = modval(F, i); }
    __syncthreads();
    const int gw = F.vcu * NWAVES + F.wave, NGW = F.G * NWAVES;
    bf16* H1 = (bf16*)(F.ws + WS_B);
    for (int m = gw; m < SEQ; m += NGW) {
        const GAS f32x4* xr = (const GAS f32x4*)(F.in[I_X] + (size_t)m * DM) + F.lane;
        f32x4 v[8]; float s = 0.f;
#pragma unroll
        for (int j = 0; j < 8; ++j) { v[j] = xr[64 * j]; s += (v[j].x * v[j].x + v[j].y * v[j].y) + (v[j].z * v[j].z + v[j].w * v[j].w); }
        const float rstd = 1.0f / sqrtf(wave_sum(s) * (1.0f / DM) + NORM_EPS);
        GAS v2u* o8 = (GAS v2u*)(H1 + (size_t)m * DM) + F.lane;
#pragma unroll
        for (int j = 0; j < 8; ++j) { const f32x4 a = *(const LAS f32x4*)(tA + 256 * j + 4 * F.lane), b = *(const LAS f32x4*)(tB + 256 * j + 4 * F.lane); const f32x4 h = v[j] * rstd * a + b;
            v2u w; w.x = pk2(h.x, h.y); w.y = pk2(h.z, h.w); o8[64 * j] = w; }
    }
    __syncthreads();
}

__device__ __forceinline__ void p3_conv(Frame& F) {
    const int gw = F.vcu * NWAVES + F.wave, NGW = F.G * NWAVES;
    const bf16* P = (const bf16*)(F.ws + WS_A); bf16* Y = (bf16*)(F.ws + WS_B); const float* wc = F.in[I_WCONV];
    for (int it = gw; it < 2048; it += NGW) {
        const int t0 = (it >> 1) * 16, ch = (it & 1) * 512 + F.lane * 8;
        float w0[8], w1[8], w2[8], z1[8], z2[8];
#pragma unroll
        for (int i = 0; i < 8; ++i) { w0[i] = wc[ch + i]; w1[i] = wc[1024 + ch + i]; w2[i] = wc[2048 + ch + i]; z1[i] = 0.f; z2[i] = 0.f; }
        for (int t = t0 - 2; t < t0 + 16; ++t) {
            if (t < 0) continue;
            const bf16* row = P + (size_t)t * att::PITCH;
            const v4u cg = *(const GAS v4u*)(row + 4096 + ch), xu = *(const GAS v4u*)(row + 5120 + ch);
            float z[8];
#pragma unroll
            for (int i = 0; i < 4; ++i) { z[2 * i] = bf_lo(cg[i]) * bf_lo(xu[i]); z[2 * i + 1] = bf_hi(cg[i]) * bf_hi(xu[i]); }
            if (t >= t0) {
                const v4u bg = *(const GAS v4u*)(row + 3072 + ch); float y[8];
#pragma unroll
                for (int i = 0; i < 4; ++i) { y[2 * i] = bf_lo(bg[i]) * (w0[2 * i] * z2[2 * i] + w1[2 * i] * z1[2 * i] + w2[2 * i] * z[2 * i]);
                    y[2 * i + 1] = bf_hi(bg[i]) * (w0[2 * i + 1] * z2[2 * i + 1] + w1[2 * i + 1] * z1[2 * i + 1] + w2[2 * i + 1] * z[2 * i + 1]); }
                v4u o; o.x = pk2(y[0], y[1]); o.y = pk2(y[2], y[3]); o.z = pk2(y[4], y[5]); o.w = pk2(y[6], y[7]);
                *(GAS v4u*)(Y + (size_t)t * DM + 1024 + ch) = o;
            }
#pragma unroll
            for (int i = 0; i < 8; ++i) { z2[i] = z1[i]; z1[i] = z[i]; }
        }
    }
}

__device__ __forceinline__ void p5_post_route(Frame& F) {
    LAS float* tG = (LAS float*)(F.lds + RING_OFF); LAS float* tA = tG + 2048; LAS float* tS = tA + 2048;
    for (int i = F.tid; i < 2048; i += 512) { tG[i] = modval(F, 4096 + i) * F.in[I_GPOST1][i]; tA[i] = F.in[I_GPRE2][i] * (1.0f + modval(F, 8192 + i)); tS[i] = modval(F, 6144 + i); }
    __syncthreads();
    const int gw = F.vcu * NWAVES + F.wave, NGW = F.G * NWAVES;
    const bf16* Y1 = (const bf16*)(F.ws + WS_A); bf16* H2 = (bf16*)(F.ws + WS_A + 64 * MiB);
    const float* WrT = (const float*)(F.ws + WS_WRT);
    float* gates = (float*)(F.ws + WS_GATES); int* list = (int*)(F.ws + WS_LIST); unsigned* cnt = (unsigned*)(F.ctl + CW_CNT);
    for (int b = gw; b < SEQ / 4; b += NGW) {
        f32x4 hv[4][8];
#pragma unroll
        for (int r = 0; r < 4; ++r) {
            const int m = 4 * b + r;
            const GAS f32x4* xr = (const GAS f32x4*)(F.in[I_X] + (size_t)m * DM) + F.lane;
            const GAS v2u* yr = (const GAS v2u*)(Y1 + (size_t)m * DM) + F.lane;
            f32x4 xv[8]; v2u yp[8]; float s1 = 0.f;
#pragma unroll
            for (int j = 0; j < 8; ++j) { xv[j] = xr[64 * j]; yp[j] = yr[64 * j]; const f32x4 y = (f32x4){bf_lo(yp[j].x), bf_hi(yp[j].x), bf_lo(yp[j].y), bf_hi(yp[j].y)};
                s1 += (y.x * y.x + y.y * y.y) + (y.z * y.z + y.w * y.w); }
            const float r1 = 1.0f / sqrtf(wave_sum(s1) * (1.0f / DM) + NORM_EPS);
            GAS f32x4* orow = (GAS f32x4*)(F.out + (size_t)m * DM) + F.lane; float s2 = 0.f;
#pragma unroll
            for (int j = 0; j < 8; ++j) { const f32x4 g = *(const LAS f32x4*)(tG + 256 * j + 4 * F.lane); const f32x4 y = (f32x4){bf_lo(yp[j].x), bf_hi(yp[j].x), bf_lo(yp[j].y), bf_hi(yp[j].y)};
                xv[j] = xv[j] + y * r1 * g; orow[64 * j] = xv[j];
                s2 += (xv[j].x * xv[j].x + xv[j].y * xv[j].y) + (xv[j].z * xv[j].z + xv[j].w * xv[j].w); }
            const float r2 = 1.0f / sqrtf(wave_sum(s2) * (1.0f / DM) + NORM_EPS);
            GAS v2u* h8 = (GAS v2u*)(H2 + (size_t)m * DM) + F.lane;
#pragma unroll
            for (int j = 0; j < 8; ++j) { const f32x4 a = *(const LAS f32x4*)(tA + 256 * j + 4 * F.lane), s = *(const LAS f32x4*)(tS + 256 * j + 4 * F.lane); const f32x4 h = xv[j] * r2 * a + s; hv[r][j] = h;
                v2u w; w.x = pk2(h.x, h.y); w.y = pk2(h.z, h.w); h8[64 * j] = w; }
            __builtin_amdgcn_sched_barrier(0);
        }
        LAS float* lg = (LAS float*)(F.lds + RING_OFF + 32768 + F.wave * 1024);
#pragma unroll 1
        for (int j = 0; j < 36; ++j) {
            const GAS f32x4* wr_ = (const GAS f32x4*)(WrT + (size_t)j * DM) + F.lane;
            float a0 = 0.f, a1 = 0.f, a2 = 0.f, a3 = 0.f;
#pragma unroll
            for (int q = 0; q < 8; ++q) { const f32x4 w = wr_[64 * q];
                a0 += (hv[0][q].x * w.x + hv[0][q].y * w.y) + (hv[0][q].z * w.z + hv[0][q].w * w.w);
                a1 += (hv[1][q].x * w.x + hv[1][q].y * w.y) + (hv[1][q].z * w.z + hv[1][q].w * w.w);
                a2 += (hv[2][q].x * w.x + hv[2][q].y * w.y) + (hv[2][q].z * w.z + hv[2][q].w * w.w);
                a3 += (hv[3][q].x * w.x + hv[3][q].y * w.y) + (hv[3][q].z * w.z + hv[3][q].w * w.w); }
            a0 = wave_sum(a0); a1 = wave_sum(a1); a2 = wave_sum(a2); a3 = wave_sum(a3);
            if (F.lane == 0) { lg[j] = a0; lg[36 + j] = a1; lg[72 + j] = a2; lg[108 + j] = a3; }
        }
        LDS_WAIT();
        if (F.lane < 4) {
            const int m = 4 * b + F.lane;
            const LAS float* mine = lg + 36 * F.lane;
            float gl[4]; int gi = 0; float gm;
#pragma unroll
            for (int g = 0; g < 4; ++g) gl[g] = mine[g] + F.in[I_BRG][g];
            gm = gl[0];
#pragma unroll
            for (int g = 1; g < 4; ++g) if (gl[g] > gm) { gm = gl[g]; gi = g; }
            float gs = 0.f;
#pragma unroll
            for (int g = 0; g < 4; ++g) gs += __expf(gl[g] - gm);
            const float gwt = 1.0f / gs;
            float el[8];
#pragma unroll
            for (int e = 0; e < 8; ++e) el[e] = mine[4 + gi * 8 + e] + F.in[I_BRE][gi * 8 + e];
            int i1 = 0; float l1 = el[0];
#pragma unroll
            for (int e = 1; e < 8; ++e) if (el[e] > l1) { l1 = el[e]; i1 = e; }
            int i2 = -1; float l2 = -INFINITY;
#pragma unroll
            for (int e = 0; e < 8; ++e) if (e != i1 && el[e] > l2) { l2 = el[e]; i2 = e; }
            const float w1 = 1.0f / (1.0f + __expf(l2 - l1)), w2 = 1.0f - w1;
            const int e1 = gi * 8 + i1, e2 = gi * 8 + i2;
            const unsigned p1 = atomicAdd(cnt + e1, 1u), p2 = atomicAdd(cnt + e2, 1u);
            list[e1 * CAP + (int)p1] = 2 * m; list[e2 * CAP + (int)p2] = 2 * m + 1;
            gates[2 * m] = gwt * w1; gates[2 * m + 1] = gwt * w2;
        }
    }
    __syncthreads();
}

__device__ __forceinline__ void p8_final(Frame& F) {
    LAS float* tG = (LAS float*)(F.lds + RING_OFF);
    for (int i = F.tid; i < 2048; i += 512) tG[i] = modval(F, 10240 + i) * F.in[I_GPOST2][i];
    __syncthreads();
    const int gw = F.vcu * NWAVES + F.wave, NGW = F.G * NWAVES;
    const bf16* Y2 = (const bf16*)(F.ws + WS_A);
    for (int m = gw; m < SEQ; m += NGW) {
        GAS f32x4* xr = (GAS f32x4*)(F.out + (size_t)m * DM) + F.lane;
        const GAS v2u* ya = (const GAS v2u*)(Y2 + (size_t)(2 * m) * DM) + F.lane; const GAS v2u* yb = (const GAS v2u*)(Y2 + (size_t)(2 * m + 1) * DM) + F.lane;
        f32x4 xv[8], yv[8]; float s = 0.f;
#pragma unroll
        for (int j = 0; j < 8; ++j) { xv[j] = xr[64 * j]; const v2u a = ya[64 * j], b = yb[64 * j];
            yv[j] = (f32x4){bf_lo(a.x) + bf_lo(b.x), bf_hi(a.x) + bf_hi(b.x), bf_lo(a.y) + bf_lo(b.y), bf_hi(a.y) + bf_hi(b.y)};
            s += (yv[j].x * yv[j].x + yv[j].y * yv[j].y) + (yv[j].z * yv[j].z + yv[j].w * yv[j].w); }
        const float rstd = 1.0f / sqrtf(wave_sum(s) * (1.0f / DM) + NORM_EPS);
#pragma unroll
        for (int j = 0; j < 8; ++j) { const f32x4 g = *(const LAS f32x4*)(tG + 256 * j + 4 * F.lane); xr[64 * j] = xv[j] + yv[j] * rstd * g; }
    }
}

template <int NPN, bool TOKEN_ROWS>
struct MoeOrder {
    static constexpr bool GATHER = true;
    const LAS int* pre; const LAS int* cntl; const int* list; int G, c;
    __device__ __forceinline__ bool next(int i, pg8::Unit& u) const {
        const int L = i * G + c; const int total = __builtin_amdgcn_readfirstlane(pre[32]);
        if (L >= total * NPN) return false;
        const int rt = L / NPN, pnl = L % NPN;
        int e = 0;
#pragma unroll 1
        for (int k = 1; k < 32; ++k) if (pre[k] <= rt) e = k;
        e = __builtin_amdgcn_readfirstlane(e);
        u.pm = rt; u.e = e; u.row0 = __builtin_amdgcn_readfirstlane((rt - pre[e]) * 256); const int left = __builtin_amdgcn_readfirstlane(cntl[e]) - u.row0; u.nvalid = left < 256 ? left : 256; u.pn = e * NPN + pnl;
        return true;
    }
    __device__ __forceinline__ void rows(const pg8::Unit& u, const int (&RA)[2], const int (&CA)[2], int K, unsigned (&v)[2][2]) const {
#pragma unroll
        for (int h = 0; h < 2; ++h)
#pragma unroll
            for (int i = 0; i < 2; ++i) { const int r = h * 128 + RA[i]; const int ts = list[u.e * CAP + u.row0 + (r < u.nvalid ? r : 0)];
                const int srow = TOKEN_ROWS ? (ts >> 1) : ts; v[h][i] = (unsigned)((srow * K + CA[i]) * 2); }
    }
};
struct EpiSwiglu {
    static constexpr bool PERM = true;
    bf16* act; const int* list; const float* gates;
    __device__ __forceinline__ void operator()(const pg8::f32x4 (&acc)[2][2][4][2], const pg8::Unit& u, int wr, int wc, int fr, int fq) const {
        const int pnl = u.pn & 3; const int col0 = pnl * 128 + wc * 32 + 8 * fq;
#pragma unroll
        for (int ai = 0; ai < 2; ++ai)
#pragma unroll
            for (int m = 0; m < 4; ++m) { const int r = ai * 128 + wr * 64 + m * 16 + fr;
                if (r < u.nvalid) { const int ts = list[u.e * CAP + u.row0 + r]; const float gt = gates[ts];
                    float o[8];
#pragma unroll
                    for (int n = 0; n < 2; ++n)
#pragma unroll
                        for (int i = 0; i < 4; ++i) { const float g = acc[ai][0][m][n][i], up = acc[ai][1][m][n][i]; o[4 * n + i] = g / (1.0f + __expf(-g)) * up * gt; }
                    pg8::u32x4 w; w.x = pg8::cvt_pk_bf16(o[0], o[1]); w.y = pg8::cvt_pk_bf16(o[2], o[3]); w.z = pg8::cvt_pk_bf16(o[4], o[5]); w.w = pg8::cvt_pk_bf16(o[6], o[7]);
                    *(pg8::u32x4*)(act + (size_t)ts * DEXP + col0) = w; } }
    }
};
struct EpiDown {
    static constexpr bool PERM = true;
    bf16* y2; const int* list;
    __device__ __forceinline__ void operator()(const pg8::f32x4 (&acc)[2][2][4][2], const pg8::Unit& u, int wr, int wc, int fr, int fq) const {
        const int pnl = u.pn & 7; const int col0 = pnl * 256 + wc * 32 + 8 * fq;
#pragma unroll
        for (int ai = 0; ai < 2; ++ai)
#pragma unroll
            for (int m = 0; m < 4; ++m) { const int r = ai * 128 + wr * 64 + m * 16 + fr;
                if (r < u.nvalid) { const int ts = list[u.e * CAP + u.row0 + r]; bf16* rowp = y2 + (size_t)ts * DM + col0;
#pragma unroll
                    for (int bj = 0; bj < 2; ++bj) { const pg8::f32x4 v0 = acc[ai][bj][m][0], v1 = acc[ai][bj][m][1];
                        pg8::u32x4 w; w.x = pg8::cvt_pk_bf16(v0[0], v0[1]); w.y = pg8::cvt_pk_bf16(v0[2], v0[3]); w.z = pg8::cvt_pk_bf16(v1[0], v1[1]); w.w = pg8::cvt_pk_bf16(v1[2], v1[3]);
                        *(pg8::u32x4*)(rowp + bj * 128) = w; } } }
    }
};
__device__ __forceinline__ void moe_tables(Frame& F) {
    LAS int* pre = (LAS int*)(F.lds + LT_PRE); LAS int* cl = (LAS int*)(F.lds + LT_CNT);
    if (F.tid == 0) { int s = 0; const unsigned* cnt = (const unsigned*)(F.ctl + CW_CNT);
        for (int e = 0; e < 32; ++e) { int c = (int)cnt[e]; c = c < 0 ? 0 : (c > CAP ? CAP : c); cl[e] = c; pre[e] = s; s += (c + 255) >> 8; } pre[32] = s; }
    __syncthreads();
}

struct Args { const float* in[23]; float* out; unsigned char* ws; int ph_lo, ph_hi; };
__global__ void __launch_bounds__(NWAVES * 64, 2) mk_fwd(Args args) {
    extern __shared__ __attribute__((aligned(16))) unsigned char lds[];
    Frame F;
    F.lds = (LAS unsigned char*)lds;
    F.tid = threadIdx.x; F.lane = F.tid & 63; F.wave = __builtin_amdgcn_readfirstlane(F.tid >> 6);
    F.G = gridDim.x; { const int bx = blockIdx.x; F.vcu = (F.G % 8 == 0) ? (bx % 8) * (F.G / 8) + bx / 8 : bx; }
    F.ws = args.ws; F.ctl = (gu32*)(args.ws + WS_CTL); F.out = args.out;
#pragma unroll
    for (int i = 0; i < 23; ++i) F.in[i] = args.in[i];
    for (int u = F.tid; u < (LDS_BYTES - LDSCTL_OFF) / 4; u += NWAVES * 64) ((LAS unsigned*)(F.lds + LDSCTL_OFF))[u] = 0u;
    __syncthreads();
    XcdBarrier bar; bar.bar = (unsigned*)(F.ctl + CW_BAR); bar.x = 0; bar.st = nullptr;
    if (N_LAUNCHES == 1) bar = xcd_barrier_post((unsigned*)(F.ctl + CW_BAR), (volatile LAS unsigned*)(F.lds + LDSCTL_OFF));
    const int lo = args.ph_lo, hi = args.ph_hi;
#define IN(k) (lo <= (k) && (k) < hi)
#define SEAM(k) do { if (IN(k) && IN((k) + 1)) xcd_barrier(bar); } while (0)
#ifdef PROBE_PHASE
#define REP(k) ((k) == PROBE_PHASE ? 2 : 1)
#else
#define REP(k) 1
#endif

    if (IN(0)) { p0_prologue(F); } SEAM(0);
    if (IN(1)) { p1_norm(F); } SEAM(1);
    if (IN(2)) {
        pg8::Gemm g{(const pg8::bf16_t*)(F.ws + WS_B), (const pg8::bf16_t*)(F.ws + WS_WIN), SEQ, NPROJ, DM}; pg8::StaticOrder S; S.init(SEQ, NPROJ, F.G, (int)blockIdx.x);
        pg8::EpiBf16 E{(pg8::bf16_t*)(F.ws + WS_A), att::PITCH, 1024, att::QSCALE, (unsigned*)(F.ctl + CW_NMAX), 2048};
        pg8::gemm_phase<pg8::EpiBf16, pg8::StaticOrder, true>(F.lds + RING_OFF, g, S, E); if (REP(2) == 2) { pg8::gemm_phase<pg8::EpiBf16, pg8::StaticOrder, true>(F.lds + RING_OFF, g, S, E); }
    } SEAM(2);
    if (IN(3)) {
        p3_conv(F);
        float lam;
        { const float a = wave_sum(F.in[I_LQ1][F.lane] * F.in[I_LK1][F.lane]), b = wave_sum(F.in[I_LQ2][F.lane] * F.in[I_LK2][F.lane]); lam = __expf(a) - __expf(b) + 0.2f; }
        const att::Tensors T{(const __hip_bfloat16*)(F.ws + WS_A), (__hip_bfloat16*)(F.ws + WS_B), F.in[I_GSUB], lam};
        const unsigned* nmx = (const unsigned*)(F.ctl + CW_NMAX);
        LAS int* qslot = (LAS int*)(F.lds + LT_CNT + 256);
#define ATT_QUEUE(VARIANT, TT, QW) for (;;) { \
            if (F.tid == 0) qslot[0] = (int)atomicAdd((unsigned*)(F.ctl + CW_QUEUE) + (QW), 1u); \
            __syncthreads(); \
            const int ui = __builtin_amdgcn_readfirstlane(qslot[0]); \
            __syncthreads(); \
            if (ui >= 1024) break; \
            const int qb = 127 - (ui >> 3), h = ui & 7;             \
            float sm = 0.f; \
            _Pragma("unroll") for (int mp = 0; mp < 2; ++mp) { const float qn = __uint_as_float(nmx[4 * h + 2 * mp]) + __uint_as_float(nmx[4 * h + 2 * mp + 1]), kn = __uint_as_float(nmx[32 + 4 * h + 2 * mp]) + __uint_as_float(nmx[32 + 4 * h + 2 * mp + 1]); \
                sm = fmaxf(sm, sqrtf(qn * kn)); } \
            const float slope2 = exp2f(-(float)(h + 1)) * att::LOG2E; \
            const float D = (2.0f * 1.02f * sm + 152.0f) / slope2; \
            int t_lo = (int)ceilf(((float)(qb * 128 - 63) - D) * (1.0f / 64.0f)); t_lo = t_lo < 0 ? 0 : t_lo; \
            t_lo = __builtin_amdgcn_readfirstlane(t_lo); \
            att::attn_unit<VARIANT>(h, qb, t_lo, TT, (att::lds_ptr)(F.lds + RING_OFF)); }
        ATT_QUEUE(0, T, 0)
#ifdef PROBE_ATT
        { const att::Tensors T2{(const __hip_bfloat16*)(F.ws + WS_A), (__hip_bfloat16*)(F.ws + WS_END), F.in[I_GSUB], lam};
          ATT_QUEUE(PROBE_ATT, T2, 64) }
#endif
#undef ATT_QUEUE
    } SEAM(3);
    if (IN(4)) {
        pg8::Gemm g{(const pg8::bf16_t*)(F.ws + WS_B), (const pg8::bf16_t*)(F.ws + WS_WOUT), SEQ, DM, DM}; pg8::StaticOrder S; S.init(SEQ, DM, F.G, (int)blockIdx.x);
        pg8::EpiBf16 E{(pg8::bf16_t*)(F.ws + WS_A), DM, 0, 1.0f, nullptr, 0};
        pg8::gemm_phase<pg8::EpiBf16, pg8::StaticOrder, true>(F.lds + RING_OFF, g, S, E); if (REP(4) == 2) { pg8::gemm_phase<pg8::EpiBf16, pg8::StaticOrder, true>(F.lds + RING_OFF, g, S, E); }
    } SEAM(4);
    if (IN(5)) { p5_post_route(F); } SEAM(5);
    if (IN(6)) {
        moe_tables(F);
        pg8::Gemm g{(const pg8::bf16_t*)(F.ws + WS_A + 64 * MiB), (const pg8::bf16_t*)(F.ws + WS_W1), SEQ, 1024, DM};
        MoeOrder<4, true> S{(const LAS int*)(F.lds + LT_PRE), (const LAS int*)(F.lds + LT_CNT), (const int*)(F.ws + WS_LIST), F.G, F.vcu};
        EpiSwiglu E{(bf16*)(F.ws + WS_A + 128 * MiB), (const int*)(F.ws + WS_LIST), (const float*)(F.ws + WS_GATES)};
        pg8::gemm_phase<EpiSwiglu, MoeOrder<4, true>, true>(F.lds + RING_OFF, g, S, E); if (REP(6) == 2) { pg8::gemm_phase<EpiSwiglu, MoeOrder<4, true>, true>(F.lds + RING_OFF, g, S, E); }
    } SEAM(6);
    if (IN(7)) {
        moe_tables(F);
        pg8::Gemm g{(const pg8::bf16_t*)(F.ws + WS_A + 128 * MiB), (const pg8::bf16_t*)(F.ws + WS_W2), 2 * SEQ, DM, DEXP};
        MoeOrder<8, false> S{(const LAS int*)(F.lds + LT_PRE), (const LAS int*)(F.lds + LT_CNT), (const int*)(F.ws + WS_LIST), F.G, F.vcu};
        EpiDown E{(bf16*)(F.ws + WS_A), (const int*)(F.ws + WS_LIST)};
        pg8::gemm_phase<EpiDown, MoeOrder<8, false>, true>(F.lds + RING_OFF, g, S, E); if (REP(7) == 2) { pg8::gemm_phase<EpiDown, MoeOrder<8, false>, true>(F.lds + RING_OFF, g, S, E); }
    } SEAM(7);
    if (IN(8)) { p8_final(F); }
#undef IN
#undef SEAM
}

extern "C" void kernel_launch(void* const* d_in, const int* in_sizes, int n_in, void* d_out, int out_size, void* d_ws, size_t ws_size, hipStream_t stream) {
    static int grid = 0;
    if (grid == 0) {
        if (n_in != 23 || in_sizes[0] != SEQ * DM || out_size != SEQ * DM || ws_size < WS_END + 64 * MiB) { fprintf(stderr, "kernel_launch: shape/workspace mismatch (n_in %d, in0 %d, out %d, ws %zu < %zu); nothing launched\n", n_in, n_in > 0 ? in_sizes[0] : -1, out_size, ws_size, (size_t)WS_END); grid = -1; return; }
        int dev = 0, cus = 0, per_cu = 0;
        if (hipGetDevice(&dev) != hipSuccess || hipDeviceGetAttribute(&cus, hipDeviceAttributeMultiprocessorCount, dev) != hipSuccess) { fprintf(stderr, "kernel_launch: hipGetDevice / hipDeviceGetAttribute failed\n"); grid = -1; return; }
        if (hipFuncSetAttribute((const void*)mk_fwd, hipFuncAttributeMaxDynamicSharedMemorySize, LDS_BYTES) != hipSuccess) { fprintf(stderr, "kernel_launch: hipFuncSetAttribute failed\n"); grid = -1; return; }
        if (hipOccupancyMaxActiveBlocksPerMultiprocessor(&per_cu, (const void*)mk_fwd, NWAVES * 64, LDS_BYTES) != hipSuccess || per_cu < 1) { fprintf(stderr, "kernel_launch: occupancy query reports %d workgroups per CU\n", per_cu); }
        (void)hipGetLastError();
        grid = cus;
    }
    if (grid < 0) return;
    if (hipMemsetAsync((char*)d_ws + WS_CTL, 0, CTL_ZERO_BYTES, stream) != hipSuccess) { fprintf(stderr, "kernel_launch: hipMemsetAsync failed\n"); return; }
    Args a{};
    for (int i = 0; i < 23; ++i) a.in[i] = (const float*)d_in[i];
    a.out = (float*)d_out; a.ws = (unsigned char*)d_ws;
    for (int li = 0; li < N_LAUNCHES; ++li) {
        a.ph_lo = (N_LAUNCHES == 1) ? 0 : li; a.ph_hi = (N_LAUNCHES == 1) ? N_PHASES : li + 1;
        hipLaunchKernelGGL(mk_fwd, dim3(grid), dim3(NWAVES * 64), LDS_BYTES, stream, a);
        const hipError_t le = hipPeekAtLastError();
        if (le != hipSuccess) { fprintf(stderr, "kernel_launch: launch %d failed: %s\n", li, hipGetErrorName(le)); break; }
    }
}
```

```cpp
#include <hip/hip_runtime.h>
#include <hip/hip_bf16.h>
#include <cstdio>
#include <cstdint>
#include <cmath>

namespace pg8 {
#define PG8_LAS __attribute__((address_space(3)))
typedef unsigned short bf16_t;
typedef short bf16x8 __attribute__((ext_vector_type(8)));
typedef float f32x4 __attribute__((ext_vector_type(4)));
typedef unsigned u32x4 __attribute__((ext_vector_type(4)));
constexpr int BM = 256, BK = 64, HALF = 128, HTB = HALF * BK * 2  , STAGE_BYTES = 8 * HTB, NXCD = 8, WGM = 8;

__host__ __device__ __forceinline__ int lds_byte(int r, int c) { const int st = (r >> 4) * 2 + (c >> 5), rr = r & 15, cc = c & 31, ob = rr * 64 + cc * 2; return st * 1024 + (ob ^ (((ob >> 9) & 1) << 5)); }
__host__ __device__ __forceinline__ void stage_rc(int b, int& R, int& C) { const int st = b / 1024, sb = b % 1024, swz = sb ^ (((sb >> 9) & 1) << 5); R = (st >> 1) * 16 + swz / 64; C = (st & 1) * 32 + (swz % 64) / 2; }
__host__ __device__ __forceinline__ int perm32(int rho) { const int n = rho >> 4, i = rho & 15; return 8 * (i >> 2) + 4 * n + (i & 3); }

struct Unit { int pm, pn; int e, row0, nvalid; };
struct Gemm { const bf16_t* A; const bf16_t* Bt; int M, N, K; };

struct StaticOrder {
    static constexpr bool GATHER = false;
    int nM, nN, nwg, G, c;
    __host__ __device__ void init(int M, int N, int G_, int c_) { nM = M / BM; nN = N / BM; nwg = nM * nN; G = G_; c = c_; }
    __device__ __forceinline__ bool next(int i, Unit& u) const {
        const long L = (long)i * G + c; if (L >= nwg) return false;
        int wgid = (int)L; { const int q = nwg / NXCD, r = nwg % NXCD, xcd = wgid % NXCD, off = wgid / NXCD; wgid = (xcd < r ? xcd * (q + 1) : r * (q + 1) + (xcd - r) * q) + off; }
        const int nig = WGM * nN, gid = wgid / nig, fm = gid * WGM, gsz = (nM - fm) < WGM ? (nM - fm) : WGM;
        u.pm = fm + ((wgid % nig) % gsz); u.pn = (wgid % nig) / gsz; u.e = 0; u.row0 = 0; u.nvalid = 256; return true;
    }
    __device__ __forceinline__ void rows(const Unit& u, const int (&RA)[2], const int (&CA)[2], int K, unsigned (&v)[2][2]) const {
#pragma unroll
        for (int h = 0; h < 2; ++h)
#pragma unroll
            for (int i = 0; i < 2; ++i) v[h][i] = (unsigned)(((u.pm * BM + h * HALF + RA[i]) * K + CA[i]) * 2);
    }
};

__device__ __forceinline__ unsigned cvt_pk_bf16(float lo, float hi) { unsigned r; asm volatile("v_cvt_pk_bf16_f32 %0, %1, %2" : "=v"(r) : "v"(lo), "v"(hi)); return r; }

struct EpiBf16 {
    static constexpr bool PERM = true;
    bf16_t* O; int ldc; int scale_cols; float scale0;
    unsigned* nmax; int nmax_cols;
    __device__ __forceinline__ void operator()(const f32x4 (&acc)[2][2][4][2], const Unit& u, int wr, int wc, int fr, int fq) const {
        const int row0 = u.pm * BM + wr * 64 + fr; const int colt = u.pn * BM;
        const float sc = (colt < scale_cols) ? scale0 : 1.f;
        const int col0 = colt + wc * 32 + 8 * fq;
        const bool donorm = (nmax != nullptr) && (colt < nmax_cols);
        float nm[2] = {0.f, 0.f};
#pragma unroll
        for (int ai = 0; ai < 2; ++ai)
#pragma unroll
            for (int m = 0; m < 4; ++m) { bf16_t* rowp = O + (size_t)(row0 + ai * HALF + m * 16) * ldc + col0;
#pragma unroll
                for (int bj = 0; bj < 2; ++bj) { f32x4 v0 = acc[ai][bj][m][0] * sc, v1 = acc[ai][bj][m][1] * sc;
                    u32x4 w; w.x = cvt_pk_bf16(v0[0], v0[1]); w.y = cvt_pk_bf16(v0[2], v0[3]); w.z = cvt_pk_bf16(v1[0], v1[1]); w.w = cvt_pk_bf16(v1[2], v1[3]);
                    *(u32x4*)(rowp + bj * HALF) = w;
                    if (donorm) { float ss = (v0[0] * v0[0] + v0[1] * v0[1]) + (v0[2] * v0[2] + v0[3] * v0[3]) + (v1[0] * v1[0] + v1[1] * v1[1]) + (v1[2] * v1[2] + v1[3] * v1[3]);
                        ss += __shfl_xor(ss, 16); ss += __shfl_xor(ss, 32); nm[bj] = fmaxf(nm[bj], ss); } } }
        if (donorm) {
#pragma unroll
            for (int bj = 0; bj < 2; ++bj) { float v = nm[bj];
#pragma unroll
                for (int o = 1; o < 16; o <<= 1) v = fmaxf(v, __shfl_xor(v, o));
                if ((threadIdx.x & 63) == 0) atomicMax(nmax + (colt >> 5) + 4 * bj + wc, __float_as_uint(v)); }
        }
    }
};

template <class Epi, class Sched, bool ALIGN_EPI = false>
__device__ __forceinline__ void gemm_phase(PG8_LAS unsigned char* lds, const Gemm g, const Sched& S, const Epi& E) {
    const int tid = threadIdx.x, wid = __builtin_amdgcn_readfirstlane(tid >> 6), lane = tid & 63, wr = wid >> 2, wc = wid & 3, fr = lane & 15, fq = lane >> 4;
    const int K = g.K, nt = K / BK;
    int RA[2], CA[2]; unsigned voffB[2];
#pragma unroll
    for (int i = 0; i < 2; ++i) { int R, C; stage_rc(tid * 16 + i * 8192, R, C); const int Rb = Epi::PERM ? ((R & ~31) + perm32(R & 31)) : R;
        RA[i] = R; CA[i] = C; voffB[i] = (unsigned)(Rb * K + C) * 2u; }
    const size_t kstep = (size_t)(BK * 2);
    const size_t hstep = (size_t)HALF * K * 2;
    const size_t tstep = 2 * hstep;
    const unsigned ldsw = (unsigned)wid * 1024u;
    const int aoff = lds_byte(wr * 64 + fr, fq * 8), boff = lds_byte(wc * 32 + fr, fq * 8);
    const char* const Abase = (const char*)g.A;
#define PG8_SA(b, h) (((b) * 2 + (h)) * HTB)
#define PG8_SB(b, h) ((4 + (b) * 2 + (h)) * HTB)
#define PG8_STAGE(bufoff, gbase, voff) do { _Pragma("unroll") for (int _i = 0; _i < 2; ++_i) \
        __builtin_amdgcn_global_load_lds((const unsigned*)((const char*)(gbase) + (voff)[_i]), (PG8_LAS unsigned*)(lds + (bufoff) + ldsw + _i * 8192), 16, 0, 0); } while (0)
#define PG8_STAGE_A(bufoff, v0, v1, kb) do { \
        __builtin_amdgcn_global_load_lds((const unsigned*)(Abase + (size_t)((v0) + (kb))), (PG8_LAS unsigned*)(lds + (bufoff) + ldsw), 16, 0, 0); \
        __builtin_amdgcn_global_load_lds((const unsigned*)(Abase + (size_t)((v1) + (kb))), (PG8_LAS unsigned*)(lds + (bufoff) + ldsw + 8192), 16, 0, 0); } while (0)
#define PG8_LDA(dst, b, h) do { _Pragma("unroll") for (int m = 0; m < 4; ++m) _Pragma("unroll") for (int k = 0; k < 2; ++k) dst[m][k] = *(const PG8_LAS bf16x8*)(lds + PG8_SA(b, h) + aoff + m * 2048 + k * 1024); } while (0)
#define PG8_LDB(dst, b, h) do { _Pragma("unroll") for (int n = 0; n < 2; ++n) _Pragma("unroll") for (int k = 0; k < 2; ++k) dst[n][k] = *(const PG8_LAS bf16x8*)(lds + PG8_SB(b, h) + boff + n * 2048 + k * 1024); } while (0)
#define PG8_MMA(ai, bj, At, Bt) do { __builtin_amdgcn_s_setprio(1); _Pragma("unroll") for (int m = 0; m < 4; ++m) _Pragma("unroll") for (int n = 0; n < 2; ++n) _Pragma("unroll") for (int k = 0; k < 2; ++k) \
        acc[ai][bj][m][n] = __builtin_amdgcn_mfma_f32_16x16x32_bf16(Bt[n][k], At[m][k], acc[ai][bj][m][n], 0, 0, 0); __builtin_amdgcn_s_setprio(0); } while (0)
#define PG8_WAIT_V(n) asm volatile("s_waitcnt vmcnt(" #n ")" ::: "memory")
#define PG8_WAIT_L(n) asm volatile("s_waitcnt lgkmcnt(" #n ")" ::: "memory")
#define PG8_BAR __builtin_amdgcn_s_barrier()
#define PG8_SCHED __builtin_amdgcn_sched_barrier(0)
    Unit cur, nxt; int ui = 0;
    if (!S.next(0, cur)) return;
    f32x4 acc[2][2][4][2];
#pragma unroll
    for (int a = 0; a < 2; ++a)
#pragma unroll
        for (int b = 0; b < 2; ++b)
#pragma unroll
            for (int m = 0; m < 4; ++m)
#pragma unroll
                for (int n = 0; n < 2; ++n) acc[a][b][m][n] = (f32x4){0.f, 0.f, 0.f, 0.f};
    bf16x8 At[4][2], B0[2][2], B1[2][2];
    unsigned vAc[2][2], vAn[2][2];
    S.rows(cur, RA, CA, K, vAc);
    const char* cB = (const char*)g.Bt + (size_t)cur.pn * tstep;
    PG8_STAGE(PG8_SB(0, 0), cB, voffB); PG8_STAGE(PG8_SB(0, 1), cB + hstep, voffB); PG8_STAGE_A(PG8_SA(0, 0), vAc[0][0], vAc[0][1], 0u); PG8_STAGE_A(PG8_SA(0, 1), vAc[1][0], vAc[1][1], 0u);
    if (wr == 1) PG8_BAR;
    PG8_WAIT_V(2); PG8_BAR;
    PG8_STAGE(PG8_SB(1, 0), cB + kstep, voffB); PG8_STAGE_A(PG8_SA(1, 0), vAc[0][0], vAc[0][1], (unsigned)kstep); PG8_STAGE(PG8_SB(1, 1), cB + hstep + kstep, voffB);
    PG8_WAIT_V(6); PG8_BAR;
    for (;;) {
        const bool has_next = S.next(ui + 1, nxt);
        if (has_next) S.rows(nxt, RA, CA, K, vAn);
        else { vAn[0][0] = vAc[0][0]; vAn[0][1] = vAc[0][1]; vAn[1][0] = vAc[1][0]; vAn[1][1] = vAc[1][1]; }
        const char* nB = has_next ? (const char*)g.Bt + (size_t)nxt.pn * tstep : cB;
        for (int t = 0; t < nt; t += 2) {
            const bool last = (t == nt - 2);
            const unsigned kb1 = (unsigned)(t + 1) * (unsigned)kstep;
            const unsigned kb2 = last ? 0u : (unsigned)(t + 2) * (unsigned)kstep, kb3 = kb2 + (unsigned)kstep;
            const unsigned x00 = last ? vAn[0][0] : vAc[0][0], x01 = last ? vAn[0][1] : vAc[0][1], x10 = last ? vAn[1][0] : vAc[1][0], x11 = last ? vAn[1][1] : vAc[1][1];
            const char* b2 = last ? nB : cB + (size_t)(t + 2) * kstep; const char* b3 = b2 + kstep;
            PG8_LDB(B0, 0, 0); PG8_LDB(B1, 0, 1); PG8_SCHED; PG8_LDA(At, 0, 0); PG8_STAGE_A(PG8_SA(1, 1), vAc[1][0], vAc[1][1], kb1);
            PG8_WAIT_V(8); PG8_WAIT_L(0); PG8_BAR; PG8_MMA(0, 0, At, B0); PG8_MMA(0, 1, At, B1); PG8_BAR; PG8_SCHED;
            PG8_LDA(At, 0, 1); PG8_STAGE(PG8_SB(0, 0), b2, voffB); PG8_STAGE(PG8_SB(0, 1), b2 + hstep, voffB); PG8_STAGE_A(PG8_SA(0, 0), x00, x01, kb2);
            PG8_WAIT_V(8); PG8_WAIT_L(0); PG8_BAR; PG8_MMA(1, 0, At, B0); PG8_MMA(1, 1, At, B1); PG8_BAR; PG8_SCHED;
            PG8_LDB(B0, 1, 0); PG8_LDB(B1, 1, 1); PG8_SCHED; PG8_LDA(At, 1, 0); PG8_STAGE_A(PG8_SA(0, 1), x10, x11, kb2);
            PG8_WAIT_V(8); PG8_WAIT_L(0); PG8_BAR; PG8_MMA(0, 0, At, B0); PG8_MMA(0, 1, At, B1); PG8_BAR; PG8_SCHED;
            PG8_LDA(At, 1, 1); PG8_STAGE(PG8_SB(1, 0), b3, voffB); PG8_STAGE(PG8_SB(1, 1), b3 + hstep, voffB); PG8_STAGE_A(PG8_SA(1, 0), x00, x01, kb3);
            PG8_WAIT_V(8); PG8_WAIT_L(0); PG8_BAR; PG8_MMA(1, 0, At, B0); PG8_MMA(1, 1, At, B1); PG8_BAR; PG8_SCHED;
        }
        if constexpr (ALIGN_EPI) { if (wr == 0) PG8_BAR; }
        E(acc, cur, wr, wc, fr, fq);
        if (!has_next) break;
#pragma unroll
        for (int a = 0; a < 2; ++a)
#pragma unroll
            for (int b = 0; b < 2; ++b)
#pragma unroll
                for (int m = 0; m < 4; ++m)
#pragma unroll
                    for (int n = 0; n < 2; ++n) acc[a][b][m][n] = (f32x4){0.f, 0.f, 0.f, 0.f};
        cur = nxt; cB = nB; ++ui;
        vAc[0][0] = vAn[0][0]; vAc[0][1] = vAn[0][1]; vAc[1][0] = vAn[1][0]; vAc[1][1] = vAn[1][1];
        if constexpr (ALIGN_EPI) { if (wr == 1) PG8_BAR; }
    }
    PG8_WAIT_V(0);
    if constexpr (!ALIGN_EPI) { if (wr == 0) PG8_BAR; }
    PG8_BAR;
#undef PG8_SA
#undef PG8_SB
#undef PG8_STAGE
#undef PG8_STAGE_A
#undef PG8_LDA
#undef PG8_LDB
#undef PG8_MMA
#undef PG8_WAIT_V
#undef PG8_WAIT_L
#undef PG8_BAR
#undef PG8_SCHED
}
}

namespace att {
typedef __attribute__((address_space(3))) const char* lds_cptr;
typedef __attribute__((address_space(3))) char* lds_ptr;
using bf16x8 = __attribute__((ext_vector_type(8))) short;
using s16x4 = __attribute__((ext_vector_type(4))) short;
using f32x16 = __attribute__((ext_vector_type(16))) float;
using f32x4 = __attribute__((ext_vector_type(4))) float;
using u32x4 = __attribute__((ext_vector_type(4))) unsigned;
typedef short v4i16_t __attribute__((ext_vector_type(4)));
typedef float f32x2_t __attribute__((ext_vector_type(2))); typedef __bf16 bf16x2_t __attribute__((ext_vector_type(2)));
constexpr int PITCH = 6144 + 128;
constexpr int COL_Q = 0, COL_K = 1024, COL_V = 2048;
constexpr int SLOT = 16384;
constexpr int NSLOT = 4, L_K = 0, L_V = NSLOT * SLOT, L_X = 0, XSTRIDE = 17408, L_WS = 131072 + 2048, LDS_BYTES = L_WS + 8 * 256;
constexpr float LOG2E = 1.4426950408889634f;
constexpr float QSCALE = 0.125f * LOG2E;
constexpr float THR = 6.0f;

__device__ __forceinline__ int crow(int r, int hi) { return (r & 3) + 8 * (r >> 2) + 4 * hi; }
__device__ __forceinline__ void glds16(const void* sbase, unsigned voff, unsigned lds_dst) { unsigned keep;
    asm volatile("s_mov_b32 %0, m0\n\ts_mov_b32 m0, %3\n\ts_nop 0\n\tglobal_load_lds_dwordx4 %1, %2\n\ts_mov_b32 m0, %0" : "=&s"(keep) : "v"(voff), "s"(sbase), "s"(lds_dst) : "memory"); }
__device__ __forceinline__ float max3f(float a, float b, float c) { float r; asm("v_max3_f32 %0, %1, %2, %3" : "=v"(r) : "v"(a), "v"(b), "v"(c)); return r; }
__device__ __forceinline__ float max2f(float a, float b) { float r; asm("v_max_f32_e32 %0, %1, %2" : "=v"(r) : "v"(a), "v"(b)); return r; }
__device__ __forceinline__ unsigned cvtpk_s(float lo, float hi) { f32x2_t v = {lo, hi}; bf16x2_t b = __builtin_convertvector(v, bf16x2_t); return __builtin_bit_cast(unsigned, b); }
__device__ __forceinline__ s16x4 vtr(lds_cptr p) { return __builtin_bit_cast(s16x4, __builtin_amdgcn_ds_read_tr16_b64_v4i16((__attribute__((address_space(3))) v4i16_t*)p)); }

struct Tensors { const __hip_bfloat16* proj; __hip_bfloat16* ycat; const float* g_subln; float lam; };

__device__ __forceinline__ float xhalf(float v) { return __shfl_xor(v, 32); }

struct WaveState { f32x16 o[4]; float mhat, l_reg; u32x4 pw0, pw1, pw2, pw3; };
__device__ __forceinline__ void att_qksm(WaveState& st, const bf16x8 (&qr)[4], lds_cptr kb, const int (&kof)[4], __attribute__((address_space(3))) float* wsf, const float (&cst)[16],
                                         float slope2, int qpos, int t, bool diag, int r32, int hi) {
    f32x16 p0, p1;
    bf16x8 kf[8];
#pragma unroll
    for (int d0 = 0; d0 < 4; ++d0) { kf[2 * d0] = *(const __attribute__((address_space(3))) bf16x8*)(kb + kof[d0]); kf[2 * d0 + 1] = *(const __attribute__((address_space(3))) bf16x8*)(kb + kof[d0] + 8192); }
    __builtin_amdgcn_sched_barrier(0);
    const float dq = (float)(qpos - t * 64 - 4 * hi);
    if (diag) {
#pragma unroll
        for (int r = 0; r < 16; ++r) { const float d0_ = dq - (float)((r & 3) + 8 * (r >> 2)); p0[r] = -slope2 * fabsf(d0_) - st.mhat; p1[r] = -slope2 * fabsf(d0_ - 32.f) - st.mhat; }
    } else {
        const float A0 = -slope2 * dq - st.mhat, A1 = A0 + 32.f * slope2;
#pragma unroll
        for (int r = 0; r < 16; ++r) { p0[r] = A0 + cst[r]; p1[r] = A1 + cst[r]; }
    }
    __builtin_amdgcn_sched_barrier(0);
#pragma unroll
    for (int d0 = 0; d0 < 4; ++d0) {
        p0 = __builtin_amdgcn_mfma_f32_32x32x16_bf16(kf[2 * d0], qr[d0], p0, 0, 0, 0);
        p1 = __builtin_amdgcn_mfma_f32_32x32x16_bf16(kf[2 * d0 + 1], qr[d0], p1, 0, 0, 0);
    }
    asm volatile("s_nop 15\n\ts_nop 7" : "+v"(p0), "+v"(p1));
    float rm;
    { float a_ = max3f(p0[0], p0[1], p1[0]), b_ = max3f(p0[2], p0[3], p1[1]); a_ = max3f(a_, p1[2], p1[3]);
#pragma unroll
      for (int r = 4; r < 16; r += 4) { a_ = max3f(a_, p0[r], p0[r + 1]); b_ = max3f(b_, p0[r + 2], p0[r + 3]); a_ = max3f(a_, p1[r], p1[r + 1]); b_ = max3f(b_, p1[r + 2], p1[r + 3]); }
      rm = max2f(a_, b_); }
    { auto rr = __builtin_amdgcn_permlane32_swap(__float_as_uint(rm), __float_as_uint(rm), false, false); rm = max2f(__uint_as_float(rr[0]), __uint_as_float(rr[1])); }
    if (diag || __any(rm > THR)) {
        const float dl = diag ? rm : fmaxf(rm, 0.f);
        st.mhat += dl;
#pragma unroll
        for (int r = 0; r < 16; ++r) { p0[r] -= dl; p1[r] -= dl; }
        if (!diag) {
            const float f = __builtin_amdgcn_exp2f(-dl); st.l_reg *= f;
            if (hi == 0) wsf[r32] = f;
            asm volatile("s_waitcnt lgkmcnt(0)" ::: "memory");
            float fr_[16];
#pragma unroll
            for (int r = 0; r < 16; ++r) fr_[r] = wsf[crow(r, hi)];
#pragma unroll
            for (int d = 0; d < 4; ++d)
#pragma unroll
                for (int r = 0; r < 16; ++r) st.o[d][r] *= fr_[r];
        }
    }
    float sacc = 0.f;
#pragma unroll
    for (int r = 0; r < 16; ++r) { p0[r] = __builtin_amdgcn_exp2f(p0[r]); p1[r] = __builtin_amdgcn_exp2f(p1[r]); sacc += p0[r] + p1[r]; }
    st.l_reg += sacc;
    st.pw0 = (u32x4){cvtpk_s(p0[0], p0[1]), cvtpk_s(p0[2], p0[3]), cvtpk_s(p0[4], p0[5]), cvtpk_s(p0[6], p0[7])};
    st.pw1 = (u32x4){cvtpk_s(p0[8], p0[9]), cvtpk_s(p0[10], p0[11]), cvtpk_s(p0[12], p0[13]), cvtpk_s(p0[14], p0[15])};
    st.pw2 = (u32x4){cvtpk_s(p1[0], p1[1]), cvtpk_s(p1[2], p1[3]), cvtpk_s(p1[4], p1[5]), cvtpk_s(p1[6], p1[7])};
    st.pw3 = (u32x4){cvtpk_s(p1[8], p1[9]), cvtpk_s(p1[10], p1[11]), cvtpk_s(p1[12], p1[13]), cvtpk_s(p1[14], p1[15])};
}
__device__ __forceinline__ void att_pv(WaveState& st, lds_cptr vb, const int (&vof)[2]) {
    s16x4 alo[4], ahi[4], blo[4], bhi[4];
#define ATT_RD(LO, HI, db) do { _Pragma("unroll") for (int ks = 0; ks < 4; ++ks) { LO[ks] = vtr(vb + (vof[0] ^ (64 * (db))) + ks * 4096); HI[ks] = vtr(vb + (vof[1] ^ (64 * (db))) + ks * 4096); } } while (0)
#define ATT_PK(LO, HI, k) (bf16x8){LO[k][0], LO[k][1], LO[k][2], LO[k][3], HI[k][0], HI[k][1], HI[k][2], HI[k][3]}
#define ATT_MM(LO, HI, db) do { \
        st.o[db] = __builtin_amdgcn_mfma_f32_32x32x16_bf16(__builtin_bit_cast(bf16x8, st.pw0), ATT_PK(LO, HI, 0), st.o[db], 0, 0, 0); \
        st.o[db] = __builtin_amdgcn_mfma_f32_32x32x16_bf16(__builtin_bit_cast(bf16x8, st.pw1), ATT_PK(LO, HI, 1), st.o[db], 0, 0, 0); \
        st.o[db] = __builtin_amdgcn_mfma_f32_32x32x16_bf16(__builtin_bit_cast(bf16x8, st.pw2), ATT_PK(LO, HI, 2), st.o[db], 0, 0, 0); \
        st.o[db] = __builtin_amdgcn_mfma_f32_32x32x16_bf16(__builtin_bit_cast(bf16x8, st.pw3), ATT_PK(LO, HI, 3), st.o[db], 0, 0, 0); } while (0)
    ATT_RD(alo, ahi, 0); ATT_RD(blo, bhi, 1); __builtin_amdgcn_sched_barrier(0);
    ATT_MM(alo, ahi, 0); __builtin_amdgcn_sched_barrier(0);
    ATT_RD(alo, ahi, 2); __builtin_amdgcn_sched_barrier(0);
    ATT_MM(blo, bhi, 1); __builtin_amdgcn_sched_barrier(0);
    ATT_RD(blo, bhi, 3); __builtin_amdgcn_sched_barrier(0);
    ATT_MM(alo, ahi, 2); __builtin_amdgcn_sched_barrier(0);
    ATT_MM(blo, bhi, 3);
#undef ATT_RD
#undef ATT_PK
#undef ATT_MM
}

__device__ __forceinline__ void att_step(WaveState& st, bool pend, lds_cptr vbp, const int (&vof)[2], const bf16x8 (&qr)[4], lds_cptr kb, int kof,
                                         __attribute__((address_space(3))) float* wsf, const float (&cst)[16], float slope2, int qpos, int t, bool diag, int r32, int hi) {
    f32x16 p0, p1;
    bf16x8 kf[8];
#pragma unroll
    for (int d0 = 0; d0 < 4; ++d0) { kf[2 * d0] = *(const __attribute__((address_space(3))) bf16x8*)(kb + (kof ^ (32 * d0))); kf[2 * d0 + 1] = *(const __attribute__((address_space(3))) bf16x8*)(kb + (kof ^ (32 * d0)) + 8192); }
    __builtin_amdgcn_sched_barrier(0);
    const float dq = (float)(qpos - t * 64 - 4 * hi);
    if (diag) {
#pragma unroll
        for (int r = 0; r < 16; ++r) { const float d0_ = dq - (float)((r & 3) + 8 * (r >> 2)); p0[r] = -slope2 * fabsf(d0_) - st.mhat; p1[r] = -slope2 * fabsf(d0_ - 32.f) - st.mhat; }
    } else {
        float s2v = slope2; asm volatile("" : "+v"(s2v));
        const float A0 = -s2v * dq - st.mhat, A1 = A0 + 32.f * s2v;
#pragma unroll
        for (int r = 0; r < 16; ++r) { const float cr = (float)((r & 3) + 8 * (r >> 2)); p0[r] = fmaf(cr, s2v, A0); p1[r] = fmaf(cr, s2v, A1); }
    }
    __builtin_amdgcn_sched_barrier(0);
#pragma unroll
    for (int d0 = 0; d0 < 4; ++d0) {
        p0 = __builtin_amdgcn_mfma_f32_32x32x16_bf16(kf[2 * d0], qr[d0], p0, 0, 0, 0);
        p1 = __builtin_amdgcn_mfma_f32_32x32x16_bf16(kf[2 * d0 + 1], qr[d0], p1, 0, 0, 0);
    }
    asm volatile("s_nop 15\n\ts_nop 7" : "+v"(p0), "+v"(p1));
    float rm;
    { float a_ = max3f(p0[0], p0[1], p1[0]), b_ = max3f(p0[2], p0[3], p1[1]); a_ = max3f(a_, p1[2], p1[3]);
#pragma unroll
      for (int r = 4; r < 16; r += 4) { a_ = max3f(a_, p0[r], p0[r + 1]); b_ = max3f(b_, p0[r + 2], p0[r + 3]); a_ = max3f(a_, p1[r], p1[r + 1]); b_ = max3f(b_, p1[r + 2], p1[r + 3]); }
      rm = max2f(a_, b_); }
    { auto rr = __builtin_amdgcn_permlane32_swap(__float_as_uint(rm), __float_as_uint(rm), false, false); rm = max2f(__uint_as_float(rr[0]), __uint_as_float(rr[1])); }
    const bool need = diag || __any(rm > THR);
    float f = 1.0f;
    if (need) {
        const float dl = diag ? rm : fmaxf(rm, 0.f);
        st.mhat += dl;
#pragma unroll
        for (int r = 0; r < 16; ++r) { p0[r] -= dl; p1[r] -= dl; }
        if (!diag) f = __builtin_amdgcn_exp2f(-dl);
    }
    u32x4 nw0, nw1, nw2, nw3; float sacc = 0.f;
    if (pend) {
        s16x4 alo[4], ahi[4], blo[4], bhi[4];
#define ATT_RD(LO, HI, db) do { _Pragma("unroll") for (int ks = 0; ks < 4; ++ks) { LO[ks] = vtr(vbp + (vof[0] ^ (64 * (db))) + ks * 4096); HI[ks] = vtr(vbp + (vof[1] ^ (64 * (db))) + ks * 4096); } } while (0)
#define ATT_PK(LO, HI, k) (bf16x8){LO[k][0], LO[k][1], LO[k][2], LO[k][3], HI[k][0], HI[k][1], HI[k][2], HI[k][3]}
#define ATT_GAP(db, ks, LO, HI, PW, E0, E1, NW) do { \
        st.o[db] = __builtin_amdgcn_mfma_f32_32x32x16_bf16(__builtin_bit_cast(bf16x8, PW), ATT_PK(LO, HI, ks), st.o[db], 0, 0, 0); \
        E0 = __builtin_amdgcn_exp2f(E0); E1 = __builtin_amdgcn_exp2f(E1); sacc += E0; sacc += E1; NW = cvtpk_s(E0, E1); __builtin_amdgcn_sched_barrier(0); } while (0)
        ATT_RD(alo, ahi, 0); ATT_RD(blo, bhi, 1); __builtin_amdgcn_sched_barrier(0);
        ATT_GAP(0, 0, alo, ahi, st.pw0, p0[0], p0[1], nw0.x); ATT_GAP(0, 1, alo, ahi, st.pw1, p0[2], p0[3], nw0.y); ATT_GAP(0, 2, alo, ahi, st.pw2, p0[4], p0[5], nw0.z); ATT_GAP(0, 3, alo, ahi, st.pw3, p0[6], p0[7], nw0.w);
        ATT_RD(alo, ahi, 2); __builtin_amdgcn_sched_barrier(0);
        ATT_GAP(1, 0, blo, bhi, st.pw0, p0[8], p0[9], nw1.x); ATT_GAP(1, 1, blo, bhi, st.pw1, p0[10], p0[11], nw1.y); ATT_GAP(1, 2, blo, bhi, st.pw2, p0[12], p0[13], nw1.z); ATT_GAP(1, 3, blo, bhi, st.pw3, p0[14], p0[15], nw1.w);
        ATT_RD(blo, bhi, 3); __builtin_amdgcn_sched_barrier(0);
        ATT_GAP(2, 0, alo, ahi, st.pw0, p1[0], p1[1], nw2.x); ATT_GAP(2, 1, alo, ahi, st.pw1, p1[2], p1[3], nw2.y); ATT_GAP(2, 2, alo, ahi, st.pw2, p1[4], p1[5], nw2.z); ATT_GAP(2, 3, alo, ahi, st.pw3, p1[6], p1[7], nw2.w);
        ATT_GAP(3, 0, blo, bhi, st.pw0, p1[8], p1[9], nw3.x); ATT_GAP(3, 1, blo, bhi, st.pw1, p1[10], p1[11], nw3.y); ATT_GAP(3, 2, blo, bhi, st.pw2, p1[12], p1[13], nw3.z); ATT_GAP(3, 3, blo, bhi, st.pw3, p1[14], p1[15], nw3.w);
#undef ATT_RD
#undef ATT_PK
#undef ATT_GAP
    } else {
#pragma unroll
        for (int r = 0; r < 16; ++r) { p0[r] = __builtin_amdgcn_exp2f(p0[r]); p1[r] = __builtin_amdgcn_exp2f(p1[r]); sacc += p0[r] + p1[r]; }
        nw0 = (u32x4){cvtpk_s(p0[0], p0[1]), cvtpk_s(p0[2], p0[3]), cvtpk_s(p0[4], p0[5]), cvtpk_s(p0[6], p0[7])};
        nw1 = (u32x4){cvtpk_s(p0[8], p0[9]), cvtpk_s(p0[10], p0[11]), cvtpk_s(p0[12], p0[13]), cvtpk_s(p0[14], p0[15])};
        nw2 = (u32x4){cvtpk_s(p1[0], p1[1]), cvtpk_s(p1[2], p1[3]), cvtpk_s(p1[4], p1[5]), cvtpk_s(p1[6], p1[7])};
        nw3 = (u32x4){cvtpk_s(p1[8], p1[9]), cvtpk_s(p1[10], p1[11]), cvtpk_s(p1[12], p1[13]), cvtpk_s(p1[14], p1[15])};
    }
    st.l_reg = st.l_reg * f + sacc; st.pw0 = nw0; st.pw1 = nw1; st.pw2 = nw2; st.pw3 = nw3;
    if (need && !diag) {
        if (hi == 0) wsf[r32] = f;
        asm volatile("s_waitcnt lgkmcnt(0)" ::: "memory");
        float fr_[16];
#pragma unroll
        for (int r = 0; r < 16; ++r) fr_[r] = wsf[crow(r, hi)];
#pragma unroll
        for (int d = 0; d < 4; ++d)
#pragma unroll
            for (int r = 0; r < 16; ++r) st.o[d][r] *= fr_[r];
    }
}

template <int VAR>
__device__ __forceinline__ void attn_unit(int h, int qb, int t_lo, const Tensors& T, lds_ptr shm) {
    typedef __hip_bfloat16 bf16;
    const int tid = threadIdx.x, lane = tid & 63, r32 = lane & 31, hi = lane >> 5; const int wid = __builtin_amdgcn_readfirstlane(tid >> 6);
    const int rb = wid & 3, mp = wid >> 2;
    const int q0 = qb * 128 + rb * 32;
    const int cw = q0 >> 6;
    const int NT = 2 * qb + 2;
    const bf16* Qw = T.proj + (size_t)q0 * PITCH + COL_Q + h * 128 + mp * 64;
    const bf16* Kh = T.proj + COL_K + h * 128; const bf16* Vh = T.proj + COL_V + h * 128;
    const unsigned lds0 = (unsigned)(uintptr_t)shm;
    __attribute__((address_space(3))) float* wsf = (__attribute__((address_space(3))) float*)(shm + L_WS + wid * 256);
    const unsigned dvoff = (unsigned)(((lane >> 4) * PITCH + ((lane & 15) ^ (((lane >> 4) << 2) | (wid & 3))) * 8) * 2);
    const bf16* kpc = Kh + (size_t)(wid * 4) * PITCH; const bf16* vpc = Vh + (size_t)(wid * 4) * PITCH;
    const unsigned kdst = lds0 + L_K + wid * 1024, vdst = lds0 + L_V + wid * 1024;
#define ATT_DMA(t, ks, vs) do { const size_t toff_ = (size_t)(t) * 64 * PITCH; const unsigned ko_ = (unsigned)(ks) * SLOT, vo_ = (unsigned)(vs) * SLOT; \
        glds16(kpc + toff_, dvoff, (unsigned)__builtin_amdgcn_readfirstlane(kdst + ko_)); glds16(kpc + toff_ + (size_t)32 * PITCH, dvoff, (unsigned)__builtin_amdgcn_readfirstlane(kdst + ko_ + 8192)); \
        glds16(vpc + toff_, dvoff, (unsigned)__builtin_amdgcn_readfirstlane(vdst + vo_)); glds16(vpc + toff_ + (size_t)32 * PITCH, dvoff, (unsigned)__builtin_amdgcn_readfirstlane(vdst + vo_ + 8192)); } while (0)
    const int n_t = NT - t_lo;
    ATT_DMA(NT - 1, 0, 0);
    if (n_t > 1) ATT_DMA(NT - 2, 1, 1);
    bf16x8 qr[4];
#pragma unroll
    for (int d0 = 0; d0 < 4; ++d0) qr[d0] = *reinterpret_cast<const bf16x8*>(&Qw[(size_t)r32 * PITCH + d0 * 16 + hi * 8]);
    const float slope2 = exp2f(-(float)(h + 1)) * LOG2E;
    const float cst[16] = {};
    WaveState st; st.mhat = 0.f; st.l_reg = 0.f;
#pragma unroll
    for (int d = 0; d < 4; ++d) st.o[d] = f32x16{};
    st.pw0 = st.pw1 = st.pw2 = st.pw3 = (u32x4){0u, 0u, 0u, 0u};
    int kof, vof[2];
    { const int xr = ((r32 & 3) << 2) | ((r32 >> 2) & 3);
      kof = 256 * r32 + 16 * ((8 * mp + hi) ^ xr);
      const int q_ = (lane & 15) >> 2, p_ = lane & 3, blk = (lane >> 4) & 1;
#pragma unroll
      for (int t_ = 0; t_ < 2; ++t_) { const int row = 8 * t_ + 4 * hi + q_; const int xv = ((row & 3) << 2) | ((row >> 2) & 3);
          vof[t_] = 256 * row + 16 * ((2 * blk + (p_ >> 1)) ^ xv) + 8 * (p_ & 1); } }
    const lds_cptr kb0 = (lds_cptr)shm + L_K; const lds_cptr vb0 = (lds_cptr)shm + L_V;
    const int qpos = q0 + r32;
    bool pend = false; int pend_vs = 0;
#pragma unroll 1
    for (int j = 0; j < n_t; ++j) {
        const int t = NT - 1 - j, sl = j & 3;
        if (j + 1 < n_t) asm volatile("s_waitcnt vmcnt(4)" ::: "memory"); else asm volatile("s_waitcnt vmcnt(0)" ::: "memory");
        __builtin_amdgcn_s_barrier(); asm volatile("" ::: "memory");
        if (mp == 0 && j + 2 < n_t) ATT_DMA(t - 2, (j + 2) & 3, (j + 2) & 3);
        const bool act = (t <= cw);
        if (VAR != 2) { if (act) { att_step(st, pend, vb0 + pend_vs * SLOT, vof, qr, kb0 + sl * SLOT, kof, wsf, cst, slope2, qpos, t, t == cw, r32, hi); pend = true; pend_vs = sl; } }
        if (mp == 1 && j + 2 < n_t) ATT_DMA(t - 2, (j + 2) & 3, (j + 2) & 3);
        asm volatile("s_waitcnt lgkmcnt(0)" ::: "memory");
    }
#undef ATT_DMA
    if (VAR != 2) { if (pend) att_pv(st, vb0 + pend_vs * SLOT, vof); }
    asm volatile("s_waitcnt vmcnt(0) lgkmcnt(0)" ::: "memory"); __builtin_amdgcn_s_barrier(); asm volatile("" ::: "memory");
    float l_reg = st.l_reg; f32x16 (&o)[4] = st.o;
    l_reg += xhalf(l_reg);
    if (hi == 0) wsf[32 + r32] = l_reg;
    asm volatile("s_waitcnt lgkmcnt(0)" ::: "memory");
    float rli[16];
#pragma unroll
    for (int r = 0; r < 16; ++r) rli[r] = 1.0f / wsf[32 + crow(r, hi)];
    __attribute__((address_space(3))) float* X = (__attribute__((address_space(3))) float*)(shm + L_X + rb * XSTRIDE);
    if (mp == 1) {
#pragma unroll
        for (int d = 0; d < 4; ++d)
#pragma unroll
            for (int r = 0; r < 16; ++r) X[(d * 16 + r) * 64 + lane] = o[d][r] * rli[r];
    }
    asm volatile("s_waitcnt lgkmcnt(0)" ::: "memory"); __builtin_amdgcn_s_barrier(); asm volatile("" ::: "memory");
    if (mp == 0) {
        const float lam = T.lam;
#pragma unroll
        for (int d = 0; d < 4; ++d)
#pragma unroll
            for (int r = 0; r < 16; ++r) o[d][r] = o[d][r] * rli[r] - lam * X[(d * 16 + r) * 64 + lane];
        asm volatile("s_waitcnt lgkmcnt(0)" ::: "memory");
#pragma unroll
        for (int d = 0; d < 4; ++d)
#pragma unroll
            for (int r = 0; r < 16; ++r) X[crow(r, hi) * 132 + d * 32 + r32] = o[d][r];
        asm volatile("s_waitcnt lgkmcnt(0)" ::: "memory");
        f32x4 v[16]; float ss = 0.f;
#pragma unroll
        for (int i = 0; i < 16; ++i) { v[i] = *(const __attribute__((address_space(3))) f32x4*)(X + r32 * 132 + hi * 64 + 4 * i); ss += (v[i].x * v[i].x + v[i].y * v[i].y) + (v[i].z * v[i].z + v[i].w * v[i].w); }
        ss += xhalf(ss);
        const float rstd = 0.8f / sqrtf(ss * (1.0f / 128.0f) + 1e-5f);
        bf16* Ow = T.ycat + (size_t)(q0 + r32) * 2048 + h * 128 + hi * 64;
        const float* gs = T.g_subln + hi * 64;
#pragma unroll
        for (int i = 0; i < 8; ++i) {
            const f32x4 g0 = *(const f32x4*)(gs + 8 * i), g1 = *(const f32x4*)(gs + 8 * i + 4); const f32x4 a = v[2 * i] * rstd * g0, b = v[2 * i + 1] * rstd * g1;
            u32x4 w; w.x = cvtpk_s(a.x, a.y); w.y = cvtpk_s(a.z, a.w); w.z = cvtpk_s(b.x, b.y); w.w = cvtpk_s(b.z, b.w);
            *(u32x4*)(Ow + 8 * i) = w;
        }
    }
    asm volatile("s_waitcnt lgkmcnt(0)" ::: "memory"); __builtin_amdgcn_s_barrier(); asm volatile("" ::: "memory");
}
}

constexpr int NWAVES = 8;
constexpr int SEQ = 16384, DM = 2048, NPROJ = 6144, NHEAD = 8, NEXP = 32, DEXP = 512, CAP = 16384;
constexpr float NORM_EPS = 1e-6f;
#ifndef MK_N_LAUNCHES
#define MK_N_LAUNCHES 1
#endif
constexpr int N_PHASES = 9;
constexpr int N_LAUNCHES = MK_N_LAUNCHES;

constexpr size_t MiB = 1u << 20;
constexpr size_t WS_CTL = 0, CTL_ZERO_BYTES = 1 * MiB;
constexpr size_t WS_WRT = 1 * MiB;
constexpr size_t WS_GATES = 2 * MiB;
constexpr size_t WS_LIST = 3 * MiB;
constexpr size_t WS_WIN = 6 * MiB;
constexpr size_t WS_WOUT = 30 * MiB;
constexpr size_t WS_W1 = 38 * MiB;
constexpr size_t WS_W2 = 166 * MiB;
constexpr size_t WS_B = 230 * MiB;
constexpr size_t WS_A = 294 * MiB;
constexpr size_t WS_END = 494 * MiB;
constexpr int CW_BAR = 4096;
constexpr int CW_NMAX = 8448;
constexpr int CW_QUEUE = 8704;
constexpr int CW_CNT = 8192;
constexpr int CW_MOD = 16384;

constexpr int RING_OFF = 0, RING_BYTES = 131072;
constexpr int LDSCTL_OFF = RING_BYTES;
constexpr int LDS_BYTES = 147456;
constexpr int LT_PRE = LDSCTL_OFF + 256, LT_CNT = LT_PRE + 34 * 4;

#define GAS __attribute__((address_space(1)))
#define LAS __attribute__((address_space(3)))
typedef unsigned short bf16;
typedef unsigned v4u __attribute__((ext_vector_type(4)));
typedef unsigned v2u __attribute__((ext_vector_type(2)));
typedef float f32x4 __attribute__((ext_vector_type(4)));
typedef GAS unsigned gu32;
#define RLX_AGENT __ATOMIC_RELAXED, __HIP_MEMORY_SCOPE_AGENT
#define LDS_WAIT() asm volatile("s_waitcnt lgkmcnt(0)" ::: "memory")
#define VM_WAIT() asm volatile("s_waitcnt vmcnt(0)" ::: "memory")
__device__ __forceinline__ unsigned f2bf(float f) { unsigned u = __builtin_bit_cast(unsigned, f); return (u + 0x7fffu + ((u >> 16) & 1u)) >> 16; }
__device__ __forceinline__ unsigned pk2(float lo, float hi) { return f2bf(lo) | (f2bf(hi) << 16); }
__device__ __forceinline__ float bf_lo(unsigned w) { return __builtin_bit_cast(float, w << 16); }
__device__ __forceinline__ float bf_hi(unsigned w) { return __builtin_bit_cast(float, w & 0xffff0000u); }

#define XB_TMO      128
#define XB_XCNT(j)  (256  + 64 * (j))
#define XB_XSUB(j)  (1280 + 64 * (j))
#define XB_XGEN(j)  (2304 + 64 * (j))
#define XB_TOP      3328
#define XB_TOPGEN   3392
#define XCD_BAR_WORDS 3456
#define XB_SPIN_CAP (1u << 18)

__device__ __forceinline__ unsigned xb_ld(unsigned* p)              { return __hip_atomic_load(p, __ATOMIC_RELAXED, __HIP_MEMORY_SCOPE_AGENT); }
__device__ __forceinline__ unsigned xb_add(unsigned* p, unsigned v) { return __hip_atomic_fetch_add(p, v, __ATOMIC_RELAXED, __HIP_MEMORY_SCOPE_AGENT); }
__device__ __forceinline__ unsigned xb_xcc_id() { return (unsigned)__builtin_amdgcn_s_getreg((3 << 11) | 20) & 0xFu; }
#define XB_SPIN(cond, bar) do { unsigned _sp = 0; while (cond) { __builtin_amdgcn_s_sleep(1); \
    if ((++_sp & 255u) == 0u) { if (xb_ld(&(bar)[XB_TMO])) break; if (_sp > XB_SPIN_CAP) { atomicAdd(&(bar)[XB_TMO], 1u); break; } } } } while (0)

struct XcdBarrier {
    unsigned* bar; unsigned x;
    volatile LAS unsigned* st;
};

__device__ __forceinline__ XcdBarrier xcd_barrier_post(unsigned* bar, volatile LAS unsigned* st) {
    XcdBarrier b; b.bar = bar; b.x = xb_xcc_id(); b.st = st;
    if (threadIdx.x == 0) (void)xb_add(&bar[XB_XCNT(b.x)], 1u);
    return b;
}
__device__ __forceinline__ void xcd_barrier_complete(unsigned* bar, unsigned x, unsigned& nloc, unsigned& nx) {
    const unsigned G = gridDim.x * gridDim.y * gridDim.z;
    unsigned sum, cnt, mine, sp = 0u;
    for (;;) {
        sum = 0u; cnt = 0u; mine = 0u;
#pragma unroll
        for (unsigned j = 0; j < 16; ++j) { const unsigned c = xb_ld(&bar[XB_XCNT(j)]); sum += c; cnt += (c > 0u) ? 1u : 0u; mine = (j == x) ? c : mine; }
        if (sum == G) break;
        __builtin_amdgcn_s_sleep(1);
        if ((++sp & 255u) == 0u) { if (xb_ld(&bar[XB_TMO])) break; if (sp > XB_SPIN_CAP) { atomicAdd(&bar[XB_TMO], 1u); break; } }
    }
    nloc = mine > 0u ? mine : 1u; nx = cnt > 0u ? cnt : 1u;
}

__device__ __forceinline__ void xcd_barrier(const XcdBarrier& b) {
    asm volatile("s_waitcnt vmcnt(0)" ::: "memory");
    __syncthreads();
    if (threadIdx.x == 0) {
        unsigned* bar = b.bar;
        __builtin_amdgcn_s_waitcnt(0);
        unsigned nloc = b.st[0], nx = b.st[1];
        if (nloc == 0u) { xcd_barrier_complete(bar, b.x, nloc, nx); b.st[0] = nloc; b.st[1] = nx; }
        const unsigned old = xb_add(&bar[XB_XSUB(b.x)], 1u);
        const unsigned gen = old / nloc;
        if (old + 1u == (gen + 1u) * nloc) {
            __builtin_amdgcn_fence(__ATOMIC_RELEASE, "agent");
            asm volatile("s_waitcnt vmcnt(0)" ::: "memory");
            const unsigned og = xb_add(&bar[XB_TOP], 1u);
            const unsigned tg = og / nx;
            if (og + 1u == (tg + 1u) * nx) xb_add(&bar[XB_TOPGEN], 1u);
            else XB_SPIN(xb_ld(&bar[XB_TOPGEN]) == tg, bar);
            __builtin_amdgcn_fence(__ATOMIC_ACQUIRE, "agent");
            xb_add(&bar[XB_XGEN(b.x)], 1u);
            asm volatile("s_waitcnt vmcnt(0)" ::: "memory");
        } else {
            XB_SPIN(xb_ld(&bar[XB_XGEN(b.x)]) == gen, bar);
            __builtin_amdgcn_fence(__ATOMIC_ACQUIRE, "agent");
            asm volatile("s_waitcnt vmcnt(0)" ::: "memory");
        }
    }
    __syncthreads();
}

struct Frame {
    LAS unsigned char* lds;
    gu32* ctl;
    int tid, lane, wave;
    int vcu, G;
    const float* in[23]; float* out; unsigned char* ws;
};
enum { I_X = 0, I_C, I_WADA, I_BADA, I_GPRE1, I_WIN, I_LQ1, I_LK1, I_LQ2, I_LK2, I_GSUB, I_WCONV, I_WOUT, I_GPOST1, I_GPRE2, I_WRG, I_BRG, I_WRE, I_BRE, I_WGATE, I_WUP, I_WDOWN, I_GPOST2 };

__device__ __forceinline__ float wave_sum(float v) {
#pragma unroll
    for (int o = 1; o < 64; o <<= 1) v += __shfl_xor(v, o);
    return v;
}
__device__ __forceinline__ float modval(const Frame& F, int n) {
    const long long a = ((const long long*)(F.ctl + CW_MOD))[n];
    return F.in[I_BADA][n] + (float)a * 9.094947017729282e-13f;
}

__device__ __forceinline__ void p0_transpose_item(const float* W, int K, int N, bf16* WT, int k0, int n0, int dst_row0, LAS float* scr, int lane) {
    float t_[32];
#pragma unroll
    for (int i = 0; i < 32; ++i) { const int kk = 2 * i + (lane >> 5); t_[i] = W[(size_t)(k0 + kk) * N + n0 + (lane & 31)]; }
#pragma unroll
    for (int i = 0; i < 32; ++i) { const int kk = 2 * i + (lane >> 5); scr[kk * 33 + (lane & 31)] = t_[i]; }
    LDS_WAIT(); asm volatile("" ::: "memory");
    const int c = lane & 7;
#pragma unroll
    for (int j = 0; j < 4; ++j) { const int n = (lane >> 3) + 8 * j; const LAS float* s = scr + (8 * c) * 33 + n;
        v4u o; o.x = pk2(s[0 * 33], s[1 * 33]); o.y = pk2(s[2 * 33], s[3 * 33]); o.z = pk2(s[4 * 33], s[5 * 33]); o.w = pk2(s[6 * 33], s[7 * 33]);
        *(GAS v4u*)(WT + (size_t)(dst_row0 + n) * K + k0 + 8 * c) = o; }
    LDS_WAIT(); asm volatile("" ::: "memory");
}

constexpr int CVT_I_IN = 32 * 192, CVT_I_OUT = 32 * 64, CVT_I_G = 32 * 32 * 16, CVT_I_D = 32 * 8 * 64, CVT_NITEMS = CVT_I_IN + CVT_I_OUT + 2 * CVT_I_G + CVT_I_D;
constexpr int CVT_CHUNK = 64, CVT_NCHUNK = (CVT_NITEMS - CVT_I_IN + CVT_CHUNK - 1) / CVT_CHUNK;
__device__ __forceinline__ void cvt_item(Frame& F, int it, LAS float* scr) {
    int r = it;
    if (r < CVT_I_IN) { const int kb = r / 192, nb = r % 192; p0_transpose_item(F.in[I_WIN], 2048, 6144, (bf16*)(F.ws + WS_WIN), 64 * kb, 32 * nb, 32 * nb, scr, F.lane); return; } r -= CVT_I_IN;
    if (r < CVT_I_OUT) { const int kb = r / 64, nb = r % 64; p0_transpose_item(F.in[I_WOUT], 2048, 2048, (bf16*)(F.ws + WS_WOUT), 64 * kb, 32 * nb, 32 * nb, scr, F.lane); return; } r -= CVT_I_OUT;
    if (r < 2 * CVT_I_G) { const int up = r / CVT_I_G; r -= up * CVT_I_G; const int e = r / 512, q = r % 512, kb = q / 16, nb = q % 16, n0 = 32 * nb;
        p0_transpose_item(F.in[up ? I_WUP : I_WGATE] + (size_t)e * 2048 * 512, 2048, 512, (bf16*)(F.ws + WS_W1), 64 * kb, n0, e * 1024 + (n0 >> 7) * 256 + up * 128 + (n0 & 127), scr, F.lane); return; } r -= 2 * CVT_I_G;
    { const int e = r / 512, q = r % 512, kb = q / 64, nb = q % 64;
        p0_transpose_item(F.in[I_WDOWN] + (size_t)e * 512 * 2048, 512, 2048, (bf16*)(F.ws + WS_W2), 64 * kb, 32 * nb, e * 2048 + 32 * nb, scr, F.lane); }
}
__device__ __forceinline__ void cvt_chunk(Frame& F, int c) {
    LAS float* scr = (LAS float*)(F.lds + RING_OFF + F.wave * 16384);
    const int base = CVT_I_IN + c * CVT_CHUNK + F.wave * 8;
#pragma unroll 1
    for (int i = 0; i < 8; ++i) { const int it = base + i; if (it < CVT_NITEMS) cvt_item(F, it, scr); }
}
__device__ __forceinline__ void p0_prologue(Frame& F) {
    const int gw = F.vcu * NWAVES + F.wave, NGW = F.G * NWAVES;
    {
        const float* c = F.in[I_C]; const float* W = F.in[I_WADA];
        unsigned long long* acc = (unsigned long long*)(F.ctl + CW_MOD);
        for (int it = gw; it < 48 * 32; it += NGW) {
            const int cg = it % 48, ks = it / 48, k0 = ks * 64, col = cg * 256 + F.lane * 4;
            f32x4 a = {0.f, 0.f, 0.f, 0.f};
#pragma unroll 16
            for (int kk = 0; kk < 64; ++kk) { const float cv = c[k0 + kk]; const float s = cv / (1.0f + __expf(-cv)); const f32x4 w = *(const f32x4*)(W + (size_t)(k0 + kk) * 12288 + col); a += w * s; }
#pragma unroll
            for (int i = 0; i < 4; ++i) { const long long q = __float2ll_rn(a[i] * 1099511627776.0f); atomicAdd(acc + col + i, (unsigned long long)q); }
        }
    }
    {
        float* WrT = (float*)(F.ws + WS_WRT);
        for (int idx = blockIdx.x * 512 + F.tid; idx < 36 * 2048; idx += F.G * 512) { const int j = idx >> 11, k = idx & 2047;
            WrT[idx] = (j < 4) ? F.in[I_WRG][k * 4 + j] : F.in[I_WRE][k * 32 + (j - 4)]; }
    }
    LAS float* scr = (LAS float*)(F.lds + RING_OFF + F.wave * 16384);
    for (int it = gw; it < CVT_I_IN; it += NGW) cvt_item(F, it, scr);
#if defined(PROBE_PHASE) && PROBE_PHASE == 0
    for (int it = gw; it < CVT_NITEMS; it += NGW) cvt_item(F, it, scr);
#endif
}

__device__ __forceinline__ void p1_norm(Frame& F) {
    LAS float* tA = (LAS float*)(F.lds + RING_OFF); LAS float* tB = tA + 2048;
    for (int i = F.tid; i < 2048; i += 512) { tA[i] = F.in[I_GPRE1][i] * (1.0f + modval(F, 2048 + i)); tB[i] = modval(F, i); }
    __syncthreads();
    const int gw = F.vcu * NWAVES + F.wave, NGW = F.G * NWAVES;
    bf16* H1 = (bf16*)(F.ws + WS_B);
    for (int m = gw; m < SEQ; m += NGW) {
        const GAS f32x4* xr = (const GAS f32x4*)(F.in[I_X] + (size_t)m * DM) + F.lane;
        f32x4 v[8]; float s = 0.f;
#pragma unroll
        for (int j = 0; j < 8; ++j) { v[j] = xr[64 * j]; s += (v[j].x * v[j].x + v[j].y * v[j].y) + (v[j].z * v[j].z + v[j].w * v[j].w); }
        const float rstd = 1.0f / sqrtf(wave_sum(s) * (1.0f / DM) + NORM_EPS);
        GAS v2u* o8 = (GAS v2u*)(H1 + (size_t)m * DM) + F.lane;
#pragma unroll
        for (int j = 0; j < 8; ++j) { const f32x4 a = *(const LAS f32x4*)(tA + 256 * j + 4 * F.lane), b = *(const LAS f32x4*)(tB + 256 * j + 4 * F.lane); const f32x4 h = v[j] * rstd * a + b;
            v2u w; w.x = pk2(h.x, h.y); w.y = pk2(h.z, h.w); o8[64 * j] = w; }
    }
    __syncthreads();
}

__device__ __noinline__ void p3_conv_item(const bf16* P, bf16* Y, const float* wc, int it, int lane) {
    {
        const int t0 = (it >> 1) * 16, ch = (it & 1) * 512 + lane * 8;
        float w0[8], w1[8], w2[8], z1[8], z2[8];
#pragma unroll
        for (int i = 0; i < 8; ++i) { w0[i] = wc[ch + i]; w1[i] = wc[1024 + ch + i]; w2[i] = wc[2048 + ch + i]; z1[i] = 0.f; z2[i] = 0.f; }
        for (int t = t0 - 2; t < t0 + 16; ++t) {
            if (t < 0) continue;
            const bf16* row = P + (size_t)t * att::PITCH;
            const v4u cg = *(const GAS v4u*)(row + 4096 + ch), xu = *(const GAS v4u*)(row + 5120 + ch);
            float z[8];
#pragma unroll
            for (int i = 0; i < 4; ++i) { z[2 * i] = bf_lo(cg[i]) * bf_lo(xu[i]); z[2 * i + 1] = bf_hi(cg[i]) * bf_hi(xu[i]); }
            if (t >= t0) {
                const v4u bg = *(const GAS v4u*)(row + 3072 + ch); float y[8];
#pragma unroll
                for (int i = 0; i < 4; ++i) { y[2 * i] = bf_lo(bg[i]) * (w0[2 * i] * z2[2 * i] + w1[2 * i] * z1[2 * i] + w2[2 * i] * z[2 * i]);
                    y[2 * i + 1] = bf_hi(bg[i]) * (w0[2 * i + 1] * z2[2 * i + 1] + w1[2 * i + 1] * z1[2 * i + 1] + w2[2 * i + 1] * z[2 * i + 1]); }
                v4u o; o.x = pk2(y[0], y[1]); o.y = pk2(y[2], y[3]); o.z = pk2(y[4], y[5]); o.w = pk2(y[6], y[7]);
                *(GAS v4u*)(Y + (size_t)t * DM + 1024 + ch) = o;
            }
#pragma unroll
            for (int i = 0; i < 8; ++i) { z2[i] = z1[i]; z1[i] = z[i]; }
        }
    }
}
constexpr int SIDE_NCHUNK = CVT_NCHUNK + 2048 / NWAVES;
__device__ __forceinline__ void side_chunk(Frame& F, int c) {
    if (c < CVT_NCHUNK) cvt_chunk(F, c); else p3_conv_item((const bf16*)(F.ws + WS_A), (bf16*)(F.ws + WS_B), F.in[I_WCONV], (c - CVT_NCHUNK) * NWAVES + F.wave, F.lane);
}

__device__ __forceinline__ void p5_post_route(Frame& F) {
    LAS float* tG = (LAS float*)(F.lds + RING_OFF); LAS float* tA = tG + 2048; LAS float* tS = tA + 2048;
    for (int i = F.tid; i < 2048; i += 512) { tG[i] = modval(F, 4096 + i) * F.in[I_GPOST1][i]; tA[i] = F.in[I_GPRE2][i] * (1.0f + modval(F, 8192 + i)); tS[i] = modval(F, 6144 + i); }
    __syncthreads();
    const int gw = F.vcu * NWAVES + F.wave, NGW = F.G * NWAVES;
    const bf16* Y1 = (const bf16*)(F.ws + WS_A); bf16* H2 = (bf16*)(F.ws + WS_A + 64 * MiB);
    const float* WrT = (const float*)(F.ws + WS_WRT);
    float* gates = (float*)(F.ws + WS_GATES); int* slotix = (int*)(F.ws + WS_GATES + 256 * 1024); int* list = (int*)(F.ws + WS_LIST); unsigned* cnt = (unsigned*)(F.ctl + CW_CNT);
    for (int b = gw; b < SEQ / 4; b += NGW) {
        f32x4 hv[4][8];
#pragma unroll
        for (int r = 0; r < 4; ++r) {
            const int m = 4 * b + r;
            const GAS f32x4* xr = (const GAS f32x4*)(F.in[I_X] + (size_t)m * DM) + F.lane;
            const GAS v2u* yr = (const GAS v2u*)(Y1 + (size_t)m * DM) + F.lane;
            f32x4 xv[8]; v2u yp[8]; float s1 = 0.f;
#pragma unroll
            for (int j = 0; j < 8; ++j) { xv[j] = xr[64 * j]; yp[j] = yr[64 * j]; const f32x4 y = (f32x4){bf_lo(yp[j].x), bf_hi(yp[j].x), bf_lo(yp[j].y), bf_hi(yp[j].y)};
                s1 += (y.x * y.x + y.y * y.y) + (y.z * y.z + y.w * y.w); }
            const float r1 = 1.0f / sqrtf(wave_sum(s1) * (1.0f / DM) + NORM_EPS);
            GAS f32x4* orow = (GAS f32x4*)(F.out + (size_t)m * DM) + F.lane; float s2 = 0.f;
#pragma unroll
            for (int j = 0; j < 8; ++j) { const f32x4 g = *(const LAS f32x4*)(tG + 256 * j + 4 * F.lane); const f32x4 y = (f32x4){bf_lo(yp[j].x), bf_hi(yp[j].x), bf_lo(yp[j].y), bf_hi(yp[j].y)};
                xv[j] = xv[j] + y * r1 * g; orow[64 * j] = xv[j];
                s2 += (xv[j].x * xv[j].x + xv[j].y * xv[j].y) + (xv[j].z * xv[j].z + xv[j].w * xv[j].w); }
            const float r2 = 1.0f / sqrtf(wave_sum(s2) * (1.0f / DM) + NORM_EPS);
            GAS v2u* h8 = (GAS v2u*)(H2 + (size_t)m * DM) + F.lane;
#pragma unroll
            for (int j = 0; j < 8; ++j) { const f32x4 a = *(const LAS f32x4*)(tA + 256 * j + 4 * F.lane), s = *(const LAS f32x4*)(tS + 256 * j + 4 * F.lane); const f32x4 h = xv[j] * r2 * a + s; hv[r][j] = h;
                v2u w; w.x = pk2(h.x, h.y); w.y = pk2(h.z, h.w); h8[64 * j] = w; }
            __builtin_amdgcn_sched_barrier(0);
        }
        LAS float* lg = (LAS float*)(F.lds + RING_OFF + 32768 + F.wave * 1024);
#pragma unroll 1
        for (int j = 0; j < 36; ++j) {
            const GAS f32x4* wr_ = (const GAS f32x4*)(WrT + (size_t)j * DM) + F.lane;
            float a0 = 0.f, a1 = 0.f, a2 = 0.f, a3 = 0.f;
#pragma unroll
            for (int q = 0; q < 8; ++q) { const f32x4 w = wr_[64 * q];
                a0 += (hv[0][q].x * w.x + hv[0][q].y * w.y) + (hv[0][q].z * w.z + hv[0][q].w * w.w);
                a1 += (hv[1][q].x * w.x + hv[1][q].y * w.y) + (hv[1][q].z * w.z + hv[1][q].w * w.w);
                a2 += (hv[2][q].x * w.x + hv[2][q].y * w.y) + (hv[2][q].z * w.z + hv[2][q].w * w.w);
                a3 += (hv[3][q].x * w.x + hv[3][q].y * w.y) + (hv[3][q].z * w.z + hv[3][q].w * w.w); }
            a0 = wave_sum(a0); a1 = wave_sum(a1); a2 = wave_sum(a2); a3 = wave_sum(a3);
            if (F.lane == 0) { lg[j] = a0; lg[36 + j] = a1; lg[72 + j] = a2; lg[108 + j] = a3; }
        }
        LDS_WAIT();
        if (F.lane < 4) {
            const int m = 4 * b + F.lane;
            const LAS float* mine = lg + 36 * F.lane;
            float gl[4]; int gi = 0; float gm;
#pragma unroll
            for (int g = 0; g < 4; ++g) gl[g] = mine[g] + F.in[I_BRG][g];
            gm = gl[0];
#pragma unroll
            for (int g = 1; g < 4; ++g) if (gl[g] > gm) { gm = gl[g]; gi = g; }
            float gs = 0.f;
#pragma unroll
            for (int g = 0; g < 4; ++g) gs += __expf(gl[g] - gm);
            const float gwt = 1.0f / gs;
            float el[8];
#pragma unroll
            for (int e = 0; e < 8; ++e) el[e] = mine[4 + gi * 8 + e] + F.in[I_BRE][gi * 8 + e];
            int i1 = 0; float l1 = el[0];
#pragma unroll
            for (int e = 1; e < 8; ++e) if (el[e] > l1) { l1 = el[e]; i1 = e; }
            int i2 = -1; float l2 = -INFINITY;
#pragma unroll
            for (int e = 0; e < 8; ++e) if (e != i1 && el[e] > l2) { l2 = el[e]; i2 = e; }
            const float w1 = 1.0f / (1.0f + __expf(l2 - l1)), w2 = 1.0f - w1;
            const int e1 = gi * 8 + i1, e2 = gi * 8 + i2;
            const unsigned p1 = atomicAdd(cnt + e1, 1u), p2 = atomicAdd(cnt + e2, 1u);
            list[e1 * CAP + (int)p1] = 2 * m; list[e2 * CAP + (int)p2] = 2 * m + 1;
            slotix[2 * m] = e1 * CAP + (int)p1; slotix[2 * m + 1] = e2 * CAP + (int)p2;
            gates[2 * m] = gwt * w1; gates[2 * m + 1] = gwt * w2;
        }
    }
    __syncthreads();
}

__device__ __forceinline__ void p8_final(Frame& F) {
    LAS float* tG = (LAS float*)(F.lds + RING_OFF);
    for (int i = F.tid; i < 2048; i += 512) tG[i] = modval(F, 10240 + i) * F.in[I_GPOST2][i];
    __syncthreads();
    const int gw = F.vcu * NWAVES + F.wave, NGW = F.G * NWAVES;
    const bf16* Y2 = (const bf16*)(F.ws + WS_A);
    const float* gates = (const float*)(F.ws + WS_GATES); const int* slotix = (const int*)(F.ws + WS_GATES + 256 * 1024);
    const LAS int* pre = (const LAS int*)(F.lds + LT_PRE);
    for (int m = gw; m < SEQ; m += NGW) {
        GAS f32x4* xr = (GAS f32x4*)(F.out + (size_t)m * DM) + F.lane;
        const int i0 = slotix[2 * m], i1 = slotix[2 * m + 1]; const float g0 = gates[2 * m], g1 = gates[2 * m + 1];
        const int r0 = pre[i0 >> 14] * 256 + (i0 & (CAP - 1)), r1 = pre[i1 >> 14] * 256 + (i1 & (CAP - 1));
        const GAS v2u* ya = (const GAS v2u*)(Y2 + (size_t)r0 * DM) + F.lane; const GAS v2u* yb = (const GAS v2u*)(Y2 + (size_t)r1 * DM) + F.lane;
        f32x4 xv[8], yv[8]; float s = 0.f;
#pragma unroll
        for (int j = 0; j < 8; ++j) { xv[j] = xr[64 * j]; const v2u a = ya[64 * j], b = yb[64 * j];
            yv[j] = (f32x4){g0 * bf_lo(a.x) + g1 * bf_lo(b.x), g0 * bf_hi(a.x) + g1 * bf_hi(b.x), g0 * bf_lo(a.y) + g1 * bf_lo(b.y), g0 * bf_hi(a.y) + g1 * bf_hi(b.y)};
            s += (yv[j].x * yv[j].x + yv[j].y * yv[j].y) + (yv[j].z * yv[j].z + yv[j].w * yv[j].w); }
        const float rstd = 1.0f / sqrtf(wave_sum(s) * (1.0f / DM) + NORM_EPS);
#pragma unroll
        for (int j = 0; j < 8; ++j) { const f32x4 g = *(const LAS f32x4*)(tG + 256 * j + 4 * F.lane); xr[64 * j] = xv[j] + yv[j] * rstd * g; }
    }
}

template <int NPN, bool TOKEN_ROWS>
struct MoeOrder {
    static constexpr bool GATHER = true;
    const LAS int* pre; const LAS int* cntl; const int* list; int G, c;
    __device__ __forceinline__ bool next(int i, pg8::Unit& u) const {
        const int L = i * G + c; const int total = __builtin_amdgcn_readfirstlane(pre[32]);
        if (L >= total * NPN) return false;
        const int rt = L / NPN, pnl = L % NPN;
        int e = 0;
#pragma unroll 1
        for (int k = 1; k < 32; ++k) if (pre[k] <= rt) e = k;
        e = __builtin_amdgcn_readfirstlane(e);
        u.pm = rt; u.e = e; u.row0 = __builtin_amdgcn_readfirstlane((rt - pre[e]) * 256); const int left = __builtin_amdgcn_readfirstlane(cntl[e]) - u.row0; u.nvalid = left < 256 ? left : 256; u.pn = e * NPN + pnl;
        return true;
    }
    __device__ __forceinline__ void rows(const pg8::Unit& u, const int (&RA)[2], const int (&CA)[2], int K, unsigned (&v)[2][2]) const {
#pragma unroll
        for (int h = 0; h < 2; ++h)
#pragma unroll
            for (int i = 0; i < 2; ++i) { const int r = h * 128 + RA[i];
                if (TOKEN_ROWS) { const int ts = list[u.e * CAP + u.row0 + (r < u.nvalid ? r : 0)]; v[h][i] = (unsigned)(((ts >> 1) * K + CA[i]) * 2); }
                else v[h][i] = (unsigned)(((u.pm * 256 + r) * K + CA[i]) * 2); }
    }
};
struct EpiSwiglu {
    static constexpr bool PERM = true;
    bf16* act;
    __device__ __forceinline__ void operator()(const pg8::f32x4 (&acc)[2][2][4][2], const pg8::Unit& u, int wr, int wc, int fr, int fq) const {
        const int pnl = u.pn & 3; const int col0 = pnl * 128 + wc * 32 + 8 * fq;
#pragma unroll
        for (int ai = 0; ai < 2; ++ai)
#pragma unroll
            for (int m = 0; m < 4; ++m) { const int r = ai * 128 + wr * 64 + m * 16 + fr;
                float o[8];
#pragma unroll
                for (int n = 0; n < 2; ++n)
#pragma unroll
                    for (int i = 0; i < 4; ++i) { const float g = acc[ai][0][m][n][i], up = acc[ai][1][m][n][i]; o[4 * n + i] = g * __builtin_amdgcn_rcpf(1.0f + __expf(-g)) * up; }
                pg8::u32x4 w; w.x = pg8::cvt_pk_bf16(o[0], o[1]); w.y = pg8::cvt_pk_bf16(o[2], o[3]); w.z = pg8::cvt_pk_bf16(o[4], o[5]); w.w = pg8::cvt_pk_bf16(o[6], o[7]);
                *(pg8::u32x4*)(act + (size_t)(u.pm * 256 + r) * DEXP + col0) = w; }
    }
};
struct EpiDown {
    static constexpr bool PERM = true;
    bf16* y2;
    __device__ __forceinline__ void operator()(const pg8::f32x4 (&acc)[2][2][4][2], const pg8::Unit& u, int wr, int wc, int fr, int fq) const {
        const int pnl = u.pn & 7; const int col0 = pnl * 256 + wc * 32 + 8 * fq;
#pragma unroll
        for (int ai = 0; ai < 2; ++ai)
#pragma unroll
            for (int m = 0; m < 4; ++m) { const int r = ai * 128 + wr * 64 + m * 16 + fr; bf16* rowp = y2 + (size_t)(u.pm * 256 + r) * DM + col0;
#pragma unroll
                for (int bj = 0; bj < 2; ++bj) { const pg8::f32x4 v0 = acc[ai][bj][m][0], v1 = acc[ai][bj][m][1];
                    pg8::u32x4 w; w.x = pg8::cvt_pk_bf16(v0[0], v0[1]); w.y = pg8::cvt_pk_bf16(v0[2], v0[3]); w.z = pg8::cvt_pk_bf16(v1[0], v1[1]); w.w = pg8::cvt_pk_bf16(v1[2], v1[3]);
                    *(pg8::u32x4*)(rowp + bj * 128) = w; } }
    }
};
__device__ __forceinline__ void moe_tables(Frame& F) {
    LAS int* pre = (LAS int*)(F.lds + LT_PRE); LAS int* cl = (LAS int*)(F.lds + LT_CNT);
    if (F.tid == 0) { int s = 0; const unsigned* cnt = (const unsigned*)(F.ctl + CW_CNT);
        for (int e = 0; e < 32; ++e) { int c = (int)cnt[e]; c = c < 0 ? 0 : (c > CAP ? CAP : c); cl[e] = c; pre[e] = s; s += (c + 255) >> 8; } pre[32] = s; }
    __syncthreads();
}

struct Args { const float* in[23]; float* out; unsigned char* ws; int ph_lo, ph_hi; };
__global__ void __launch_bounds__(NWAVES * 64, 2) mk_fwd(Args args) {
    extern __shared__ __attribute__((aligned(16))) unsigned char lds[];
    Frame F;
    F.lds = (LAS unsigned char*)lds;
    F.tid = threadIdx.x; F.lane = F.tid & 63; F.wave = __builtin_amdgcn_readfirstlane(F.tid >> 6);
    F.G = gridDim.x; { const int bx = blockIdx.x; F.vcu = (F.G % 8 == 0) ? (bx % 8) * (F.G / 8) + bx / 8 : bx; }
    F.ws = args.ws; F.ctl = (gu32*)(args.ws + WS_CTL); F.out = args.out;
#pragma unroll
    for (int i = 0; i < 23; ++i) F.in[i] = args.in[i];
    for (int u = F.tid; u < (LDS_BYTES - LDSCTL_OFF) / 4; u += NWAVES * 64) ((LAS unsigned*)(F.lds + LDSCTL_OFF))[u] = 0u;
    __syncthreads();
    XcdBarrier bar; bar.bar = (unsigned*)(F.ctl + CW_BAR); bar.x = 0; bar.st = nullptr;
    if (N_LAUNCHES == 1) bar = xcd_barrier_post((unsigned*)(F.ctl + CW_BAR), (volatile LAS unsigned*)(F.lds + LDSCTL_OFF));
    const int lo = args.ph_lo, hi = args.ph_hi;
#define IN(k) (lo <= (k) && (k) < hi)
#define SEAM(k) do { if (IN(k) && IN((k) + 1)) xcd_barrier(bar); } while (0)
#ifdef PROBE_PHASE
#define REP(k) ((k) == PROBE_PHASE ? 2 : 1)
#else
#define REP(k) 1
#endif

    if (IN(0)) { p0_prologue(F); } SEAM(0);
    if (IN(1)) { p1_norm(F); } SEAM(1);
    if (IN(2)) {
        pg8::Gemm g{(const pg8::bf16_t*)(F.ws + WS_B), (const pg8::bf16_t*)(F.ws + WS_WIN), SEQ, NPROJ, DM}; pg8::StaticOrder S; S.init(SEQ, NPROJ, F.G, (int)blockIdx.x);
        pg8::EpiBf16 E{(pg8::bf16_t*)(F.ws + WS_A), att::PITCH, 1024, att::QSCALE, (unsigned*)(F.ctl + CW_NMAX), 2048};
        pg8::gemm_phase<pg8::EpiBf16, pg8::StaticOrder, true>(F.lds + RING_OFF, g, S, E); if (REP(2) == 2) { pg8::gemm_phase<pg8::EpiBf16, pg8::StaticOrder, true>(F.lds + RING_OFF, g, S, E); }
    } SEAM(2);
    if (IN(3)) {
        float lam;
        { const float a = wave_sum(F.in[I_LQ1][F.lane] * F.in[I_LK1][F.lane]), b = wave_sum(F.in[I_LQ2][F.lane] * F.in[I_LK2][F.lane]); lam = __expf(a) - __expf(b) + 0.2f; }
        const att::Tensors T{(const __hip_bfloat16*)(F.ws + WS_A), (__hip_bfloat16*)(F.ws + WS_B), F.in[I_GSUB], lam};
        const unsigned* nmx = (const unsigned*)(F.ctl + CW_NMAX);
        LAS int* qslot = (LAS int*)(F.lds + LT_CNT + 256);
#define ATT_QUEUE(VARIANT, TT, QW, WITH_CVT) for (bool more_ = true; more_;) { \
            if (F.tid == 0) { qslot[0] = (int)atomicAdd((unsigned*)(F.ctl + CW_QUEUE) + (QW), 1u); if (WITH_CVT) qslot[1] = (int)atomicAdd((unsigned*)(F.ctl + CW_QUEUE) + 128, 1u); } \
            __syncthreads(); \
            const int ui = __builtin_amdgcn_readfirstlane(qslot[0]); const int ci = WITH_CVT ? __builtin_amdgcn_readfirstlane(qslot[1]) : SIDE_NCHUNK; \
            __syncthreads(); \
            more_ = (ui < 1024) || (ci < SIDE_NCHUNK); \
            if (ui < 1024) { \
            const int qb = 127 - (ui >> 3), h = ui & 7;             \
            float sm = 0.f; \
            _Pragma("unroll") for (int mp = 0; mp < 2; ++mp) { const float qn = __uint_as_float(nmx[4 * h + 2 * mp]) + __uint_as_float(nmx[4 * h + 2 * mp + 1]), kn = __uint_as_float(nmx[32 + 4 * h + 2 * mp]) + __uint_as_float(nmx[32 + 4 * h + 2 * mp + 1]); \
                sm = fmaxf(sm, sqrtf(qn * kn)); } \
            const float slope2 = exp2f(-(float)(h + 1)) * att::LOG2E; \
            const float D = (2.0f * 1.02f * sm + 152.0f) / slope2; \
            int t_lo = (int)ceilf(((float)(qb * 128 - 63) - D) * (1.0f / 64.0f)); t_lo = t_lo < 0 ? 0 : t_lo; \
            t_lo = __builtin_amdgcn_readfirstlane(t_lo); \
            att::attn_unit<VARIANT>(h, qb, t_lo, TT, (att::lds_ptr)(F.lds + RING_OFF)); } \
            if (ci < SIDE_NCHUNK) side_chunk(F, ci); }
        ATT_QUEUE(0, T, 0, true)
#ifdef PROBE_ATT
        { const att::Tensors T2{(const __hip_bfloat16*)(F.ws + WS_A), (__hip_bfloat16*)(F.ws + WS_END), F.in[I_GSUB], lam};
          ATT_QUEUE(PROBE_ATT, T2, 64, false) }
#endif
#undef ATT_QUEUE
    } SEAM(3);
    if (IN(4)) {
        pg8::Gemm g{(const pg8::bf16_t*)(F.ws + WS_B), (const pg8::bf16_t*)(F.ws + WS_WOUT), SEQ, DM, DM}; pg8::StaticOrder S; S.init(SEQ, DM, F.G, (int)blockIdx.x);
        pg8::EpiBf16 E{(pg8::bf16_t*)(F.ws + WS_A), DM, 0, 1.0f, nullptr, 0};
        pg8::gemm_phase<pg8::EpiBf16, pg8::StaticOrder, true>(F.lds + RING_OFF, g, S, E); if (REP(4) == 2) { pg8::gemm_phase<pg8::EpiBf16, pg8::StaticOrder, true>(F.lds + RING_OFF, g, S, E); }
    } SEAM(4);
    if (IN(5)) { p5_post_route(F); } SEAM(5);
    if (IN(6)) {
        moe_tables(F);
        pg8::Gemm g{(const pg8::bf16_t*)(F.ws + WS_A + 64 * MiB), (const pg8::bf16_t*)(F.ws + WS_W1), SEQ, 1024, DM};
        MoeOrder<4, true> S{(const LAS int*)(F.lds + LT_PRE), (const LAS int*)(F.lds + LT_CNT), (const int*)(F.ws + WS_LIST), F.G, F.vcu};
        EpiSwiglu E{(bf16*)(F.ws + WS_A + 160 * MiB)};
        pg8::gemm_phase<EpiSwiglu, MoeOrder<4, true>, true>(F.lds + RING_OFF, g, S, E); if (REP(6) == 2) { pg8::gemm_phase<EpiSwiglu, MoeOrder<4, true>, true>(F.lds + RING_OFF, g, S, E); }
    } SEAM(6);
    if (IN(7)) {
        moe_tables(F);
        pg8::Gemm g{(const pg8::bf16_t*)(F.ws + WS_A + 160 * MiB), (const pg8::bf16_t*)(F.ws + WS_W2), 2 * SEQ, DM, DEXP};
        MoeOrder<8, false> S{(const LAS int*)(F.lds + LT_PRE), (const LAS int*)(F.lds + LT_CNT), (const int*)(F.ws + WS_LIST), F.G, F.vcu};
        EpiDown E{(bf16*)(F.ws + WS_A)};
        pg8::gemm_phase<EpiDown, MoeOrder<8, false>, true>(F.lds + RING_OFF, g, S, E); if (REP(7) == 2) { pg8::gemm_phase<EpiDown, MoeOrder<8, false>, true>(F.lds + RING_OFF, g, S, E); }
    } SEAM(7);
    if (IN(8)) { moe_tables(F); p8_final(F); }
#undef IN
#undef SEAM
}

extern "C" void kernel_launch(void* const* d_in, const int* in_sizes, int n_in, void* d_out, int out_size, void* d_ws, size_t ws_size, hipStream_t stream) {
    static int grid = 0;
    if (grid == 0) {
        if (n_in != 23 || in_sizes[0] != SEQ * DM || out_size != SEQ * DM || ws_size < WS_END + 64 * MiB) { fprintf(stderr, "kernel_launch: shape/workspace mismatch (n_in %d, in0 %d, out %d, ws %zu < %zu); nothing launched\n", n_in, n_in > 0 ? in_sizes[0] : -1, out_size, ws_size, (size_t)WS_END); grid = -1; return; }
        int dev = 0, cus = 0, per_cu = 0;
        if (hipGetDevice(&dev) != hipSuccess || hipDeviceGetAttribute(&cus, hipDeviceAttributeMultiprocessorCount, dev) != hipSuccess) { fprintf(stderr, "kernel_launch: hipGetDevice / hipDeviceGetAttribute failed\n"); grid = -1; return; }
        if (hipFuncSetAttribute((const void*)mk_fwd, hipFuncAttributeMaxDynamicSharedMemorySize, LDS_BYTES) != hipSuccess) { fprintf(stderr, "kernel_launch: hipFuncSetAttribute failed\n"); grid = -1; return; }
        if (hipOccupancyMaxActiveBlocksPerMultiprocessor(&per_cu, (const void*)mk_fwd, NWAVES * 64, LDS_BYTES) != hipSuccess || per_cu < 1) { fprintf(stderr, "kernel_launch: occupancy query reports %d workgroups per CU\n", per_cu); }
        (void)hipGetLastError();
        grid = cus;
    }
    if (grid < 0) return;
    if (hipMemsetAsync((char*)d_ws + WS_CTL, 0, CTL_ZERO_BYTES, stream) != hipSuccess) { fprintf(stderr, "kernel_launch: hipMemsetAsync failed\n"); return; }
    Args a{};
    for (int i = 0; i < 23; ++i) a.in[i] = (const float*)d_in[i];
    a.out = (float*)d_out; a.ws = (unsigned char*)d_ws;
    for (int li = 0; li < N_LAUNCHES; ++li) {
        a.ph_lo = (N_LAUNCHES == 1) ? 0 : li; a.ph_hi = (N_LAUNCHES == 1) ? N_PHASES : li + 1;
        hipLaunchKernelGGL(mk_fwd, dim3(grid), dim3(NWAVES * 64), LDS_BYTES, stream, a);
        const hipError_t le = hipPeekAtLastError();
        if (le != hipSuccess) { fprintf(stderr, "kernel_launch: launch %d failed: %s\n", li, hipGetErrorName(le)); break; }
    }
}
```

```cpp
#include <hip/hip_runtime.h>
#include <hip/hip_bf16.h>
#include <cstdio>
#include <cstdint>
#include <cmath>

namespace pg8 {
#define PG8_LAS __attribute__((address_space(3)))
typedef unsigned short bf16_t;
typedef short bf16x8 __attribute__((ext_vector_type(8)));
typedef float f32x4 __attribute__((ext_vector_type(4)));
typedef unsigned u32x4 __attribute__((ext_vector_type(4)));
constexpr int BM = 256, BK = 64, HALF = 128, HTB = HALF * BK * 2  , STAGE_BYTES = 8 * HTB, NXCD = 8, WGM = 8;

__host__ __device__ __forceinline__ int lds_byte(int r, int c) { const int st = (r >> 4) * 2 + (c >> 5), rr = r & 15, cc = c & 31, ob = rr * 64 + cc * 2; return st * 1024 + (ob ^ (((ob >> 9) & 1) << 5)); }
__host__ __device__ __forceinline__ void stage_rc(int b, int& R, int& C) { const int st = b / 1024, sb = b % 1024, swz = sb ^ (((sb >> 9) & 1) << 5); R = (st >> 1) * 16 + swz / 64; C = (st & 1) * 32 + (swz % 64) / 2; }
__host__ __device__ __forceinline__ int perm32(int rho) { const int n = rho >> 4, i = rho & 15; return 8 * (i >> 2) + 4 * n + (i & 3); }

struct Unit { int pm, pn; int e, row0, nvalid; };
struct Gemm { const bf16_t* A; const bf16_t* Bt; int M, N, K; };

struct StaticOrder {
    static constexpr bool GATHER = false;
    int nM, nN, nwg, G, c;
    __host__ __device__ void init(int M, int N, int G_, int c_) { nM = M / BM; nN = N / BM; nwg = nM * nN; G = G_; c = c_; }
    __device__ __forceinline__ bool next(int i, Unit& u) const {
        const long L = (long)i * G + c; if (L >= nwg) return false;
        int wgid = (int)L; { const int q = nwg / NXCD, r = nwg % NXCD, xcd = wgid % NXCD, off = wgid / NXCD; wgid = (xcd < r ? xcd * (q + 1) : r * (q + 1) + (xcd - r) * q) + off; }
        const int nig = WGM * nN, gid = wgid / nig, fm = gid * WGM, gsz = (nM - fm) < WGM ? (nM - fm) : WGM;
        u.pm = fm + ((wgid % nig) % gsz); u.pn = (wgid % nig) / gsz; u.e = 0; u.row0 = 0; u.nvalid = 256; return true;
    }
    __device__ __forceinline__ void rows(const Unit& u, const int (&RA)[2], const int (&CA)[2], int K, unsigned (&v)[2][2]) const {
#pragma unroll
        for (int h = 0; h < 2; ++h)
#pragma unroll
            for (int i = 0; i < 2; ++i) v[h][i] = (unsigned)(((u.pm * BM + h * HALF + RA[i]) * K + CA[i]) * 2);
    }
};

__device__ __forceinline__ unsigned cvt_pk_bf16(float lo, float hi) { unsigned r; asm volatile("v_cvt_pk_bf16_f32 %0, %1, %2" : "=v"(r) : "v"(lo), "v"(hi)); return r; }

struct EpiBf16 {
    static constexpr bool PERM = true;
    bf16_t* O; int ldc; int scale_cols; float scale0;
    int keep_lo, keep_hi;
    unsigned* nmaxp;
    unsigned* nmax; int nmax_cols;
    __device__ __forceinline__ void operator()(const f32x4 (&acc)[2][2][4][2], const Unit& u, int wr, int wc, int fr, int fq) const {
        const int row0 = u.pm * BM + wr * 64 + fr; const int colt = u.pn * BM;
        const float sc = (colt < scale_cols) ? scale0 : 1.f;
        const int col0 = colt + wc * 32 + 8 * fq;
        const bool donorm = (nmax != nullptr) && (colt < nmax_cols);
        const bool ntst = (keep_hi > 0) && (colt < keep_lo || colt >= keep_hi);
        float nm[2] = {0.f, 0.f};
#pragma unroll
        for (int ai = 0; ai < 2; ++ai)
#pragma unroll
            for (int m = 0; m < 4; ++m) { bf16_t* rowp = O + (size_t)(row0 + ai * HALF + m * 16) * ldc + col0;
#pragma unroll
                for (int bj = 0; bj < 2; ++bj) { f32x4 v0 = acc[ai][bj][m][0] * sc, v1 = acc[ai][bj][m][1] * sc;
                    u32x4 w; w.x = cvt_pk_bf16(v0[0], v0[1]); w.y = cvt_pk_bf16(v0[2], v0[3]); w.z = cvt_pk_bf16(v1[0], v1[1]); w.w = cvt_pk_bf16(v1[2], v1[3]);
                    if (ntst) __builtin_nontemporal_store(w, (u32x4*)(rowp + bj * HALF)); else *(u32x4*)(rowp + bj * HALF) = w;
                    if (donorm) { float ss = (v0[0] * v0[0] + v0[1] * v0[1]) + (v0[2] * v0[2] + v0[3] * v0[3]) + (v1[0] * v1[0] + v1[1] * v1[1]) + (v1[2] * v1[2] + v1[3] * v1[3]);
                        ss += __shfl_xor(ss, 16); ss += __shfl_xor(ss, 32); nm[bj] = fmaxf(nm[bj], ss); } } }
        if (donorm) {
#pragma unroll
            for (int bj = 0; bj < 2; ++bj) { float v = nm[bj];
#pragma unroll
                for (int o = 1; o < 16; o <<= 1) v = fmaxf(v, __shfl_xor(v, o));
                if ((threadIdx.x & 63) == 0) { atomicMax(nmax + (colt >> 5) + 4 * bj + wc, __float_as_uint(v)); if (nmaxp != nullptr && colt < 1024) atomicMax(nmaxp + 32 * u.pm + (colt >> 5) + 4 * bj + wc, __float_as_uint(v)); } }
        }
    }
};

template <class Epi, class Sched, bool ALIGN_EPI = false>
__device__ __forceinline__ void gemm_phase(PG8_LAS unsigned char* lds, const Gemm g, const Sched& S, const Epi& E) {
    const int tid = threadIdx.x, wid = __builtin_amdgcn_readfirstlane(tid >> 6), lane = tid & 63, wr = wid >> 2, wc = wid & 3, fr = lane & 15, fq = lane >> 4;
    const int K = g.K, nt = K / BK;
    int RA[2], CA[2]; unsigned voffB[2];
#pragma unroll
    for (int i = 0; i < 2; ++i) { int R, C; stage_rc(tid * 16 + i * 8192, R, C); const int Rb = Epi::PERM ? ((R & ~31) + perm32(R & 31)) : R;
        RA[i] = R; CA[i] = C; voffB[i] = (unsigned)(Rb * K + C) * 2u; }
    const size_t kstep = (size_t)(BK * 2);
    const size_t hstep = (size_t)HALF * K * 2;
    const size_t tstep = 2 * hstep;
    const unsigned ldsw = (unsigned)wid * 1024u;
    const int aoff = lds_byte(wr * 64 + fr, fq * 8), boff = lds_byte(wc * 32 + fr, fq * 8);
    const char* const Abase = (const char*)g.A;
#define PG8_SA(b, h) (((b) * 2 + (h)) * HTB)
#define PG8_SB(b, h) ((4 + (b) * 2 + (h)) * HTB)
#define PG8_STAGE(bufoff, gbase, voff) do { _Pragma("unroll") for (int _i = 0; _i < 2; ++_i) \
        __builtin_amdgcn_global_load_lds((const unsigned*)((const char*)(gbase) + (voff)[_i]), (PG8_LAS unsigned*)(lds + (bufoff) + ldsw + _i * 8192), 16, 0, 0); } while (0)
#define PG8_STAGE_A(bufoff, v0, v1, kb) do { \
        __builtin_amdgcn_global_load_lds((const unsigned*)(Abase + (size_t)((v0) + (kb))), (PG8_LAS unsigned*)(lds + (bufoff) + ldsw), 16, 0, 0); \
        __builtin_amdgcn_global_load_lds((const unsigned*)(Abase + (size_t)((v1) + (kb))), (PG8_LAS unsigned*)(lds + (bufoff) + ldsw + 8192), 16, 0, 0); } while (0)
#define PG8_LDA(dst, b, h) do { _Pragma("unroll") for (int m = 0; m < 4; ++m) _Pragma("unroll") for (int k = 0; k < 2; ++k) dst[m][k] = *(const PG8_LAS bf16x8*)(lds + PG8_SA(b, h) + aoff + m * 2048 + k * 1024); } while (0)
#define PG8_LDB(dst, b, h) do { _Pragma("unroll") for (int n = 0; n < 2; ++n) _Pragma("unroll") for (int k = 0; k < 2; ++k) dst[n][k] = *(const PG8_LAS bf16x8*)(lds + PG8_SB(b, h) + boff + n * 2048 + k * 1024); } while (0)
#define PG8_MMA(ai, bj, At, Bt) do { __builtin_amdgcn_s_setprio(1); _Pragma("unroll") for (int m = 0; m < 4; ++m) _Pragma("unroll") for (int n = 0; n < 2; ++n) _Pragma("unroll") for (int k = 0; k < 2; ++k) \
        acc[ai][bj][m][n] = __builtin_amdgcn_mfma_f32_16x16x32_bf16(Bt[n][k], At[m][k], acc[ai][bj][m][n], 0, 0, 0); __builtin_amdgcn_s_setprio(0); } while (0)
#define PG8_WAIT_V(n) asm volatile("s_waitcnt vmcnt(" #n ")" ::: "memory")
#define PG8_WAIT_L(n) asm volatile("s_waitcnt lgkmcnt(" #n ")" ::: "memory")
#define PG8_BAR __builtin_amdgcn_s_barrier()
#define PG8_SCHED __builtin_amdgcn_sched_barrier(0)
    Unit cur, nxt; int ui = 0;
    if (!S.next(0, cur)) return;
    f32x4 acc[2][2][4][2];
#pragma unroll
    for (int a = 0; a < 2; ++a)
#pragma unroll
        for (int b = 0; b < 2; ++b)
#pragma unroll
            for (int m = 0; m < 4; ++m)
#pragma unroll
                for (int n = 0; n < 2; ++n) acc[a][b][m][n] = (f32x4){0.f, 0.f, 0.f, 0.f};
    bf16x8 At[4][2], B0[2][2], B1[2][2];
    unsigned vAc[2][2], vAn[2][2];
    S.rows(cur, RA, CA, K, vAc);
    const char* cB = (const char*)g.Bt + (size_t)cur.pn * tstep;
    PG8_STAGE(PG8_SB(0, 0), cB, voffB); PG8_STAGE(PG8_SB(0, 1), cB + hstep, voffB); PG8_STAGE_A(PG8_SA(0, 0), vAc[0][0], vAc[0][1], 0u); PG8_STAGE_A(PG8_SA(0, 1), vAc[1][0], vAc[1][1], 0u);
    if (wr == 1) PG8_BAR;
    PG8_WAIT_V(2); PG8_BAR;
    PG8_STAGE(PG8_SB(1, 0), cB + kstep, voffB); PG8_STAGE_A(PG8_SA(1, 0), vAc[0][0], vAc[0][1], (unsigned)kstep); PG8_STAGE(PG8_SB(1, 1), cB + hstep + kstep, voffB);
    PG8_WAIT_V(6); PG8_BAR;
    for (;;) {
        const bool has_next = S.next(ui + 1, nxt);
        if (has_next) S.rows(nxt, RA, CA, K, vAn);
        else { vAn[0][0] = vAc[0][0]; vAn[0][1] = vAc[0][1]; vAn[1][0] = vAc[1][0]; vAn[1][1] = vAc[1][1]; }
        const char* nB = has_next ? (const char*)g.Bt + (size_t)nxt.pn * tstep : cB;
        for (int t = 0; t < nt; t += 2) {
            const bool last = (t == nt - 2);
            const unsigned kb1 = (unsigned)(t + 1) * (unsigned)kstep;
            const unsigned kb2 = last ? 0u : (unsigned)(t + 2) * (unsigned)kstep, kb3 = kb2 + (unsigned)kstep;
            const unsigned x00 = last ? vAn[0][0] : vAc[0][0], x01 = last ? vAn[0][1] : vAc[0][1], x10 = last ? vAn[1][0] : vAc[1][0], x11 = last ? vAn[1][1] : vAc[1][1];
            const char* b2 = last ? nB : cB + (size_t)(t + 2) * kstep; const char* b3 = b2 + kstep;
            PG8_LDB(B0, 0, 0); PG8_LDB(B1, 0, 1); PG8_SCHED; PG8_LDA(At, 0, 0); PG8_STAGE_A(PG8_SA(1, 1), vAc[1][0], vAc[1][1], kb1);
            PG8_WAIT_V(8); PG8_WAIT_L(0); PG8_BAR; PG8_MMA(0, 0, At, B0); PG8_MMA(0, 1, At, B1); PG8_BAR; PG8_SCHED;
            PG8_LDA(At, 0, 1); PG8_STAGE(PG8_SB(0, 0), b2, voffB); PG8_STAGE(PG8_SB(0, 1), b2 + hstep, voffB); PG8_STAGE_A(PG8_SA(0, 0), x00, x01, kb2);
            PG8_WAIT_V(8); PG8_WAIT_L(0); PG8_BAR; PG8_MMA(1, 0, At, B0); PG8_MMA(1, 1, At, B1); PG8_BAR; PG8_SCHED;
            PG8_LDB(B0, 1, 0); PG8_LDB(B1, 1, 1); PG8_SCHED; PG8_LDA(At, 1, 0); PG8_STAGE_A(PG8_SA(0, 1), x10, x11, kb2);
            PG8_WAIT_V(8); PG8_WAIT_L(0); PG8_BAR; PG8_MMA(0, 0, At, B0); PG8_MMA(0, 1, At, B1); PG8_BAR; PG8_SCHED;
            PG8_LDA(At, 1, 1); PG8_STAGE(PG8_SB(1, 0), b3, voffB); PG8_STAGE(PG8_SB(1, 1), b3 + hstep, voffB); PG8_STAGE_A(PG8_SA(1, 0), x00, x01, kb3);
            PG8_WAIT_V(8); PG8_WAIT_L(0); PG8_BAR; PG8_MMA(1, 0, At, B0); PG8_MMA(1, 1, At, B1); PG8_BAR; PG8_SCHED;
        }
        if constexpr (ALIGN_EPI) { if (wr == 0) PG8_BAR; }
        E(acc, cur, wr, wc, fr, fq);
        if (!has_next) break;
#pragma unroll
        for (int a = 0; a < 2; ++a)
#pragma unroll
            for (int b = 0; b < 2; ++b)
#pragma unroll
                for (int m = 0; m < 4; ++m)
#pragma unroll
                    for (int n = 0; n < 2; ++n) acc[a][b][m][n] = (f32x4){0.f, 0.f, 0.f, 0.f};
        cur = nxt; cB = nB; ++ui;
        vAc[0][0] = vAn[0][0]; vAc[0][1] = vAn[0][1]; vAc[1][0] = vAn[1][0]; vAc[1][1] = vAn[1][1];
        if constexpr (ALIGN_EPI) { if (wr == 1) PG8_BAR; }
    }
    PG8_WAIT_V(0);
    if constexpr (!ALIGN_EPI) { if (wr == 0) PG8_BAR; }
    PG8_BAR;
#undef PG8_SA
#undef PG8_SB
#undef PG8_STAGE
#undef PG8_STAGE_A
#undef PG8_LDA
#undef PG8_LDB
#undef PG8_MMA
#undef PG8_WAIT_V
#undef PG8_WAIT_L
#undef PG8_BAR
#undef PG8_SCHED
}
}

namespace att {
typedef __attribute__((address_space(3))) const char* lds_cptr;
typedef __attribute__((address_space(3))) char* lds_ptr;
using bf16x8 = __attribute__((ext_vector_type(8))) short;
using s16x4 = __attribute__((ext_vector_type(4))) short;
using f32x16 = __attribute__((ext_vector_type(16))) float;
using f32x4 = __attribute__((ext_vector_type(4))) float;
using u32x4 = __attribute__((ext_vector_type(4))) unsigned;
typedef short v4i16_t __attribute__((ext_vector_type(4)));
typedef float f32x2_t __attribute__((ext_vector_type(2))); typedef __bf16 bf16x2_t __attribute__((ext_vector_type(2)));
constexpr int PITCH = 6144 + 128;
constexpr int COL_Q = 0, COL_K = 1024, COL_V = 2048;
constexpr int SLOT = 16384;
constexpr int NSLOT = 4, L_K = 0, L_V = NSLOT * SLOT, L_X = 0, XSTRIDE = 17408, L_WS = 131072 + 2048, LDS_BYTES = L_WS + 8 * 256;
constexpr float LOG2E = 1.4426950408889634f;
constexpr float QSCALE = 0.125f * LOG2E;
constexpr float THR = 6.0f;

__device__ __forceinline__ int crow(int r, int hi) { return (r & 3) + 8 * (r >> 2) + 4 * hi; }
__device__ __forceinline__ void glds16(const void* sbase, unsigned voff, unsigned lds_dst) { unsigned keep;
    asm volatile("s_mov_b32 %0, m0\n\ts_mov_b32 m0, %3\n\ts_nop 0\n\tglobal_load_lds_dwordx4 %1, %2\n\ts_mov_b32 m0, %0" : "=&s"(keep) : "v"(voff), "s"(sbase), "s"(lds_dst) : "memory"); }
__device__ __forceinline__ float max3f(float a, float b, float c) { float r; asm("v_max3_f32 %0, %1, %2, %3" : "=v"(r) : "v"(a), "v"(b), "v"(c)); return r; }
__device__ __forceinline__ float max2f(float a, float b) { float r; asm("v_max_f32_e32 %0, %1, %2" : "=v"(r) : "v"(a), "v"(b)); return r; }
__device__ __forceinline__ unsigned cvtpk_s(float lo, float hi) { f32x2_t v = {lo, hi}; bf16x2_t b = __builtin_convertvector(v, bf16x2_t); return __builtin_bit_cast(unsigned, b); }
__device__ __forceinline__ s16x4 vtr(lds_cptr p) { return __builtin_bit_cast(s16x4, __builtin_amdgcn_ds_read_tr16_b64_v4i16((__attribute__((address_space(3))) v4i16_t*)p)); }

struct Tensors { const __hip_bfloat16* proj; __hip_bfloat16* ycat; const float* g_subln; float lam; };

__device__ __forceinline__ float xhalf(float v) { return __shfl_xor(v, 32); }

struct WaveState { f32x16 o[4]; float mhat, l_reg; u32x4 pw0, pw1, pw2, pw3; bool resc; };
__device__ __forceinline__ void att_pv(WaveState& st, lds_cptr vb, const int (&vof)[2]) {
    s16x4 alo[4], ahi[4], blo[4], bhi[4];
#define ATT_RD(LO, HI, db) do { _Pragma("unroll") for (int ks = 0; ks < 4; ++ks) { LO[ks] = vtr(vb + (vof[0] ^ (64 * (db))) + ks * 4096); HI[ks] = vtr(vb + (vof[1] ^ (64 * (db))) + ks * 4096); } } while (0)
#define ATT_PK(LO, HI, k) (bf16x8){LO[k][0], LO[k][1], LO[k][2], LO[k][3], HI[k][0], HI[k][1], HI[k][2], HI[k][3]}
#define ATT_MM(LO, HI, db) do { \
        st.o[db] = __builtin_amdgcn_mfma_f32_32x32x16_bf16(__builtin_bit_cast(bf16x8, st.pw0), ATT_PK(LO, HI, 0), st.o[db], 0, 0, 0); \
        st.o[db] = __builtin_amdgcn_mfma_f32_32x32x16_bf16(__builtin_bit_cast(bf16x8, st.pw1), ATT_PK(LO, HI, 1), st.o[db], 0, 0, 0); \
        st.o[db] = __builtin_amdgcn_mfma_f32_32x32x16_bf16(__builtin_bit_cast(bf16x8, st.pw2), ATT_PK(LO, HI, 2), st.o[db], 0, 0, 0); \
        st.o[db] = __builtin_amdgcn_mfma_f32_32x32x16_bf16(__builtin_bit_cast(bf16x8, st.pw3), ATT_PK(LO, HI, 3), st.o[db], 0, 0, 0); } while (0)
    ATT_RD(alo, ahi, 0); ATT_RD(blo, bhi, 1); __builtin_amdgcn_sched_barrier(0);
    ATT_MM(alo, ahi, 0); __builtin_amdgcn_sched_barrier(0);
    ATT_RD(alo, ahi, 2); __builtin_amdgcn_sched_barrier(0);
    ATT_MM(blo, bhi, 1); __builtin_amdgcn_sched_barrier(0);
    ATT_RD(blo, bhi, 3); __builtin_amdgcn_sched_barrier(0);
    ATT_MM(alo, ahi, 2); __builtin_amdgcn_sched_barrier(0);
    ATT_MM(blo, bhi, 3);
#undef ATT_RD
#undef ATT_PK
#undef ATT_MM
}

__device__ __forceinline__ void att_rescale(WaveState& st, __attribute__((address_space(3))) float* wsf, int hi) {
    float fr_[16];
#pragma unroll
    for (int r = 0; r < 16; ++r) fr_[r] = wsf[crow(r, hi)];
#pragma unroll
    for (int d = 0; d < 4; ++d)
#pragma unroll
        for (int r = 0; r < 16; ++r) st.o[d][r] *= fr_[r];
    st.resc = false;
}
__device__ __forceinline__ void att_step(WaveState& st, bool pend, lds_cptr vbp, const int (&vof)[2], const bf16x8 (&qr)[4], lds_cptr kb, int kof,
                                         __attribute__((address_space(3))) float* wsf, float slope2, int qpos, int t, bool diag, bool first, int r32, int hi,
                                         const __hip_bfloat16* dk, const __hip_bfloat16* dv, unsigned dkd, unsigned dvd, unsigned dvoff, bool act) {
    if (st.resc) att_rescale(st, wsf, hi);
    f32x16 p0, p1;
    bf16x8 kf[8];
#pragma unroll
    for (int d0 = 0; d0 < 4; ++d0) { kf[2 * d0] = *(const __attribute__((address_space(3))) bf16x8*)(kb + (kof ^ (32 * d0))); kf[2 * d0 + 1] = *(const __attribute__((address_space(3))) bf16x8*)(kb + (kof ^ (32 * d0)) + 8192); }
    __builtin_amdgcn_sched_barrier(0);
    const float dq = (float)(qpos - t * 64 - 4 * hi);
    if (diag) {
#pragma unroll
        for (int r = 0; r < 16; ++r) { const float d0_ = dq - (float)((r & 3) + 8 * (r >> 2)); p0[r] = -slope2 * fabsf(d0_) - st.mhat; p1[r] = -slope2 * fabsf(d0_ - 32.f) - st.mhat; }
    } else {
        float s2v = slope2; asm volatile("" : "+v"(s2v));
        const float A0 = -s2v * dq - st.mhat, A1 = A0 + 32.f * s2v;
#pragma unroll
        for (int r = 0; r < 16; ++r) { const float cr = (float)((r & 3) + 8 * (r >> 2)); p0[r] = fmaf(cr, s2v, A0); p1[r] = fmaf(cr, s2v, A1); }
    }
    __builtin_amdgcn_sched_barrier(0);
#define ATT_QK(d0) p0 = __builtin_amdgcn_mfma_f32_32x32x16_bf16(kf[2 * (d0)], qr[d0], p0, 0, 0, 0); __builtin_amdgcn_sched_barrier(0); p1 = __builtin_amdgcn_mfma_f32_32x32x16_bf16(kf[2 * (d0) + 1], qr[d0], p1, 0, 0, 0); __builtin_amdgcn_sched_barrier(0)
    ATT_QK(0); glds16(dk, dvoff, dkd); __builtin_amdgcn_sched_barrier(0);
    ATT_QK(1); glds16(dk + (size_t)32 * PITCH, dvoff, dkd + 8192); __builtin_amdgcn_sched_barrier(0);
    ATT_QK(2); glds16(dv, dvoff, dvd); __builtin_amdgcn_sched_barrier(0);
    ATT_QK(3); glds16(dv + (size_t)32 * PITCH, dvoff, dvd + 8192); __builtin_amdgcn_sched_barrier(0);
#undef ATT_QK
    if (!act) return;
    asm volatile("s_nop 15\n\ts_nop 7" : "+v"(p0), "+v"(p1));
    float rm;
    { float a_ = max3f(p0[0], p0[1], p1[0]), b_ = max3f(p0[2], p0[3], p1[1]); a_ = max3f(a_, p1[2], p1[3]);
#pragma unroll
      for (int r = 4; r < 16; r += 4) { a_ = max3f(a_, p0[r], p0[r + 1]); b_ = max3f(b_, p0[r + 2], p0[r + 3]); a_ = max3f(a_, p1[r], p1[r + 1]); b_ = max3f(b_, p1[r + 2], p1[r + 3]); }
      rm = max2f(a_, b_); }
    { auto rr = __builtin_amdgcn_permlane32_swap(__float_as_uint(rm), __float_as_uint(rm), false, false); rm = max2f(__uint_as_float(rr[0]), __uint_as_float(rr[1])); }
    const bool need = first || __any(rm > THR);
    float f = 1.0f;
    if (need) {
        const float dl = first ? rm : fmaxf(rm, 0.f);
        st.mhat += dl;
#pragma unroll
        for (int r = 0; r < 16; ++r) { p0[r] -= dl; p1[r] -= dl; }
        if (!first) { f = __builtin_amdgcn_exp2f(-dl); if (hi == 0) wsf[r32] = f; st.resc = true; }
    }
    u32x4 nw0, nw1, nw2, nw3; float sacc = 0.f;
    {
        s16x4 alo[4], ahi[4], blo[4], bhi[4];
#define ATT_RD(LO, HI, ks) do { _Pragma("unroll") for (int db = 0; db < 4; ++db) { LO[db] = vtr(vbp + (vof[0] ^ (64 * db)) + (ks) * 4096); HI[db] = vtr(vbp + (vof[1] ^ (64 * db)) + (ks) * 4096); } } while (0)
#define ATT_PK(LO, HI, k) (bf16x8){LO[k][0], LO[k][1], LO[k][2], LO[k][3], HI[k][0], HI[k][1], HI[k][2], HI[k][3]}
#define ATT_GAP(db, LO, HI, PW, E0, E1, NW) do { \
        st.o[db] = __builtin_amdgcn_mfma_f32_32x32x16_bf16(__builtin_bit_cast(bf16x8, PW), ATT_PK(LO, HI, db), st.o[db], 0, 0, 0); \
        E0 = __builtin_amdgcn_exp2f(E0); E1 = __builtin_amdgcn_exp2f(E1); sacc += E0; sacc += E1; NW = cvtpk_s(E0, E1); __builtin_amdgcn_sched_barrier(0); } while (0)
        ATT_RD(alo, ahi, 0); ATT_RD(blo, bhi, 1); __builtin_amdgcn_sched_barrier(0);
        ATT_GAP(0, alo, ahi, st.pw0, p0[0], p0[1], nw0.x); ATT_GAP(1, alo, ahi, st.pw0, p0[2], p0[3], nw0.y); ATT_GAP(2, alo, ahi, st.pw0, p0[4], p0[5], nw0.z); ATT_GAP(3, alo, ahi, st.pw0, p0[6], p0[7], nw0.w);
        ATT_RD(alo, ahi, 2); __builtin_amdgcn_sched_barrier(0);
        ATT_GAP(0, blo, bhi, st.pw1, p0[8], p0[9], nw1.x); ATT_GAP(1, blo, bhi, st.pw1, p0[10], p0[11], nw1.y); ATT_GAP(2, blo, bhi, st.pw1, p0[12], p0[13], nw1.z); ATT_GAP(3, blo, bhi, st.pw1, p0[14], p0[15], nw1.w);
        ATT_RD(blo, bhi, 3); __builtin_amdgcn_sched_barrier(0);
        ATT_GAP(0, alo, ahi, st.pw2, p1[0], p1[1], nw2.x); ATT_GAP(1, alo, ahi, st.pw2, p1[2], p1[3], nw2.y); ATT_GAP(2, alo, ahi, st.pw2, p1[4], p1[5], nw2.z); ATT_GAP(3, alo, ahi, st.pw2, p1[6], p1[7], nw2.w);
        ATT_GAP(0, blo, bhi, st.pw3, p1[8], p1[9], nw3.x); ATT_GAP(1, blo, bhi, st.pw3, p1[10], p1[11], nw3.y); ATT_GAP(2, blo, bhi, st.pw3, p1[12], p1[13], nw3.z); ATT_GAP(3, blo, bhi, st.pw3, p1[14], p1[15], nw3.w);
#undef ATT_RD
#undef ATT_PK
#undef ATT_GAP
    }
    asm volatile("" : "+v"(nw0), "+v"(nw1), "+v"(nw2), "+v"(nw3), "+v"(sacc));
    st.l_reg = st.l_reg * f + sacc; st.pw0 = nw0; st.pw1 = nw1; st.pw2 = nw2; st.pw3 = nw3;
}

template <int VAR>
__device__ __forceinline__ void attn_unit(int h, int qb, int j_lo, int j_hi, int part, float* dump, unsigned* dcnt, __attribute__((address_space(3))) int* flag, float smx, float tskip, const Tensors& T, lds_ptr shm) {
    typedef __hip_bfloat16 bf16;
    int tid = threadIdx.x; asm volatile("" : "+v"(tid));
    const int lane = tid & 63, r32 = lane & 31, hi = lane >> 5; const int wid = __builtin_amdgcn_readfirstlane(tid >> 6);
    const int rb = wid & 3, mp = wid >> 2;
    const int q0 = qb * 128 + rb * 32;
    const int cw = q0 >> 6;
    const int NT = 2 * qb + 2;
    const bf16* Qw = T.proj + (size_t)q0 * PITCH + COL_Q + h * 128 + mp * 64;
    const bf16* Kh = T.proj + COL_K + h * 128; const bf16* Vh = T.proj + COL_V + h * 128;
    const unsigned lds0 = (unsigned)(uintptr_t)shm;
    __attribute__((address_space(3))) float* wsf = (__attribute__((address_space(3))) float*)(shm + L_WS + wid * 256);
    const unsigned dvoff = (unsigned)(((lane >> 4) * PITCH + ((lane & 15) ^ (((lane >> 4) << 2) | (wid & 3))) * 8) * 2);
    const bf16* kpc = Kh + (size_t)(wid * 4) * PITCH; const bf16* vpc = Vh + (size_t)(wid * 4) * PITCH;
    const unsigned kdst = lds0 + L_K + wid * 1024, vdst = lds0 + L_V + wid * 1024;
#define ATT_DMA(t, ks, vs) do { const size_t toff_ = (size_t)(t) * 64 * PITCH; const unsigned ko_ = (unsigned)(ks) * SLOT, vo_ = (unsigned)(vs) * SLOT; \
        glds16(kpc + toff_, dvoff, (unsigned)__builtin_amdgcn_readfirstlane(kdst + ko_)); glds16(kpc + toff_ + (size_t)32 * PITCH, dvoff, (unsigned)__builtin_amdgcn_readfirstlane(kdst + ko_ + 8192)); \
        glds16(vpc + toff_, dvoff, (unsigned)__builtin_amdgcn_readfirstlane(vdst + vo_)); glds16(vpc + toff_ + (size_t)32 * PITCH, dvoff, (unsigned)__builtin_amdgcn_readfirstlane(vdst + vo_ + 8192)); } while (0)
    ATT_DMA(NT - 1 - j_lo, 0, 0);
    ATT_DMA((j_hi - j_lo > 1) ? NT - 2 - j_lo : 0, 1, 1);
    bf16x8 qr[4];
#pragma unroll
    for (int d0 = 0; d0 < 4; ++d0) qr[d0] = *reinterpret_cast<const bf16x8*>(&Qw[(size_t)r32 * PITCH + d0 * 16 + hi * 8]);
    const float slope2 = exp2f(-(float)(h + 1)) * LOG2E;
    asm volatile("" : "+v"(qr[0]), "+v"(qr[1]), "+v"(qr[2]), "+v"(qr[3]));
    WaveState st; st.mhat = 0.f; st.l_reg = 0.f; st.resc = false;
#pragma unroll
    for (int d = 0; d < 4; ++d) st.o[d] = f32x16{};
    st.pw0 = st.pw1 = st.pw2 = st.pw3 = (u32x4){0u, 0u, 0u, 0u};
    int kof, vof[2];
    { const int xr = ((r32 & 3) << 2) | ((r32 >> 2) & 3);
      kof = 256 * r32 + 16 * ((8 * mp + hi) ^ xr);
      const int q_ = (lane & 15) >> 2, p_ = lane & 3, blk = (lane >> 4) & 1;
#pragma unroll
      for (int t_ = 0; t_ < 2; ++t_) { const int row = 8 * t_ + 4 * hi + q_; const int xv = ((row & 3) << 2) | ((row >> 2) & 3);
          vof[t_] = 256 * row + 16 * ((2 * blk + (p_ >> 1)) ^ xv) + 8 * (p_ & 1); } }
    const lds_cptr kb0 = (lds_cptr)shm + L_K; const lds_cptr vb0 = (lds_cptr)shm + L_V;
    const int qpos = q0 + r32;
    bool pend = false; int pend_vs = 0;
    __attribute__((address_space(3))) float* tmin = (__attribute__((address_space(3))) float*)(shm + L_WS + 2048);
#pragma unroll 1
    for (int j = j_lo; j < j_hi; ++j) {
        const int t = NT - 1 - j, sl = (j - j_lo) & 3;
        asm volatile("s_waitcnt vmcnt(4)" ::: "memory");
        __builtin_amdgcn_s_barrier(); asm volatile("" ::: "memory");
        const bool act = (t <= cw);
        if (part == 0 && j == 4 && j_hi > 8) {
            float tn = tmin[0];
#pragma unroll
            for (int w_ = 1; w_ < 8; ++w_) tn = fminf(tn, tmin[w_]);
            const int t_need = __builtin_amdgcn_readfirstlane((int)floorf(tn));
            int jh = NT - t_need; jh = jh < 8 ? 8 : jh; j_hi = jh < j_hi ? jh : j_hi;
        }
        const int ds_ = (j - j_lo + 2) & 3; const int td_ = (j + 2 < j_hi) ? t - 2 : 0; const size_t dto = (size_t)td_ * 64 * PITCH;
        att_step(st, pend, vb0 + pend_vs * SLOT, vof, qr, kb0 + sl * SLOT, kof, wsf, slope2, qpos, t, t == cw, part ? (j == j_lo) : (t == cw), r32, hi,
                 kpc + dto, vpc + dto, (unsigned)__builtin_amdgcn_readfirstlane(kdst + ds_ * SLOT), (unsigned)__builtin_amdgcn_readfirstlane(vdst + ds_ * SLOT), dvoff, act);
        if (act) { pend = true; pend_vs = sl; }
        if (part == 0 && j == 3) {
            float tn = ((float)(qpos - 63) - (smx - st.mhat + tskip) / slope2) * (1.0f / 64.0f);
#pragma unroll
            for (int o_ = 1; o_ < 64; o_ <<= 1) tn = fminf(tn, __shfl_xor(tn, o_));
            if (lane == 0) tmin[wid] = tn;
        }
        asm volatile("s_waitcnt lgkmcnt(0)" ::: "memory");
    }
#undef ATT_DMA
    if (VAR != 2) { if (pend) { if (st.resc) att_rescale(st, wsf, hi); att_pv(st, vb0 + pend_vs * SLOT, vof); } }
    if (dump != nullptr) {
        float* dw = dump + (size_t)(part * 8 + wid) * (66 * 64) + lane;
#pragma unroll
        for (int d = 0; d < 4; ++d)
#pragma unroll
            for (int r = 0; r < 16; ++r) dw[(d * 16 + r) * 64] = st.o[d][r];
        dw[64 * 64] = st.l_reg; dw[65 * 64] = st.mhat;
        asm volatile("s_waitcnt vmcnt(0)" ::: "memory");
        __syncthreads();
        if (tid == 0) { __builtin_amdgcn_fence(__ATOMIC_RELEASE, "agent"); flag[0] = (int)__hip_atomic_fetch_add(dcnt, 1u, __ATOMIC_RELAXED, __HIP_MEMORY_SCOPE_AGENT); }
        __syncthreads();
        const int arrived = __builtin_amdgcn_readfirstlane(flag[0]);
        if (arrived == 0) { __syncthreads(); return; }
        __builtin_amdgcn_fence(__ATOMIC_ACQUIRE, "agent");
        const float* pw_ = dump + (size_t)((1 - part) * 8 + wid) * (66 * 64) + lane;
        const float pl = pw_[64 * 64], pm = pw_[65 * 64];
        const float m_ = fmaxf(st.mhat, pm), fa = exp2f(st.mhat - m_), fb = exp2f(pm - m_);
        st.l_reg = st.l_reg * fa + pl * fb;
        if (hi == 0) { wsf[r32] = fa; wsf[32 + r32] = fb; }
        asm volatile("s_waitcnt lgkmcnt(0)" ::: "memory");
        float fra[16], frb[16];
#pragma unroll
        for (int r = 0; r < 16; ++r) { fra[r] = wsf[crow(r, hi)]; frb[r] = wsf[32 + crow(r, hi)]; }
#pragma unroll
        for (int d = 0; d < 4; ++d)
#pragma unroll
            for (int r = 0; r < 16; ++r) st.o[d][r] = st.o[d][r] * fra[r] + pw_[(d * 16 + r) * 64] * frb[r];
        asm volatile("s_waitcnt lgkmcnt(0)" ::: "memory");
    }
    asm volatile("s_waitcnt vmcnt(0) lgkmcnt(0)" ::: "memory"); __builtin_amdgcn_s_barrier(); asm volatile("" ::: "memory");
    float l_reg = st.l_reg; f32x16 (&o)[4] = st.o;
    l_reg += xhalf(l_reg);
    if (hi == 0) wsf[32 + r32] = l_reg;
    asm volatile("s_waitcnt lgkmcnt(0)" ::: "memory");
    float rli[16];
#pragma unroll
    for (int r = 0; r < 16; ++r) rli[r] = 1.0f / wsf[32 + crow(r, hi)];
    __attribute__((address_space(3))) float* X = (__attribute__((address_space(3))) float*)(shm + L_X + rb * XSTRIDE);
    if (mp == 1) {
#pragma unroll
        for (int d = 0; d < 4; ++d)
#pragma unroll
            for (int r = 0; r < 16; ++r) X[(d * 16 + r) * 64 + lane] = o[d][r] * rli[r];
    }
    asm volatile("s_waitcnt lgkmcnt(0)" ::: "memory"); __builtin_amdgcn_s_barrier(); asm volatile("" ::: "memory");
    if (mp == 0) {
        const float lam = T.lam;
#pragma unroll
        for (int d = 0; d < 4; ++d)
#pragma unroll
            for (int r = 0; r < 16; ++r) o[d][r] = o[d][r] * rli[r] - lam * X[(d * 16 + r) * 64 + lane];
        asm volatile("s_waitcnt lgkmcnt(0)" ::: "memory");
#pragma unroll
        for (int d = 0; d < 4; ++d)
#pragma unroll
            for (int r = 0; r < 16; ++r) X[crow(r, hi) * 132 + d * 32 + r32] = o[d][r];
        asm volatile("s_waitcnt lgkmcnt(0)" ::: "memory");
        f32x4 v[16]; float ss = 0.f;
#pragma unroll
        for (int i = 0; i < 16; ++i) { v[i] = *(const __attribute__((address_space(3))) f32x4*)(X + r32 * 132 + hi * 64 + 4 * i); ss += (v[i].x * v[i].x + v[i].y * v[i].y) + (v[i].z * v[i].z + v[i].w * v[i].w); }
        ss += xhalf(ss);
        const float rstd = 0.8f / sqrtf(ss * (1.0f / 128.0f) + 1e-5f);
        bf16* Ow = T.ycat + (size_t)(q0 + r32) * 2048 + h * 128 + hi * 64;
        const float* gs = T.g_subln + hi * 64;
#pragma unroll
        for (int i = 0; i < 8; ++i) {
            const f32x4 g0 = *(const f32x4*)(gs + 8 * i), g1 = *(const f32x4*)(gs + 8 * i + 4); const f32x4 a = v[2 * i] * rstd * g0, b = v[2 * i + 1] * rstd * g1;
            u32x4 w; w.x = cvtpk_s(a.x, a.y); w.y = cvtpk_s(a.z, a.w); w.z = cvtpk_s(b.x, b.y); w.w = cvtpk_s(b.z, b.w);
            *(u32x4*)(Ow + 8 * i) = w;
        }
    }
    asm volatile("s_waitcnt lgkmcnt(0)" ::: "memory"); __builtin_amdgcn_s_barrier(); asm volatile("" ::: "memory");
}
}

constexpr int NWAVES = 8;
constexpr int SEQ = 16384, DM = 2048, NPROJ = 6144, NHEAD = 8, NEXP = 32, DEXP = 512, CAP = 16384;
constexpr float NORM_EPS = 1e-6f;
#ifndef MK_N_LAUNCHES
#define MK_N_LAUNCHES 1
#endif
constexpr int N_PHASES = 9;
constexpr int N_LAUNCHES = MK_N_LAUNCHES;

constexpr size_t MiB = 1u << 20;
constexpr size_t WS_CTL = 0, CTL_ZERO_BYTES = 1 * MiB;
constexpr size_t WS_WRT = 1 * MiB;
constexpr size_t WS_GATES = 2 * MiB;
constexpr size_t WS_LIST = 3 * MiB;
constexpr size_t WS_WIN = 6 * MiB;
constexpr size_t WS_WOUT = 30 * MiB;
constexpr size_t WS_W1 = 38 * MiB;
constexpr size_t WS_W2 = 166 * MiB;
constexpr size_t WS_B = 230 * MiB;
constexpr size_t WS_A = 294 * MiB;
constexpr size_t WS_END = 494 * MiB;
constexpr int CW_BAR = 4096;
constexpr int CW_NMAXP = 12288;
constexpr int CW_NMAX = 8448;
constexpr int CW_QUEUE = 8704;
constexpr int CW_SPLIT = 10240;
constexpr int CW_CNT = 8192;
constexpr int CW_MOD = 16384;

constexpr int RING_OFF = 0, RING_BYTES = 131072;
constexpr int LDSCTL_OFF = RING_BYTES;
constexpr int LDS_BYTES = 147456;
constexpr int LT_PRE = LDSCTL_OFF + 256, LT_CNT = LT_PRE + 34 * 4;

#define GAS __attribute__((address_space(1)))
#define LAS __attribute__((address_space(3)))
typedef unsigned short bf16;
typedef unsigned v4u __attribute__((ext_vector_type(4)));
typedef unsigned v2u __attribute__((ext_vector_type(2)));
typedef float f32x4 __attribute__((ext_vector_type(4)));
typedef GAS unsigned gu32;
#define RLX_AGENT __ATOMIC_RELAXED, __HIP_MEMORY_SCOPE_AGENT
#define LDS_WAIT() asm volatile("s_waitcnt lgkmcnt(0)" ::: "memory")
#define VM_WAIT() asm volatile("s_waitcnt vmcnt(0)" ::: "memory")
__device__ __forceinline__ unsigned f2bf(float f) { unsigned u = __builtin_bit_cast(unsigned, f); return (u + 0x7fffu + ((u >> 16) & 1u)) >> 16; }
__device__ __forceinline__ unsigned pk2(float lo, float hi) { return f2bf(lo) | (f2bf(hi) << 16); }
__device__ __forceinline__ float bf_lo(unsigned w) { return __builtin_bit_cast(float, w << 16); }
__device__ __forceinline__ float bf_hi(unsigned w) { return __builtin_bit_cast(float, w & 0xffff0000u); }

#define XB_TMO      128
#define XB_XCNT(j)  (256  + 64 * (j))
#define XB_XSUB(j)  (1280 + 64 * (j))
#define XB_XGEN(j)  (2304 + 64 * (j))
#define XB_TOP      3328
#define XB_TOPGEN   3392
#define XCD_BAR_WORDS 3456
#define XB_SPIN_CAP (1u << 18)

__device__ __forceinline__ unsigned xb_ld(unsigned* p)              { return __hip_atomic_load(p, __ATOMIC_RELAXED, __HIP_MEMORY_SCOPE_AGENT); }
__device__ __forceinline__ unsigned xb_add(unsigned* p, unsigned v) { return __hip_atomic_fetch_add(p, v, __ATOMIC_RELAXED, __HIP_MEMORY_SCOPE_AGENT); }
__device__ __forceinline__ unsigned xb_xcc_id() { return (unsigned)__builtin_amdgcn_s_getreg((3 << 11) | 20) & 0xFu; }
#define XB_SPIN(cond, bar) do { unsigned _sp = 0; while (cond) { __builtin_amdgcn_s_sleep(1); \
    if ((++_sp & 255u) == 0u) { if (xb_ld(&(bar)[XB_TMO])) break; if (_sp > XB_SPIN_CAP) { atomicAdd(&(bar)[XB_TMO], 1u); break; } } } } while (0)

struct XcdBarrier {
    unsigned* bar; unsigned x;
    volatile LAS unsigned* st;
};

__device__ __forceinline__ XcdBarrier xcd_barrier_post(unsigned* bar, volatile LAS unsigned* st) {
    XcdBarrier b; b.bar = bar; b.x = xb_xcc_id(); b.st = st;
    if (threadIdx.x == 0) (void)xb_add(&bar[XB_XCNT(b.x)], 1u);
    return b;
}
__device__ __forceinline__ void xcd_barrier_complete(unsigned* bar, unsigned x, unsigned& nloc, unsigned& nx) {
    const unsigned G = gridDim.x * gridDim.y * gridDim.z;
    unsigned sum, cnt, mine, sp = 0u;
    for (;;) {
        sum = 0u; cnt = 0u; mine = 0u;
#pragma unroll
        for (unsigned j = 0; j < 16; ++j) { const unsigned c = xb_ld(&bar[XB_XCNT(j)]); sum += c; cnt += (c > 0u) ? 1u : 0u; mine = (j == x) ? c : mine; }
        if (sum == G) break;
        __builtin_amdgcn_s_sleep(1);
        if ((++sp & 255u) == 0u) { if (xb_ld(&bar[XB_TMO])) break; if (sp > XB_SPIN_CAP) { atomicAdd(&bar[XB_TMO], 1u); break; } }
    }
    nloc = mine > 0u ? mine : 1u; nx = cnt > 0u ? cnt : 1u;
}

__device__ __forceinline__ void xcd_barrier(const XcdBarrier& b) {
    asm volatile("s_waitcnt vmcnt(0)" ::: "memory");
    __syncthreads();
    if (threadIdx.x == 0) {
        unsigned* bar = b.bar;
        __builtin_amdgcn_s_waitcnt(0);
        unsigned nloc = b.st[0], nx = b.st[1];
        if (nloc == 0u) { xcd_barrier_complete(bar, b.x, nloc, nx); b.st[0] = nloc; b.st[1] = nx; }
        const unsigned old = xb_add(&bar[XB_XSUB(b.x)], 1u);
        const unsigned gen = old / nloc;
        if (old + 1u == (gen + 1u) * nloc) {
            __builtin_amdgcn_fence(__ATOMIC_RELEASE, "agent");
            asm volatile("s_waitcnt vmcnt(0)" ::: "memory");
            const unsigned og = xb_add(&bar[XB_TOP], 1u);
            const unsigned tg = og / nx;
            if (og + 1u == (tg + 1u) * nx) xb_add(&bar[XB_TOPGEN], 1u);
            else XB_SPIN(xb_ld(&bar[XB_TOPGEN]) == tg, bar);
            __builtin_amdgcn_fence(__ATOMIC_ACQUIRE, "agent");
            xb_add(&bar[XB_XGEN(b.x)], 1u);
            asm volatile("s_waitcnt vmcnt(0)" ::: "memory");
        } else {
            XB_SPIN(xb_ld(&bar[XB_XGEN(b.x)]) == gen, bar);
            __builtin_amdgcn_fence(__ATOMIC_ACQUIRE, "agent");
            asm volatile("s_waitcnt vmcnt(0)" ::: "memory");
        }
    }
    __syncthreads();
}

struct Frame {
    LAS unsigned char* lds;
    gu32* ctl;
    int tid, lane, wave;
    int vcu, G;
    const float* in[23]; float* out; unsigned char* ws;
};
enum { I_X = 0, I_C, I_WADA, I_BADA, I_GPRE1, I_WIN, I_LQ1, I_LK1, I_LQ2, I_LK2, I_GSUB, I_WCONV, I_WOUT, I_GPOST1, I_GPRE2, I_WRG, I_BRG, I_WRE, I_BRE, I_WGATE, I_WUP, I_WDOWN, I_GPOST2 };

__device__ __forceinline__ int opaque_i(int v) { asm volatile("" : "+v"(v)); return v; }
__device__ __forceinline__ float wave_sum(float v) {
#pragma unroll
    for (int o = 1; o < 64; o <<= 1) v += __shfl_xor(v, o);
    return v;
}
__device__ __forceinline__ float modval(const Frame& F, int n) {
    const long long a = ((const long long*)(F.ctl + CW_MOD))[n];
    return F.in[I_BADA][n] + (float)a * 9.094947017729282e-13f;
}

template <bool NT_ST>
__device__ __forceinline__ void p0_transpose_item(const float* W, int K, int N, bf16* WT, int k0, int n0, int dst_row0, LAS float* scr, int lane) {
    unsigned vld = (unsigned)(((lane >> 5) * N + (lane & 31)) * 4), vst = (unsigned)((((lane >> 3) * K) + 8 * (lane & 7)) * 2);
    asm volatile("" : "+v"(vld), "+v"(vst));
    const GAS char* Wb = (const GAS char*)(W + (size_t)k0 * N + n0);
    float t_[32];
#pragma unroll
    for (int i = 0; i < 32; ++i) t_[i] = __builtin_nontemporal_load((const GAS float*)(Wb + (size_t)(2 * i) * N * 4 + vld));
#pragma unroll
    for (int i = 0; i < 32; ++i) { const int kk = 2 * i + (lane >> 5); scr[kk * 33 + (lane & 31)] = t_[i]; }
    LDS_WAIT(); asm volatile("" ::: "memory");
    const int c = lane & 7;
    GAS char* Tb = (GAS char*)(WT + (size_t)dst_row0 * K + k0);
#pragma unroll
    for (int j = 0; j < 4; ++j) { const int n = (lane >> 3) + 8 * j; const LAS float* s = scr + (8 * c) * 33 + n;
        v4u o; o.x = pk2(s[0 * 33], s[1 * 33]); o.y = pk2(s[2 * 33], s[3 * 33]); o.z = pk2(s[4 * 33], s[5 * 33]); o.w = pk2(s[6 * 33], s[7 * 33]);
        if (NT_ST) __builtin_nontemporal_store(o, (GAS v4u*)(Tb + (size_t)(8 * j) * K * 2 + vst)); else *(GAS v4u*)(Tb + (size_t)(8 * j) * K * 2 + vst) = o; }
    LDS_WAIT(); asm volatile("" ::: "memory");
}
constexpr int CVT_I_IN = 32 * 192, CVT_I_OUT = 32 * 64, CVT_I_G = 32 * 32 * 16, CVT_I_D = 32 * 8 * 64, CVT_NITEMS = CVT_I_IN + CVT_I_OUT + 2 * CVT_I_G + CVT_I_D;
constexpr int CVT_CHUNK = 64, CVT_NCHUNK = (CVT_NITEMS - CVT_I_IN + CVT_CHUNK - 1) / CVT_CHUNK;
__device__ __forceinline__ void cvt_item(Frame& F, int it, LAS float* scr, int lane) {
    int r = it;
    if (r < CVT_I_IN) { const int kb = r / 192, nb = r % 192; p0_transpose_item<false>(F.in[I_WIN], 2048, 6144, (bf16*)(F.ws + WS_WIN), 64 * kb, 32 * nb, 32 * nb, scr, lane); return; } r -= CVT_I_IN;
    if (r < CVT_I_OUT) { const int kb = r / 64, nb = r % 64; p0_transpose_item<false>(F.in[I_WOUT], 2048, 2048, (bf16*)(F.ws + WS_WOUT), 64 * kb, 32 * nb, 32 * nb, scr, lane); return; } r -= CVT_I_OUT;
    if (r < 2 * CVT_I_G) { const int up = r / CVT_I_G; r -= up * CVT_I_G; const int e = r / 512, q = r % 512, kb = q / 16, nb = q % 16, n0 = 32 * nb;
        p0_transpose_item<true>(F.in[up ? I_WUP : I_WGATE] + (size_t)e * 2048 * 512, 2048, 512, (bf16*)(F.ws + WS_W1), 64 * kb, n0, e * 1024 + (n0 >> 7) * 256 + up * 128 + (n0 & 127), scr, lane); return; } r -= 2 * CVT_I_G;
    { const int e = r / 512, q = r % 512, kb = q / 64, nb = q % 64;
        p0_transpose_item<true>(F.in[I_WDOWN] + (size_t)e * 512 * 2048, 512, 2048, (bf16*)(F.ws + WS_W2), 64 * kb, 32 * nb, e * 2048 + 32 * nb, scr, lane); }
}
__device__ __forceinline__ void cvt_chunk(Frame& F, int c) {
    const int ln = F.lane;
    LAS float* scr = (LAS float*)(F.lds + RING_OFF + F.wave * 16384);
    const int base = CVT_I_IN + c * CVT_CHUNK + F.wave * 8;
#pragma unroll 1
    for (int i = 0; i < 8; ++i) { const int it = base + i; if (it < CVT_NITEMS) cvt_item(F, it, scr, ln); }
}
__device__ __forceinline__ void p0_prologue(Frame& F) {
    const int gw = F.vcu * NWAVES + F.wave, NGW = F.G * NWAVES;
    {
        const float* c = F.in[I_C]; const float* W = F.in[I_WADA];
        unsigned long long* acc = (unsigned long long*)(F.ctl + CW_MOD);
        for (int it = gw; it < 48 * 32; it += NGW) {
            const int cg = it % 48, ks = it / 48, k0 = ks * 64, col = cg * 256 + F.lane * 4;
            f32x4 a = {0.f, 0.f, 0.f, 0.f};
#pragma unroll 16
            for (int kk = 0; kk < 64; ++kk) { const float cv = c[k0 + kk]; const float s = cv / (1.0f + __expf(-cv)); const f32x4 w = __builtin_nontemporal_load((const f32x4*)(W + (size_t)(k0 + kk) * 12288 + col)); a += w * s; }
#pragma unroll
            for (int i = 0; i < 4; ++i) { const long long q = __float2ll_rn(a[i] * 1099511627776.0f); atomicAdd(acc + col + i, (unsigned long long)q); }
        }
    }
    {
        bf16* WF = (bf16*)(F.ws + WS_WRT);
        for (int idx = blockIdx.x * 512 + F.tid; idx < 48 * 2048; idx += F.G * 512) {
            const int e = idx & 7, ln = (idx >> 3) & 63, f = idx >> 9; const int blk = f % 3, ks = (f / 3) & 3, wv = (f / 12) & 7, hf = f / 96;
            const int j = 16 * blk + (ln & 15), k = 1024 * hf + 128 * wv + 32 * ks + 8 * (ln >> 4) + e;
            const float w = (j < 32) ? F.in[I_WRE][k * 32 + j] : (j < 36) ? F.in[I_WRG][k * 4 + (j - 32)] : 0.f;
            const unsigned h = f2bf(w); const float r = w - __builtin_bit_cast(float, h << 16);
            WF[(size_t)f * 1024 + ln * 8 + e] = (bf16)h; WF[(size_t)f * 1024 + 512 + ln * 8 + e] = (bf16)f2bf(r); }
    }
    LAS float* scr = (LAS float*)(F.lds + RING_OFF + F.wave * 16384);
    for (int it = gw; it < CVT_I_IN; it += NGW) cvt_item(F, it, scr, F.lane);
#if defined(PROBE_PHASE) && PROBE_PHASE == 0
    for (int it = gw; it < CVT_NITEMS; it += NGW) cvt_item(F, it, scr, F.lane);
#endif
}

__device__ __forceinline__ void p1_norm(Frame& F) {
    const int lane_ = opaque_i(F.lane), tid_ = opaque_i(F.tid);
    LAS float* tA = (LAS float*)(F.lds + RING_OFF); LAS float* tB = tA + 2048;
    for (int i = tid_; i < 2048; i += 512) { tA[i] = F.in[I_GPRE1][i] * (1.0f + modval(F, 2048 + i)); tB[i] = modval(F, i); }
    __syncthreads();
    const int gw = F.vcu * NWAVES + F.wave, NGW = F.G * NWAVES;
    bf16* H1 = (bf16*)(F.ws + WS_B);
    for (int m = gw; m < SEQ; m += NGW) {
        const GAS f32x4* xr = (const GAS f32x4*)(F.in[I_X] + (size_t)m * DM) + lane_;
        f32x4 v[8]; float s = 0.f;
#pragma unroll
        for (int j = 0; j < 8; ++j) { v[j] = __builtin_nontemporal_load(xr + 64 * j); s += (v[j].x * v[j].x + v[j].y * v[j].y) + (v[j].z * v[j].z + v[j].w * v[j].w); }
        const float rstd = 1.0f / sqrtf(wave_sum(s) * (1.0f / DM) + NORM_EPS);
        GAS v2u* o8 = (GAS v2u*)(H1 + (size_t)m * DM) + lane_;
#pragma unroll
        for (int j = 0; j < 8; ++j) { const f32x4 a = *(const LAS f32x4*)(tA + 256 * j + 4 * lane_), b = *(const LAS f32x4*)(tB + 256 * j + 4 * lane_); const f32x4 h = v[j] * rstd * a + b;
            v2u w; w.x = pk2(h.x, h.y); w.y = pk2(h.z, h.w); o8[64 * j] = w; }
    }
    __syncthreads();
}

__device__ __noinline__ void p3_conv_item(const bf16* P, bf16* Y, const float* wc, int it, int lane) {
    {
        const int t0 = (it >> 1) * 16, ch = (it & 1) * 512 + lane * 8;
        float w0[8], w1[8], w2[8], z1[8], z2[8];
#pragma unroll
        for (int i = 0; i < 8; ++i) { w0[i] = wc[ch + i]; w1[i] = wc[1024 + ch + i]; w2[i] = wc[2048 + ch + i]; z1[i] = 0.f; z2[i] = 0.f; }
        for (int t = t0 - 2; t < t0 + 16; ++t) {
            if (t < 0) continue;
            const bf16* row = P + (size_t)t * att::PITCH;
            const v4u cg = __builtin_nontemporal_load((const GAS v4u*)(row + 4096 + ch)), xu = __builtin_nontemporal_load((const GAS v4u*)(row + 5120 + ch));
            float z[8];
#pragma unroll
            for (int i = 0; i < 4; ++i) { z[2 * i] = bf_lo(cg[i]) * bf_lo(xu[i]); z[2 * i + 1] = bf_hi(cg[i]) * bf_hi(xu[i]); }
            if (t >= t0) {
                const v4u bg = __builtin_nontemporal_load((const GAS v4u*)(row + 3072 + ch)); float y[8];
#pragma unroll
                for (int i = 0; i < 4; ++i) { y[2 * i] = bf_lo(bg[i]) * (w0[2 * i] * z2[2 * i] + w1[2 * i] * z1[2 * i] + w2[2 * i] * z[2 * i]);
                    y[2 * i + 1] = bf_hi(bg[i]) * (w0[2 * i + 1] * z2[2 * i + 1] + w1[2 * i + 1] * z1[2 * i + 1] + w2[2 * i + 1] * z[2 * i + 1]); }
                v4u o; o.x = pk2(y[0], y[1]); o.y = pk2(y[2], y[3]); o.z = pk2(y[4], y[5]); o.w = pk2(y[6], y[7]);
                *(GAS v4u*)(Y + (size_t)t * DM + 1024 + ch) = o;
            }
#pragma unroll
            for (int i = 0; i < 8; ++i) { z2[i] = z1[i]; z1[i] = z[i]; }
        }
    }
}
constexpr int CVT_NCHUNK_D = CVT_I_D / CVT_CHUNK, CVT_NCHUNK_P3 = CVT_NCHUNK - CVT_NCHUNK_D;
constexpr int SIDE_NCHUNK = CVT_NCHUNK_P3 + 2048 / NWAVES;
__device__ __forceinline__ void side_chunk(Frame& F, int c) {
    if (c < CVT_NCHUNK_P3) cvt_chunk(F, c); else p3_conv_item((const bf16*)(F.ws + WS_A), (bf16*)(F.ws + WS_B), F.in[I_WCONV], (c - CVT_NCHUNK_P3) * NWAVES + F.wave, F.lane);
}

__device__ __forceinline__ void p5_post_route(Frame& F) {
    const int lane_ = opaque_i(F.lane), tid_ = opaque_i(F.tid);
    LAS float* tG = (LAS float*)(F.lds + RING_OFF); LAS float* tA = tG + 2048; LAS float* tS = tA + 2048;
    for (int i = tid_; i < 2048; i += 512) { tG[i] = modval(F, 4096 + i) * F.in[I_GPOST1][i]; tA[i] = F.in[I_GPRE2][i] * (1.0f + modval(F, 8192 + i)); tS[i] = modval(F, 6144 + i); }
    __syncthreads();
    const bf16* Y1 = (const bf16*)(F.ws + WS_A); bf16* H2 = (bf16*)(F.ws + WS_B);
    float* gates = (float*)(F.ws + WS_GATES); int* slotix = (int*)(F.ws + WS_GATES + 256 * 1024); int* list = (int*)(F.ws + WS_LIST); unsigned* cnt = (unsigned*)(F.ctl + CW_CNT);
    LAS float* Lx = (LAS float*)(F.lds + RING_OFF + 40960);
    LAS float* Hh = (LAS float*)(F.lds + RING_OFF + 49152);
    constexpr int HS = 1028;
    for (int st = F.vcu; st < SEQ / 16; st += F.G) {
        f32x4 hv[2][8];
#pragma unroll
        for (int r = 0; r < 2; ++r) {
            const int m = 16 * st + 2 * F.wave + r;
            const GAS f32x4* xr = (const GAS f32x4*)(F.in[I_X] + (size_t)m * DM) + lane_;
            const GAS v2u* yr = (const GAS v2u*)(Y1 + (size_t)m * DM) + lane_;
            f32x4 xv[8]; v2u yp[8]; float s1 = 0.f;
#pragma unroll
            for (int j = 0; j < 8; ++j) { xv[j] = __builtin_nontemporal_load(xr + 64 * j); yp[j] = __builtin_nontemporal_load(yr + 64 * j); const f32x4 y = (f32x4){bf_lo(yp[j].x), bf_hi(yp[j].x), bf_lo(yp[j].y), bf_hi(yp[j].y)};
                s1 += (y.x * y.x + y.y * y.y) + (y.z * y.z + y.w * y.w); }
            const float r1 = 1.0f / sqrtf(wave_sum(s1) * (1.0f / DM) + NORM_EPS);
            GAS f32x4* orow = (GAS f32x4*)(F.out + (size_t)m * DM) + lane_; float s2 = 0.f;
#pragma unroll
            for (int j = 0; j < 8; ++j) { const f32x4 g = *(const LAS f32x4*)(tG + 256 * j + 4 * lane_); const f32x4 y = (f32x4){bf_lo(yp[j].x), bf_hi(yp[j].x), bf_lo(yp[j].y), bf_hi(yp[j].y)};
                xv[j] = xv[j] + y * r1 * g; __builtin_nontemporal_store(xv[j], orow + 64 * j);
                s2 += (xv[j].x * xv[j].x + xv[j].y * xv[j].y) + (xv[j].z * xv[j].z + xv[j].w * xv[j].w); }
            const float r2 = 1.0f / sqrtf(wave_sum(s2) * (1.0f / DM) + NORM_EPS);
            GAS v2u* h8 = (GAS v2u*)(H2 + (size_t)m * DM) + lane_;
#pragma unroll
            for (int j = 0; j < 8; ++j) { const f32x4 a = *(const LAS f32x4*)(tA + 256 * j + 4 * lane_), s = *(const LAS f32x4*)(tS + 256 * j + 4 * lane_); const f32x4 h = xv[j] * r2 * a + s; hv[r][j] = h;
                v2u w; w.x = pk2(h.x, h.y); w.y = pk2(h.z, h.w); h8[64 * j] = w; }
        }
        f32x4 acc0 = {0.f, 0.f, 0.f, 0.f}, acc1 = {0.f, 0.f, 0.f, 0.f}, acc2 = {0.f, 0.f, 0.f, 0.f};
        const int lr = opaque_i(lane_); const int kq = lr >> 4, ir = lr & 15;
        const GAS char* WHg = (const GAS char*)(F.ws + WS_WRT);
#pragma unroll
        for (int hf = 0; hf < 2; ++hf) {
            pg8::bf16x8 wh[4][3], wl[4][3];
            { const GAS char* wf = WHg + (size_t)((hf * 8 + F.wave) * 12) * 2048 + (unsigned)(lr * 16);
#pragma unroll
              for (int ks = 0; ks < 4; ++ks)
#pragma unroll
                  for (int b_ = 0; b_ < 3; ++b_) { wh[ks][b_] = *(const GAS pg8::bf16x8*)(wf + (ks * 3 + b_) * 2048); wl[ks][b_] = *(const GAS pg8::bf16x8*)(wf + (ks * 3 + b_) * 2048 + 1024); } }
#pragma unroll
            for (int r = 0; r < 2; ++r)
#pragma unroll
                for (int jj = 0; jj < 4; ++jj) *(LAS f32x4*)(Hh + (2 * F.wave + r) * HS + 256 * jj + 4 * lane_) = hv[r][4 * hf + jj];
            LDS_WAIT(); __syncthreads();
            const LAS float* bp = Hh + ir * HS + 128 * F.wave + 8 * kq;
#pragma unroll
            for (int ks = 0; ks < 4; ++ks) {
                const f32x4 b0 = *(const LAS f32x4*)(bp + 32 * ks), b1 = *(const LAS f32x4*)(bp + 32 * ks + 4);
                v4u hh, hl;
                hh.x = pg8::cvt_pk_bf16(b0.x, b0.y); hh.y = pg8::cvt_pk_bf16(b0.z, b0.w); hh.z = pg8::cvt_pk_bf16(b1.x, b1.y); hh.w = pg8::cvt_pk_bf16(b1.z, b1.w);
                hl.x = pg8::cvt_pk_bf16(b0.x - bf_lo(hh.x), b0.y - bf_hi(hh.x)); hl.y = pg8::cvt_pk_bf16(b0.z - bf_lo(hh.y), b0.w - bf_hi(hh.y));
                hl.z = pg8::cvt_pk_bf16(b1.x - bf_lo(hh.z), b1.y - bf_hi(hh.z)); hl.w = pg8::cvt_pk_bf16(b1.z - bf_lo(hh.w), b1.w - bf_hi(hh.w));
                const pg8::bf16x8 bh = __builtin_bit_cast(pg8::bf16x8, hh), bl = __builtin_bit_cast(pg8::bf16x8, hl);
                acc0 = __builtin_amdgcn_mfma_f32_16x16x32_bf16(wh[ks][0], bh, acc0, 0, 0, 0); acc1 = __builtin_amdgcn_mfma_f32_16x16x32_bf16(wh[ks][1], bh, acc1, 0, 0, 0); acc2 = __builtin_amdgcn_mfma_f32_16x16x32_bf16(wh[ks][2], bh, acc2, 0, 0, 0);
                acc0 = __builtin_amdgcn_mfma_f32_16x16x32_bf16(wl[ks][0], bh, acc0, 0, 0, 0); acc1 = __builtin_amdgcn_mfma_f32_16x16x32_bf16(wl[ks][1], bh, acc1, 0, 0, 0); acc2 = __builtin_amdgcn_mfma_f32_16x16x32_bf16(wl[ks][2], bh, acc2, 0, 0, 0);
                acc0 = __builtin_amdgcn_mfma_f32_16x16x32_bf16(wh[ks][0], bl, acc0, 0, 0, 0); acc1 = __builtin_amdgcn_mfma_f32_16x16x32_bf16(wh[ks][1], bl, acc1, 0, 0, 0); acc2 = __builtin_amdgcn_mfma_f32_16x16x32_bf16(wh[ks][2], bl, acc2, 0, 0, 0);
            }
            LDS_WAIT(); __syncthreads();
        }
#pragma unroll
        for (int g = 0; g < 4; ++g) { Hh[(F.wave * 12 + g) * 64 + lane_] = acc0[g]; Hh[(F.wave * 12 + 4 + g) * 64 + lane_] = acc1[g]; Hh[(F.wave * 12 + 8 + g) * 64 + lane_] = acc2[g]; }
        LDS_WAIT(); __syncthreads();
        { const int g = tid_ >> 6, ln = tid_ & 63; float s = 0.f;
#pragma unroll
          for (int w = 0; w < 8; ++w) s += Hh[(w * 12 + g) * 64 + ln];
          Lx[(ln & 15) * 37 + 16 * (g >> 2) + 4 * (ln >> 4) + (g & 3)] = s;
          if (tid_ < 64) { const int g2 = tid_ >> 4, l2 = tid_ & 15; float s2 = 0.f;
#pragma unroll
              for (int w = 0; w < 8; ++w) s2 += Hh[(w * 12 + 8 + g2) * 64 + l2];
              Lx[l2 * 37 + 32 + g2] = s2; } }
        LDS_WAIT(); __syncthreads();
        if (tid_ < 16) {
            const int row = tid_, m = 16 * st + row;
            float gl[4]; int gi = 0; float gm;
#pragma unroll
            for (int g = 0; g < 4; ++g) gl[g] = Lx[row * 37 + 32 + g] + F.in[I_BRG][g];
            gm = gl[0];
#pragma unroll
            for (int g = 1; g < 4; ++g) if (gl[g] > gm) { gm = gl[g]; gi = g; }
            float gs = 0.f;
#pragma unroll
            for (int g = 0; g < 4; ++g) gs += __expf(gl[g] - gm);
            const float gwt = 1.0f / gs;
            float el[8];
#pragma unroll
            for (int e = 0; e < 8; ++e) el[e] = Lx[row * 37 + gi * 8 + e] + F.in[I_BRE][gi * 8 + e];
            int i1 = 0; float l1 = el[0];
#pragma unroll
            for (int e = 1; e < 8; ++e) if (el[e] > l1) { l1 = el[e]; i1 = e; }
            int i2 = -1; float l2 = -INFINITY;
#pragma unroll
            for (int e = 0; e < 8; ++e) if (e != i1 && el[e] > l2) { l2 = el[e]; i2 = e; }
            const float w1 = 1.0f / (1.0f + __expf(l2 - l1)), w2 = 1.0f - w1;
            const int e1 = gi * 8 + i1, e2 = gi * 8 + i2;
            const unsigned p1 = atomicAdd(cnt + e1, 1u), p2 = atomicAdd(cnt + e2, 1u);
            list[e1 * CAP + (int)p1] = 2 * m; list[e2 * CAP + (int)p2] = 2 * m + 1;
            slotix[2 * m] = e1 * CAP + (int)p1; slotix[2 * m + 1] = e2 * CAP + (int)p2;
            gates[2 * m] = gwt * w1; gates[2 * m + 1] = gwt * w2;
        }
    }
}

__device__ __forceinline__ void p8_final(Frame& F) {
    const int lane_ = opaque_i(F.lane), tid_ = opaque_i(F.tid);
    LAS float* tG = (LAS float*)(F.lds + RING_OFF);
    for (int i = tid_; i < 2048; i += 512) tG[i] = modval(F, 10240 + i) * F.in[I_GPOST2][i];
    __syncthreads();
    const int gw = F.vcu * NWAVES + F.wave, NGW = F.G * NWAVES;
    const bf16* Y2 = (const bf16*)(F.ws + WS_A);
    const float* gates = (const float*)(F.ws + WS_GATES); const int* slotix = (const int*)(F.ws + WS_GATES + 256 * 1024);
    const LAS int* pre = (const LAS int*)(F.lds + LT_PRE);
    for (int m = gw; m < SEQ; m += NGW) {
        GAS f32x4* xr = (GAS f32x4*)(F.out + (size_t)m * DM) + lane_;
        const int i0 = slotix[2 * m], i1 = slotix[2 * m + 1]; const float g0 = gates[2 * m], g1 = gates[2 * m + 1];
        const int r0 = pre[i0 >> 14] * 256 + (i0 & (CAP - 1)), r1 = pre[i1 >> 14] * 256 + (i1 & (CAP - 1));
        const GAS v2u* ya = (const GAS v2u*)(Y2 + (size_t)r0 * DM) + lane_; const GAS v2u* yb = (const GAS v2u*)(Y2 + (size_t)r1 * DM) + lane_;
        f32x4 xv[8], yv[8]; float s = 0.f;
#pragma unroll
        for (int j = 0; j < 8; ++j) { xv[j] = __builtin_nontemporal_load(xr + 64 * j); const v2u a = __builtin_nontemporal_load(ya + 64 * j), b = __builtin_nontemporal_load(yb + 64 * j);
            yv[j] = (f32x4){g0 * bf_lo(a.x) + g1 * bf_lo(b.x), g0 * bf_hi(a.x) + g1 * bf_hi(b.x), g0 * bf_lo(a.y) + g1 * bf_lo(b.y), g0 * bf_hi(a.y) + g1 * bf_hi(b.y)};
            s += (yv[j].x * yv[j].x + yv[j].y * yv[j].y) + (yv[j].z * yv[j].z + yv[j].w * yv[j].w); }
        const float rstd = 1.0f / sqrtf(wave_sum(s) * (1.0f / DM) + NORM_EPS);
#pragma unroll
        for (int j = 0; j < 8; ++j) { const f32x4 g = *(const LAS f32x4*)(tG + 256 * j + 4 * lane_); __builtin_nontemporal_store(xv[j] + yv[j] * rstd * g, xr + 64 * j); }
    }
}

template <int NPN, bool TOKEN_ROWS>
struct MoeOrder {
    static constexpr bool GATHER = true;
    const LAS int* pre; const LAS int* cntl; const int* list; int G, c;
    __device__ __forceinline__ bool next(int i, pg8::Unit& u) const {
        const int L = i * G + c; const int total = __builtin_amdgcn_readfirstlane(pre[32]);
        if (L >= total * NPN) return false;
        const int rt = L / NPN, pnl = L % NPN;
        const int ln_ = (int)(threadIdx.x & 31u);
        const unsigned long long bal = __ballot(pre[ln_] <= rt);
        const int e = __builtin_amdgcn_readfirstlane(31 - __builtin_clz((unsigned)(bal & 0xffffffffull)));
        u.pm = rt; u.e = e; u.row0 = __builtin_amdgcn_readfirstlane((rt - pre[e]) * 256); const int left = __builtin_amdgcn_readfirstlane(cntl[e]) - u.row0; u.nvalid = left < 256 ? left : 256; u.pn = e * NPN + pnl;
        return true;
    }
    __device__ __forceinline__ void rows(const pg8::Unit& u, const int (&RA)[2], const int (&CA)[2], int K, unsigned (&v)[2][2]) const {
#pragma unroll
        for (int h = 0; h < 2; ++h)
#pragma unroll
            for (int i = 0; i < 2; ++i) { const int r = h * 128 + RA[i];
                if (TOKEN_ROWS) { const int ts = list[u.e * CAP + u.row0 + (r < u.nvalid ? r : 0)]; v[h][i] = (unsigned)(((ts >> 1) * K + CA[i]) * 2); }
                else v[h][i] = (unsigned)(((u.pm * 256 + r) * K + CA[i]) * 2); }
    }
};
struct EpiSwiglu {
    static constexpr bool PERM = true;
    bf16* act;
    __device__ __forceinline__ void operator()(const pg8::f32x4 (&acc)[2][2][4][2], const pg8::Unit& u, int wr, int wc, int fr, int fq) const {
        const int pnl = u.pn & 3; const int col0 = pnl * 128 + wc * 32 + 8 * fq;
#pragma unroll
        for (int ai = 0; ai < 2; ++ai)
#pragma unroll
            for (int m = 0; m < 4; ++m) { const int r = ai * 128 + wr * 64 + m * 16 + fr;
                float o[8];
#pragma unroll
                for (int n = 0; n < 2; ++n)
#pragma unroll
                    for (int i = 0; i < 4; ++i) { const float g = acc[ai][0][m][n][i], up = acc[ai][1][m][n][i]; o[4 * n + i] = g * __builtin_amdgcn_rcpf(1.0f + __expf(-g)) * up; }
                pg8::u32x4 w; w.x = pg8::cvt_pk_bf16(o[0], o[1]); w.y = pg8::cvt_pk_bf16(o[2], o[3]); w.z = pg8::cvt_pk_bf16(o[4], o[5]); w.w = pg8::cvt_pk_bf16(o[6], o[7]);
                *(pg8::u32x4*)(act + (size_t)(u.pm * 256 + r) * DEXP + col0) = w; }
    }
};
struct EpiDown {
    static constexpr bool PERM = true;
    bf16* y2;
    __device__ __forceinline__ void operator()(const pg8::f32x4 (&acc)[2][2][4][2], const pg8::Unit& u, int wr, int wc, int fr, int fq) const {
        const int pnl = u.pn & 7; const int col0 = pnl * 256 + wc * 32 + 8 * fq;
#pragma unroll
        for (int ai = 0; ai < 2; ++ai)
#pragma unroll
            for (int m = 0; m < 4; ++m) { const int r = ai * 128 + wr * 64 + m * 16 + fr; bf16* rowp = y2 + (size_t)(u.pm * 256 + r) * DM + col0;
#pragma unroll
                for (int bj = 0; bj < 2; ++bj) { const pg8::f32x4 v0 = acc[ai][bj][m][0], v1 = acc[ai][bj][m][1];
                    pg8::u32x4 w; w.x = pg8::cvt_pk_bf16(v0[0], v0[1]); w.y = pg8::cvt_pk_bf16(v0[2], v0[3]); w.z = pg8::cvt_pk_bf16(v1[0], v1[1]); w.w = pg8::cvt_pk_bf16(v1[2], v1[3]);
                    *(pg8::u32x4*)(rowp + bj * 128) = w; } }
    }
};
struct EpiNull { static constexpr bool PERM = true; float* sink; __device__ __forceinline__ void operator()(const pg8::f32x4 (&acc)[2][2][4][2], const pg8::Unit& u, int wr, int wc, int fr, int fq) const {
              float s = 0.f; _Pragma("unroll") for (int a = 0; a < 2; ++a) _Pragma("unroll") for (int b = 0; b < 2; ++b) _Pragma("unroll") for (int m = 0; m < 4; ++m) _Pragma("unroll") for (int n = 0; n < 2; ++n) s += acc[a][b][m][n][0] + acc[a][b][m][n][1] + acc[a][b][m][n][2] + acc[a][b][m][n][3];
              if (s == 123.456f) sink[0] = s; } };
__device__ __forceinline__ void moe_tables(Frame& F) {
    LAS int* pre = (LAS int*)(F.lds + LT_PRE); LAS int* cl = (LAS int*)(F.lds + LT_CNT);
    if (F.tid == 0) { int s = 0; const unsigned* cnt = (const unsigned*)(F.ctl + CW_CNT);
        for (int e = 0; e < 32; ++e) { int c = (int)cnt[e]; c = c < 0 ? 0 : (c > CAP ? CAP : c); cl[e] = c; pre[e] = s; s += (c + 255) >> 8; } pre[32] = s; }
    __syncthreads();
}

struct Args { const float* in[23]; float* out; unsigned char* ws; int ph_lo, ph_hi; };
__global__ void __launch_bounds__(NWAVES * 64, 2) mk_fwd(Args args) {
    extern __shared__ __attribute__((aligned(16))) unsigned char lds[];
    Frame F;
    F.lds = (LAS unsigned char*)lds;
    F.tid = threadIdx.x; F.lane = F.tid & 63; F.wave = __builtin_amdgcn_readfirstlane(F.tid >> 6);
    F.G = gridDim.x; { const int bx = blockIdx.x; F.vcu = (F.G % 8 == 0) ? (bx % 8) * (F.G / 8) + bx / 8 : bx; }
    F.ws = args.ws; F.ctl = (gu32*)(args.ws + WS_CTL); F.out = args.out;
#pragma unroll
    for (int i = 0; i < 23; ++i) F.in[i] = args.in[i];
    for (int u = F.tid; u < (LDS_BYTES - LDSCTL_OFF) / 4; u += NWAVES * 64) ((LAS unsigned*)(F.lds + LDSCTL_OFF))[u] = 0u;
    __syncthreads();
    XcdBarrier bar; bar.bar = (unsigned*)(F.ctl + CW_BAR); bar.x = 0; bar.st = nullptr;
    if (N_LAUNCHES == 1) bar = xcd_barrier_post((unsigned*)(F.ctl + CW_BAR), (volatile LAS unsigned*)(F.lds + LDSCTL_OFF));
    const int lo = args.ph_lo, hi = args.ph_hi;
#define IN(k) (lo <= (k) && (k) < hi)
#define SEAM(k) do { if (IN(k) && IN((k) + 1)) xcd_barrier(bar); } while (0)
#ifdef PROBE_PHASE
#define REP(k) ((k) == PROBE_PHASE ? 2 : 1)
#else
#define REP(k) 1
#endif
#ifdef PROBE_SPIN
#define PH_BEGIN(k) const unsigned long long t0_##k = (PROBE_SPIN == (k)) ? __builtin_amdgcn_s_memrealtime() : 0ull;
#define PH_END(k) if (PROBE_SPIN == (k)) { __syncthreads(); const unsigned long long t1_ = __builtin_amdgcn_s_memrealtime(); while (__builtin_amdgcn_s_memrealtime() < t1_ + (t1_ - t0_##k)) __builtin_amdgcn_s_sleep(8); __syncthreads(); }
#else
#define PH_BEGIN(k)
#define PH_END(k)
#endif

    if (IN(0)) { PH_BEGIN(0) p0_prologue(F); PH_END(0) } SEAM(0);
    if (IN(1)) { PH_BEGIN(1) p1_norm(F); PH_END(1) } SEAM(1);
    if (IN(2)) { PH_BEGIN(2)
        pg8::Gemm g{(const pg8::bf16_t*)(F.ws + WS_B), (const pg8::bf16_t*)(F.ws + WS_WIN), SEQ, NPROJ, DM}; pg8::StaticOrder S; S.init(SEQ, NPROJ, F.G, (int)blockIdx.x);
        pg8::EpiBf16 E{(pg8::bf16_t*)(F.ws + WS_A), att::PITCH, 1024, att::QSCALE, 1024, 3072, (unsigned*)(F.ctl + CW_NMAXP), (unsigned*)(F.ctl + CW_NMAX), 2048};
        pg8::gemm_phase<pg8::EpiBf16, pg8::StaticOrder, true>(F.lds + RING_OFF, g, S, E); if (REP(2) == 2) { pg8::gemm_phase<pg8::EpiBf16, pg8::StaticOrder, true>(F.lds + RING_OFF, g, S, E); }
    PH_END(2) } SEAM(2);
    if (IN(3)) { PH_BEGIN(3)
        float lam;
        { const float a = wave_sum(F.in[I_LQ1][F.lane] * F.in[I_LK1][F.lane]), b = wave_sum(F.in[I_LQ2][F.lane] * F.in[I_LK2][F.lane]); lam = __expf(a) - __expf(b) + 0.2f; }
        const att::Tensors T{(const __hip_bfloat16*)(F.ws + WS_A), (__hip_bfloat16*)(F.ws + WS_B), F.in[I_GSUB], lam};
        const unsigned* nmx = (const unsigned*)(F.ctl + CW_NMAX); const unsigned* nmxp = (const unsigned*)(F.ctl + CW_NMAXP);
        LAS int* qslot = (LAS int*)(F.lds + LT_CNT + 256);
        constexpr int ATT_NITEMS = 1024 + 256; constexpr float T_SKIP = 48.0f;
#define ATT_QUEUE(VARIANT, TT, QW, WITH_CVT) for (bool more_ = true; more_;) { \
            if (F.tid == 0) { qslot[0] = (int)atomicAdd((unsigned*)(F.ctl + CW_QUEUE) + (QW), 1u); if (WITH_CVT) qslot[1] = (int)atomicAdd((unsigned*)(F.ctl + CW_QUEUE) + 128, 1u); } \
            __syncthreads(); \
            const int ui = __builtin_amdgcn_readfirstlane(qslot[0]); const int ci = WITH_CVT ? __builtin_amdgcn_readfirstlane(qslot[1]) : SIDE_NCHUNK; \
            __syncthreads(); \
            more_ = (ui < ATT_NITEMS) || (ci < SIDE_NCHUNK); \
            if (ui < ATT_NITEMS) { \
              \
            const int part = ui < 256 ? 1 : 0, u2 = ui - 256; \
            const int qb = part ? 127 - (ui >> 1) : 127 - (u2 >> 3), h = part ? 7 - (ui & 1) : (u2 & 7); \
            float sm = 0.f; \
            _Pragma("unroll") for (int mp = 0; mp < 2; ++mp) { const float qn = __uint_as_float(nmxp[32 * (qb >> 1) + 4 * h + 2 * mp]) + __uint_as_float(nmxp[32 * (qb >> 1) + 4 * h + 2 * mp + 1]), kn = __uint_as_float(nmx[32 + 4 * h + 2 * mp]) + __uint_as_float(nmx[32 + 4 * h + 2 * mp + 1]); \
                sm = fmaxf(sm, sqrtf(qn * kn)); } \
            const float slope2 = exp2f(-(float)(h + 1)) * att::LOG2E; \
            const float D = (2.0f * 1.02f * sm + T_SKIP) / slope2; \
            int t_lo = (int)ceilf(((float)(qb * 128 - 63) - D) * (1.0f / 64.0f)); t_lo = t_lo < 0 ? 0 : t_lo; \
            t_lo = __builtin_amdgcn_readfirstlane(t_lo); \
            const int n_t = 2 * qb + 2 - t_lo; const bool split = (h >= 6) && (n_t >= 96); const int n_a = n_t >> 1; \
            const int sidx = (h - 6) * 128 + qb; \
            float* dump = split ? (float*)(F.ws + WS_END) + (size_t)sidx * (2 * 8 * 66 * 64) : nullptr; \
            if (!part || split) att::attn_unit<VARIANT>(h, qb, part ? n_a : 0, (split && !part) ? n_a : n_t, part, dump, (unsigned*)(F.ctl + CW_SPLIT) + sidx, qslot + 2, 1.02f * sm, T_SKIP, TT, (att::lds_ptr)(F.lds + RING_OFF)); } \
            if (ci < SIDE_NCHUNK) side_chunk(F, ci); }
        ATT_QUEUE(0, T, 0, true)
#ifdef PROBE_ATT
        { const att::Tensors T2{(const __hip_bfloat16*)(F.ws + WS_A), (__hip_bfloat16*)(F.ws + WS_END), F.in[I_GSUB], lam};
          ATT_QUEUE(PROBE_ATT, T2, 64, false) }
#endif
#undef ATT_QUEUE
    PH_END(3) } SEAM(3);
    if (IN(4)) { PH_BEGIN(4)
        pg8::Gemm g{(const pg8::bf16_t*)(F.ws + WS_B), (const pg8::bf16_t*)(F.ws + WS_WOUT), SEQ, DM, DM}; pg8::StaticOrder S; S.init(SEQ, DM, F.G, (int)blockIdx.x);
        pg8::EpiBf16 E{(pg8::bf16_t*)(F.ws + WS_A), DM, 0, 1.0f, 0, 0, nullptr, nullptr, 0};
        pg8::gemm_phase<pg8::EpiBf16, pg8::StaticOrder, true>(F.lds + RING_OFF, g, S, E);
#ifdef PROBE_K
        { pg8::Gemm g2{(const pg8::bf16_t*)(F.ws + WS_B), (const pg8::bf16_t*)(F.ws + WS_WOUT), SEQ, DM, PROBE_K};
#ifdef PROBE_NOEPI
          EpiNull E2{(float*)(F.ws + WS_END)};
          pg8::gemm_phase<EpiNull, pg8::StaticOrder, true>(F.lds + RING_OFF, g2, S, E2); }
#else
          pg8::EpiBf16 E2{(pg8::bf16_t*)(F.ws + WS_END), DM, 0, 1.0f, 0, 0, nullptr, nullptr, 0};
          pg8::gemm_phase<pg8::EpiBf16, pg8::StaticOrder, true>(F.lds + RING_OFF, g2, S, E2); }
#endif
#endif if (REP(4) == 2) { pg8::gemm_phase<pg8::EpiBf16, pg8::StaticOrder, true>(F.lds + RING_OFF, g, S, E); }
    PH_END(4) } SEAM(4);
    if (IN(5)) { PH_BEGIN(5) p5_post_route(F); PH_END(5) } SEAM(5);
    if (IN(6)) { PH_BEGIN(6)
        moe_tables(F);
        pg8::Gemm g{(const pg8::bf16_t*)(F.ws + WS_B), (const pg8::bf16_t*)(F.ws + WS_W1), SEQ, 1024, DM};
        MoeOrder<4, true> S{(const LAS int*)(F.lds + LT_PRE), (const LAS int*)(F.lds + LT_CNT), (const int*)(F.ws + WS_LIST), F.G, F.vcu};
        EpiSwiglu E{(bf16*)(F.ws + WS_A + 160 * MiB)};
        pg8::gemm_phase<EpiSwiglu, MoeOrder<4, true>, true>(F.lds + RING_OFF, g, S, E);
        { LAS int* qs = (LAS int*)(F.lds + LT_CNT + 256);
          for (;;) { if (F.tid == 0) qs[0] = (int)atomicAdd((unsigned*)(F.ctl + CW_QUEUE) + 192, 1u);
              __syncthreads(); const int ci = __builtin_amdgcn_readfirstlane(qs[0]); __syncthreads();
              if (ci >= CVT_NCHUNK_D) break;
              cvt_chunk(F, CVT_NCHUNK_P3 + ci); } }
    PH_END(6) } SEAM(6);
    if (IN(7)) { PH_BEGIN(7)
        moe_tables(F);
        pg8::Gemm g{(const pg8::bf16_t*)(F.ws + WS_A + 160 * MiB), (const pg8::bf16_t*)(F.ws + WS_W2), 2 * SEQ, DM, DEXP};
        MoeOrder<8, false> S{(const LAS int*)(F.lds + LT_PRE), (const LAS int*)(F.lds + LT_CNT), (const int*)(F.ws + WS_LIST), F.G, F.vcu};
        EpiDown E{(bf16*)(F.ws + WS_A)};
        pg8::gemm_phase<EpiDown, MoeOrder<8, false>, true>(F.lds + RING_OFF, g, S, E); if (REP(7) == 2) { pg8::gemm_phase<EpiDown, MoeOrder<8, false>, true>(F.lds + RING_OFF, g, S, E); }
    PH_END(7) } SEAM(7);
    if (IN(8)) { PH_BEGIN(8) moe_tables(F); p8_final(F); PH_END(8) }
#undef IN
#undef SEAM
}

extern "C" void kernel_launch(void* const* d_in, const int* in_sizes, int n_in, void* d_out, int out_size, void* d_ws, size_t ws_size, hipStream_t stream) {
    static int grid = 0;
    if (grid == 0) {
        if (n_in != 23 || in_sizes[0] != SEQ * DM || out_size != SEQ * DM || ws_size < WS_END + 72 * MiB) { fprintf(stderr, "kernel_launch: shape/workspace mismatch (n_in %d, in0 %d, out %d, ws %zu < %zu); nothing launched\n", n_in, n_in > 0 ? in_sizes[0] : -1, out_size, ws_size, (size_t)WS_END); grid = -1; return; }
        int dev = 0, cus = 0, per_cu = 0;
        if (hipGetDevice(&dev) != hipSuccess || hipDeviceGetAttribute(&cus, hipDeviceAttributeMultiprocessorCount, dev) != hipSuccess) { fprintf(stderr, "kernel_launch: hipGetDevice / hipDeviceGetAttribute failed\n"); grid = -1; return; }
        if (hipFuncSetAttribute((const void*)mk_fwd, hipFuncAttributeMaxDynamicSharedMemorySize, LDS_BYTES) != hipSuccess) { fprintf(stderr, "kernel_launch: hipFuncSetAttribute failed\n"); grid = -1; return; }
        if (hipOccupancyMaxActiveBlocksPerMultiprocessor(&per_cu, (const void*)mk_fwd, NWAVES * 64, LDS_BYTES) != hipSuccess || per_cu < 1) { fprintf(stderr, "kernel_launch: occupancy query reports %d workgroups per CU\n", per_cu); }
        (void)hipGetLastError();
        grid = cus;
    }
    if (grid < 0) return;
    if (hipMemsetAsync((char*)d_ws + WS_CTL, 0, CTL_ZERO_BYTES, stream) != hipSuccess) { fprintf(stderr, "kernel_launch: hipMemsetAsync failed\n"); return; }
    Args a{};
    for (int i = 0; i < 23; ++i) a.in[i] = (const float*)d_in[i];
    a.out = (float*)d_out; a.ws = (unsigned char*)d_ws;
    for (int li = 0; li < N_LAUNCHES; ++li) {
        a.ph_lo = (N_LAUNCHES == 1) ? 0 : li; a.ph_hi = (N_LAUNCHES == 1) ? N_PHASES : li + 1;
        hipLaunchKernelGGL(mk_fwd, dim3(grid), dim3(NWAVES * 64), LDS_BYTES, stream, a);
        const hipError_t le = hipPeekAtLastError();
        if (le != hipSuccess) { fprintf(stderr, "kernel_launch: launch %d failed: %s\n", li, hipGetErrorName(le)); break; }
    }
}
```

```cpp
#include <hip/hip_runtime.h>
#include <hip/hip_bf16.h>
#include <cstdio>
#include <cstdint>
#include <cmath>

namespace pg8 {
#define PG8_LAS __attribute__((address_space(3)))
typedef unsigned short bf16_t;
typedef short bf16x8 __attribute__((ext_vector_type(8)));
typedef float f32x4 __attribute__((ext_vector_type(4)));
typedef unsigned u32x4 __attribute__((ext_vector_type(4)));
constexpr int BM = 256, BK = 64, HALF = 128, HTB = HALF * BK * 2  , STAGE_BYTES = 8 * HTB, NXCD = 8, WGM = 8;

__host__ __device__ __forceinline__ int lds_byte(int r, int c) { const int st = (r >> 4) * 2 + (c >> 5), rr = r & 15, cc = c & 31, ob = rr * 64 + cc * 2; return st * 1024 + (ob ^ (((ob >> 9) & 1) << 5)); }
__host__ __device__ __forceinline__ void stage_rc(int b, int& R, int& C) { const int st = b / 1024, sb = b % 1024, swz = sb ^ (((sb >> 9) & 1) << 5); R = (st >> 1) * 16 + swz / 64; C = (st & 1) * 32 + (swz % 64) / 2; }
__host__ __device__ __forceinline__ int perm32(int rho) { const int n = rho >> 4, i = rho & 15; return 8 * (i >> 2) + 4 * n + (i & 3); }

struct Unit { int pm, pn; int e, row0, nvalid; int half; };
struct Gemm { const bf16_t* A; const bf16_t* Bt; int M, N, K; };

struct StaticOrder {
    static constexpr bool GATHER = false; static constexpr bool SPLIT = false;
    int nM, nN, nwg, G, c;
    __host__ __device__ void init(int M, int N, int G_, int c_) { nM = M / BM; nN = N / BM; nwg = nM * nN; G = G_; c = c_; }
    __device__ __forceinline__ bool next(int i, Unit& u) const {
        const long L = (long)i * G + c; if (L >= nwg) return false;
        int wgid = (int)L; { const int q = nwg / NXCD, r = nwg % NXCD, xcd = wgid % NXCD, off = wgid / NXCD; wgid = (xcd < r ? xcd * (q + 1) : r * (q + 1) + (xcd - r) * q) + off; }
        const int nig = WGM * nN, gid = wgid / nig, fm = gid * WGM, gsz = (nM - fm) < WGM ? (nM - fm) : WGM;
        u.pm = fm + ((wgid % nig) % gsz); u.pn = (wgid % nig) / gsz; u.e = 0; u.row0 = 0; u.nvalid = 256; u.half = -1; return true;
    }
    __device__ __forceinline__ void rows(const Unit& u, const int (&RA)[2], const int (&CA)[2], int K, unsigned (&v)[2][2]) const {
#pragma unroll
        for (int h = 0; h < 2; ++h)
#pragma unroll
            for (int i = 0; i < 2; ++i) v[h][i] = (unsigned)(((u.pm * BM + h * HALF + RA[i]) * K + CA[i]) * 2);
    }
};

__device__ __forceinline__ unsigned cvt_pk_bf16(float lo, float hi) { unsigned r; asm volatile("v_cvt_pk_bf16_f32 %0, %1, %2" : "=v"(r) : "v"(lo), "v"(hi)); return r; }

struct EpiBf16 {
    static constexpr bool PERM = true;
    bf16_t* O; int ldc; int scale_cols; float scale0;
    int keep_lo, keep_hi;
    unsigned* nmaxp;
    unsigned* nmax; int nmax_cols;
    __device__ __forceinline__ void operator()(const f32x4 (&acc)[2][2][4][2], const Unit& u, int wr, int wc, int fr, int fq) const {
        const int row0 = u.pm * BM + wr * 64 + fr; const int colt = u.pn * BM;
        const float sc = (colt < scale_cols) ? scale0 : 1.f;
        const int col0 = colt + wc * 32 + 8 * fq;
        const bool donorm = (nmax != nullptr) && (colt < nmax_cols);
        const bool ntst = (keep_hi > 0) && (colt < keep_lo || colt >= keep_hi);
        float nm[2] = {0.f, 0.f};
#pragma unroll
        for (int ai = 0; ai < 2; ++ai)
#pragma unroll
            for (int m = 0; m < 4; ++m) { bf16_t* rowp = O + (size_t)(row0 + ai * HALF + m * 16) * ldc + col0;
#pragma unroll
                for (int bj = 0; bj < 2; ++bj) { f32x4 v0 = acc[ai][bj][m][0] * sc, v1 = acc[ai][bj][m][1] * sc;
                    u32x4 w; w.x = cvt_pk_bf16(v0[0], v0[1]); w.y = cvt_pk_bf16(v0[2], v0[3]); w.z = cvt_pk_bf16(v1[0], v1[1]); w.w = cvt_pk_bf16(v1[2], v1[3]);
                    if (ntst) __builtin_nontemporal_store(w, (u32x4*)(rowp + bj * HALF)); else *(u32x4*)(rowp + bj * HALF) = w;
                    if (donorm) { float ss = (v0[0] * v0[0] + v0[1] * v0[1]) + (v0[2] * v0[2] + v0[3] * v0[3]) + (v1[0] * v1[0] + v1[1] * v1[1]) + (v1[2] * v1[2] + v1[3] * v1[3]);
                        ss += __shfl_xor(ss, 16); ss += __shfl_xor(ss, 32); nm[bj] = fmaxf(nm[bj], ss); } } }
        if (donorm) {
#pragma unroll
            for (int bj = 0; bj < 2; ++bj) { float v = nm[bj];
#pragma unroll
                for (int o = 1; o < 16; o <<= 1) v = fmaxf(v, __shfl_xor(v, o));
                if ((threadIdx.x & 63) == 0) { atomicMax(nmax + (colt >> 5) + 4 * bj + wc, __float_as_uint(v)); if (nmaxp != nullptr && colt < 1024) atomicMax(nmaxp + 32 * u.pm + (colt >> 5) + 4 * bj + wc, __float_as_uint(v)); } }
        }
    }
};

template <class Epi, class Sched, bool ALIGN_EPI = false>
__device__ __forceinline__ void gemm_phase(PG8_LAS unsigned char* lds, const Gemm g, const Sched& S, const Epi& E) {
    const int tid = threadIdx.x, wid = __builtin_amdgcn_readfirstlane(tid >> 6), lane = tid & 63, wr = wid >> 2, wc = wid & 3, fr = lane & 15, fq = lane >> 4;
    const int K = g.K, nt = K / BK;
    int RA[2], CA[2]; unsigned voffB[2];
#pragma unroll
    for (int i = 0; i < 2; ++i) { int R, C; stage_rc(tid * 16 + i * 8192, R, C); const int Rb = Epi::PERM ? ((R & ~31) + perm32(R & 31)) : R;
        RA[i] = R; CA[i] = C; voffB[i] = (unsigned)(Rb * K + C) * 2u; }
    const size_t kstep = (size_t)(BK * 2);
    const size_t hstep = (size_t)HALF * K * 2;
    const size_t tstep = 2 * hstep;
    const unsigned ldsw = (unsigned)wid * 1024u;
    const int aoff = lds_byte(wr * 64 + fr, fq * 8), boff = lds_byte(wc * 32 + fr, fq * 8);
    const char* const Abase = (const char*)g.A;
#define PG8_SA(b, h) (((b) * 2 + (h)) * HTB)
#define PG8_SB(b, h) ((4 + (b) * 2 + (h)) * HTB)
#define PG8_STAGE(bufoff, gbase, voff) do { _Pragma("unroll") for (int _i = 0; _i < 2; ++_i) \
        __builtin_amdgcn_global_load_lds((const unsigned*)((const char*)(gbase) + (voff)[_i]), (PG8_LAS unsigned*)(lds + (bufoff) + ldsw + _i * 8192), 16, 0, 0); } while (0)
#define PG8_STAGE_A(bufoff, v0, v1, kb) do { \
        __builtin_amdgcn_global_load_lds((const unsigned*)(Abase + (size_t)((v0) + (kb))), (PG8_LAS unsigned*)(lds + (bufoff) + ldsw), 16, 0, 0); \
        __builtin_amdgcn_global_load_lds((const unsigned*)(Abase + (size_t)((v1) + (kb))), (PG8_LAS unsigned*)(lds + (bufoff) + ldsw + 8192), 16, 0, 0); } while (0)
#define PG8_LDA(dst, b, h) do { _Pragma("unroll") for (int m = 0; m < 4; ++m) _Pragma("unroll") for (int k = 0; k < 2; ++k) dst[m][k] = *(const PG8_LAS bf16x8*)(lds + PG8_SA(b, h) + aoff + m * 2048 + k * 1024); } while (0)
#define PG8_LDB(dst, b, h) do { _Pragma("unroll") for (int n = 0; n < 2; ++n) _Pragma("unroll") for (int k = 0; k < 2; ++k) dst[n][k] = *(const PG8_LAS bf16x8*)(lds + PG8_SB(b, h) + boff + n * 2048 + k * 1024); } while (0)
#define PG8_MMA(ai, bj, At, Bt) do { __builtin_amdgcn_s_setprio(1); _Pragma("unroll") for (int m = 0; m < 4; ++m) _Pragma("unroll") for (int n = 0; n < 2; ++n) _Pragma("unroll") for (int k = 0; k < 2; ++k) \
        acc[ai][bj][m][n] = __builtin_amdgcn_mfma_f32_16x16x32_bf16(Bt[n][k], At[m][k], acc[ai][bj][m][n], 0, 0, 0); __builtin_amdgcn_s_setprio(0); } while (0)
#define PG8_WAIT_V(n) asm volatile("s_waitcnt vmcnt(" #n ")" ::: "memory")
#define PG8_WAIT_L(n) asm volatile("s_waitcnt lgkmcnt(" #n ")" ::: "memory")
#define PG8_BAR __builtin_amdgcn_s_barrier()
#define PG8_SCHED __builtin_amdgcn_sched_barrier(0)
    Unit cur, nxt; int ui = 0;
    if (!S.next(0, cur)) return;
    f32x4 acc[2][2][4][2];
#pragma unroll
    for (int a = 0; a < 2; ++a)
#pragma unroll
        for (int b = 0; b < 2; ++b)
#pragma unroll
            for (int m = 0; m < 4; ++m)
#pragma unroll
                for (int n = 0; n < 2; ++n) acc[a][b][m][n] = (f32x4){0.f, 0.f, 0.f, 0.f};
    bf16x8 At[4][2], B0[2][2], B1[2][2];
    unsigned vAc[2][2], vAn[2][2];
    S.rows(cur, RA, CA, K, vAc);
    const char* cB = (const char*)g.Bt + (size_t)cur.pn * tstep;
    PG8_STAGE(PG8_SB(0, 0), cB, voffB); PG8_STAGE(PG8_SB(0, 1), cB + hstep, voffB); PG8_STAGE_A(PG8_SA(0, 0), vAc[0][0], vAc[0][1], 0u); PG8_STAGE_A(PG8_SA(0, 1), vAc[1][0], vAc[1][1], 0u);
    if (wr == 1) PG8_BAR;
    PG8_WAIT_V(2); PG8_BAR;
    PG8_STAGE(PG8_SB(1, 0), cB + kstep, voffB); PG8_STAGE_A(PG8_SA(1, 0), vAc[0][0], vAc[0][1], (unsigned)kstep); PG8_STAGE(PG8_SB(1, 1), cB + hstep + kstep, voffB);
    PG8_WAIT_V(6); PG8_BAR;
    for (;;) {
        const bool has_next = S.next(ui + 1, nxt);
        if (has_next) S.rows(nxt, RA, CA, K, vAn);
        else { vAn[0][0] = vAc[0][0]; vAn[0][1] = vAc[0][1]; vAn[1][0] = vAc[1][0]; vAn[1][1] = vAc[1][1]; }
        const char* nB = has_next ? (const char*)g.Bt + (size_t)nxt.pn * tstep : cB;
        for (int t = 0; t < nt; t += 2) {
            const bool last = (t == nt - 2);
            const unsigned kb1 = (unsigned)(t + 1) * (unsigned)kstep;
            const unsigned kb2 = last ? 0u : (unsigned)(t + 2) * (unsigned)kstep, kb3 = kb2 + (unsigned)kstep;
            const unsigned x00 = last ? vAn[0][0] : vAc[0][0], x01 = last ? vAn[0][1] : vAc[0][1], x10 = last ? vAn[1][0] : vAc[1][0], x11 = last ? vAn[1][1] : vAc[1][1];
            const char* b2 = last ? nB : cB + (size_t)(t + 2) * kstep; const char* b3 = b2 + kstep;
            PG8_LDB(B0, 0, 0); PG8_LDB(B1, 0, 1); PG8_SCHED; PG8_LDA(At, 0, 0); PG8_STAGE_A(PG8_SA(1, 1), vAc[1][0], vAc[1][1], kb1);
            PG8_WAIT_V(8); PG8_WAIT_L(0); PG8_BAR; PG8_MMA(0, 0, At, B0); PG8_MMA(0, 1, At, B1); PG8_BAR; PG8_SCHED;
            PG8_LDA(At, 0, 1); PG8_STAGE(PG8_SB(0, 0), b2, voffB); PG8_STAGE(PG8_SB(0, 1), b2 + hstep, voffB); PG8_STAGE_A(PG8_SA(0, 0), x00, x01, kb2);
            PG8_WAIT_V(8); PG8_WAIT_L(0); PG8_BAR; if (!Sched::SPLIT || cur.half < 0) { PG8_MMA(1, 0, At, B0); PG8_MMA(1, 1, At, B1); } PG8_BAR; PG8_SCHED;
            PG8_LDB(B0, 1, 0); PG8_LDB(B1, 1, 1); PG8_SCHED; PG8_LDA(At, 1, 0); PG8_STAGE_A(PG8_SA(0, 1), x10, x11, kb2);
            PG8_WAIT_V(8); PG8_WAIT_L(0); PG8_BAR; PG8_MMA(0, 0, At, B0); PG8_MMA(0, 1, At, B1); PG8_BAR; PG8_SCHED;
            PG8_LDA(At, 1, 1); PG8_STAGE(PG8_SB(1, 0), b3, voffB); PG8_STAGE(PG8_SB(1, 1), b3 + hstep, voffB); PG8_STAGE_A(PG8_SA(1, 0), x00, x01, kb3);
            PG8_WAIT_V(8); PG8_WAIT_L(0); PG8_BAR; if (!Sched::SPLIT || cur.half < 0) { PG8_MMA(1, 0, At, B0); PG8_MMA(1, 1, At, B1); } PG8_BAR; PG8_SCHED;
        }
        if constexpr (ALIGN_EPI) { if (wr == 0) PG8_BAR; }
        E(acc, cur, wr, wc, fr, fq);
        if (!has_next) break;
#pragma unroll
        for (int a = 0; a < 2; ++a)
#pragma unroll
            for (int b = 0; b < 2; ++b)
#pragma unroll
                for (int m = 0; m < 4; ++m)
#pragma unroll
                    for (int n = 0; n < 2; ++n) acc[a][b][m][n] = (f32x4){0.f, 0.f, 0.f, 0.f};
        cur = nxt; cB = nB; ++ui;
        vAc[0][0] = vAn[0][0]; vAc[0][1] = vAn[0][1]; vAc[1][0] = vAn[1][0]; vAc[1][1] = vAn[1][1];
        if constexpr (ALIGN_EPI) { if (wr == 1) PG8_BAR; }
    }
    PG8_WAIT_V(0);
    if constexpr (!ALIGN_EPI) { if (wr == 0) PG8_BAR; }
    PG8_BAR;
#undef PG8_SA
#undef PG8_SB
#undef PG8_STAGE
#undef PG8_STAGE_A
#undef PG8_LDA
#undef PG8_LDB
#undef PG8_MMA
#undef PG8_WAIT_V
#undef PG8_WAIT_L
#undef PG8_BAR
#undef PG8_SCHED
}
}

namespace att {
typedef __attribute__((address_space(3))) const char* lds_cptr;
typedef __attribute__((address_space(3))) char* lds_ptr;
using bf16x8 = __attribute__((ext_vector_type(8))) short;
using s16x4 = __attribute__((ext_vector_type(4))) short;
using f32x16 = __attribute__((ext_vector_type(16))) float;
using f32x4 = __attribute__((ext_vector_type(4))) float;
using u32x4 = __attribute__((ext_vector_type(4))) unsigned;
typedef short v4i16_t __attribute__((ext_vector_type(4)));
typedef float f32x2_t __attribute__((ext_vector_type(2))); typedef __bf16 bf16x2_t __attribute__((ext_vector_type(2)));
constexpr int PITCH = 6144 + 128;
constexpr int COL_Q = 0, COL_K = 1024, COL_V = 2048;
constexpr int SLOT = 16384;
constexpr int NSLOT = 4, L_K = 0, L_V = NSLOT * SLOT, L_X = 0, XSTRIDE = 17408, L_WS = 131072 + 2048, LDS_BYTES = L_WS + 8 * 256;
constexpr float LOG2E = 1.4426950408889634f;
constexpr float QSCALE = 0.125f * LOG2E;
constexpr float THR = 6.0f;

__device__ __forceinline__ int crow(int r, int hi) { return (r & 3) + 8 * (r >> 2) + 4 * hi; }
__device__ __forceinline__ void glds16(const void* sbase, unsigned voff, unsigned lds_dst) { unsigned keep;
    asm volatile("s_mov_b32 %0, m0\n\ts_mov_b32 m0, %3\n\ts_nop 0\n\tglobal_load_lds_dwordx4 %1, %2\n\ts_mov_b32 m0, %0" : "=&s"(keep) : "v"(voff), "s"(sbase), "s"(lds_dst) : "memory"); }
__device__ __forceinline__ float max3f(float a, float b, float c) { float r; asm("v_max3_f32 %0, %1, %2, %3" : "=v"(r) : "v"(a), "v"(b), "v"(c)); return r; }
__device__ __forceinline__ float max2f(float a, float b) { float r; asm("v_max_f32_e32 %0, %1, %2" : "=v"(r) : "v"(a), "v"(b)); return r; }
__device__ __forceinline__ unsigned cvtpk_s(float lo, float hi) { f32x2_t v = {lo, hi}; bf16x2_t b = __builtin_convertvector(v, bf16x2_t); return __builtin_bit_cast(unsigned, b); }
__device__ __forceinline__ s16x4 vtr(lds_cptr p) { return __builtin_bit_cast(s16x4, __builtin_amdgcn_ds_read_tr16_b64_v4i16((__attribute__((address_space(3))) v4i16_t*)p)); }

struct Tensors { const __hip_bfloat16* proj; __hip_bfloat16* ycat; const float* g_subln; float lam; };

__device__ __forceinline__ float xhalf(float v) { return __shfl_xor(v, 32); }

struct WaveState { f32x16 o[4]; float mhat, l_reg; u32x4 pw0, pw1, pw2, pw3; bool resc; };
__device__ __forceinline__ void att_pv(WaveState& st, lds_cptr vb, const int (&vof)[2]) {
    s16x4 alo[4], ahi[4], blo[4], bhi[4];
#define ATT_RD(LO, HI, db) do { _Pragma("unroll") for (int ks = 0; ks < 4; ++ks) { LO[ks] = vtr(vb + (vof[0] ^ (64 * (db))) + ks * 4096); HI[ks] = vtr(vb + (vof[1] ^ (64 * (db))) + ks * 4096); } } while (0)
#define ATT_PK(LO, HI, k) (bf16x8){LO[k][0], LO[k][1], LO[k][2], LO[k][3], HI[k][0], HI[k][1], HI[k][2], HI[k][3]}
#define ATT_MM(LO, HI, db) do { \
        st.o[db] = __builtin_amdgcn_mfma_f32_32x32x16_bf16(__builtin_bit_cast(bf16x8, st.pw0), ATT_PK(LO, HI, 0), st.o[db], 0, 0, 0); \
        st.o[db] = __builtin_amdgcn_mfma_f32_32x32x16_bf16(__builtin_bit_cast(bf16x8, st.pw1), ATT_PK(LO, HI, 1), st.o[db], 0, 0, 0); \
        st.o[db] = __builtin_amdgcn_mfma_f32_32x32x16_bf16(__builtin_bit_cast(bf16x8, st.pw2), ATT_PK(LO, HI, 2), st.o[db], 0, 0, 0); \
        st.o[db] = __builtin_amdgcn_mfma_f32_32x32x16_bf16(__builtin_bit_cast(bf16x8, st.pw3), ATT_PK(LO, HI, 3), st.o[db], 0, 0, 0); } while (0)
    ATT_RD(alo, ahi, 0); ATT_RD(blo, bhi, 1); __builtin_amdgcn_sched_barrier(0);
    ATT_MM(alo, ahi, 0); __builtin_amdgcn_sched_barrier(0);
    ATT_RD(alo, ahi, 2); __builtin_amdgcn_sched_barrier(0);
    ATT_MM(blo, bhi, 1); __builtin_amdgcn_sched_barrier(0);
    ATT_RD(blo, bhi, 3); __builtin_amdgcn_sched_barrier(0);
    ATT_MM(alo, ahi, 2); __builtin_amdgcn_sched_barrier(0);
    ATT_MM(blo, bhi, 3);
#undef ATT_RD
#undef ATT_PK
#undef ATT_MM
}

__device__ __forceinline__ void att_rescale(WaveState& st, __attribute__((address_space(3))) float* wsf, int hi) {
    float fr_[16];
#pragma unroll
    for (int r = 0; r < 16; ++r) fr_[r] = wsf[crow(r, hi)];
#pragma unroll
    for (int d = 0; d < 4; ++d)
#pragma unroll
        for (int r = 0; r < 16; ++r) st.o[d][r] *= fr_[r];
    st.resc = false;
}
__device__ __forceinline__ void att_step(WaveState& st, bool pend, lds_cptr vbp, const int (&vof)[2], const bf16x8 (&qr)[4], lds_cptr kb, int kof,
                                         __attribute__((address_space(3))) float* wsf, float slope2, int qpos, int t, bool diag, bool first, int r32, int hi,
                                         const __hip_bfloat16* dk, const __hip_bfloat16* dv, unsigned dkd, unsigned dvd, unsigned dvoff, bool act) {
    if (st.resc) att_rescale(st, wsf, hi);
    f32x16 p0, p1;
    bf16x8 kf[8];
#pragma unroll
    for (int d0 = 0; d0 < 4; ++d0) { kf[2 * d0] = *(const __attribute__((address_space(3))) bf16x8*)(kb + (kof ^ (32 * d0))); kf[2 * d0 + 1] = *(const __attribute__((address_space(3))) bf16x8*)(kb + (kof ^ (32 * d0)) + 8192); }
    __builtin_amdgcn_sched_barrier(0);
    const float dq = (float)(qpos - t * 64 - 4 * hi);
    if (diag) {
#pragma unroll
        for (int r = 0; r < 16; ++r) { const float d0_ = dq - (float)((r & 3) + 8 * (r >> 2)); p0[r] = -slope2 * fabsf(d0_) - st.mhat; p1[r] = -slope2 * fabsf(d0_ - 32.f) - st.mhat; }
    } else {
        float s2v = slope2; asm volatile("" : "+v"(s2v));
        const float A0 = -s2v * dq - st.mhat, A1 = A0 + 32.f * s2v;
#pragma unroll
        for (int r = 0; r < 16; ++r) { const float cr = (float)((r & 3) + 8 * (r >> 2)); p0[r] = fmaf(cr, s2v, A0); p1[r] = fmaf(cr, s2v, A1); }
    }
    __builtin_amdgcn_sched_barrier(0);
#define ATT_QK(d0) p0 = __builtin_amdgcn_mfma_f32_32x32x16_bf16(kf[2 * (d0)], qr[d0], p0, 0, 0, 0); __builtin_amdgcn_sched_barrier(0); p1 = __builtin_amdgcn_mfma_f32_32x32x16_bf16(kf[2 * (d0) + 1], qr[d0], p1, 0, 0, 0); __builtin_amdgcn_sched_barrier(0)
    ATT_QK(0); glds16(dk, dvoff, dkd); __builtin_amdgcn_sched_barrier(0);
    ATT_QK(1); glds16(dk + (size_t)32 * PITCH, dvoff, dkd + 8192); __builtin_amdgcn_sched_barrier(0);
    ATT_QK(2); glds16(dv, dvoff, dvd); __builtin_amdgcn_sched_barrier(0);
    ATT_QK(3); glds16(dv + (size_t)32 * PITCH, dvoff, dvd + 8192); __builtin_amdgcn_sched_barrier(0);
#undef ATT_QK
    if (!act) return;
    asm volatile("s_nop 15\n\ts_nop 7" : "+v"(p0), "+v"(p1));
    float rm;
    { float a_ = max3f(p0[0], p0[1], p1[0]), b_ = max3f(p0[2], p0[3], p1[1]); a_ = max3f(a_, p1[2], p1[3]);
#pragma unroll
      for (int r = 4; r < 16; r += 4) { a_ = max3f(a_, p0[r], p0[r + 1]); b_ = max3f(b_, p0[r + 2], p0[r + 3]); a_ = max3f(a_, p1[r], p1[r + 1]); b_ = max3f(b_, p1[r + 2], p1[r + 3]); }
      rm = max2f(a_, b_); }
    { auto rr = __builtin_amdgcn_permlane32_swap(__float_as_uint(rm), __float_as_uint(rm), false, false); rm = max2f(__uint_as_float(rr[0]), __uint_as_float(rr[1])); }
    const bool need = first || __any(rm > THR);
    float f = 1.0f;
    if (need) {
        const float dl = first ? rm : fmaxf(rm, 0.f);
        st.mhat += dl;
#pragma unroll
        for (int r = 0; r < 16; ++r) { p0[r] -= dl; p1[r] -= dl; }
        if (!first) { f = __builtin_amdgcn_exp2f(-dl); if (hi == 0) wsf[r32] = f; st.resc = true; }
    }
    u32x4 nw0, nw1, nw2, nw3; float sacc = 0.f;
    {
        s16x4 alo[4], ahi[4], blo[4], bhi[4];
#define ATT_RD(LO, HI, ks) do { _Pragma("unroll") for (int db = 0; db < 4; ++db) { LO[db] = vtr(vbp + (vof[0] ^ (64 * db)) + (ks) * 4096); HI[db] = vtr(vbp + (vof[1] ^ (64 * db)) + (ks) * 4096); } } while (0)
#define ATT_PK(LO, HI, k) (bf16x8){LO[k][0], LO[k][1], LO[k][2], LO[k][3], HI[k][0], HI[k][1], HI[k][2], HI[k][3]}
#define ATT_GAP(db, LO, HI, PW, E0, E1, NW) do { \
        st.o[db] = __builtin_amdgcn_mfma_f32_32x32x16_bf16(__builtin_bit_cast(bf16x8, PW), ATT_PK(LO, HI, db), st.o[db], 0, 0, 0); \
        E0 = __builtin_amdgcn_exp2f(E0); E1 = __builtin_amdgcn_exp2f(E1); sacc += E0; sacc += E1; NW = cvtpk_s(E0, E1); __builtin_amdgcn_sched_barrier(0); } while (0)
        ATT_RD(alo, ahi, 0); ATT_RD(blo, bhi, 1); __builtin_amdgcn_sched_barrier(0);
        ATT_GAP(0, alo, ahi, st.pw0, p0[0], p0[1], nw0.x); ATT_GAP(1, alo, ahi, st.pw0, p0[2], p0[3], nw0.y); ATT_GAP(2, alo, ahi, st.pw0, p0[4], p0[5], nw0.z); ATT_GAP(3, alo, ahi, st.pw0, p0[6], p0[7], nw0.w);
        ATT_RD(alo, ahi, 2); __builtin_amdgcn_sched_barrier(0);
        ATT_GAP(0, blo, bhi, st.pw1, p0[8], p0[9], nw1.x); ATT_GAP(1, blo, bhi, st.pw1, p0[10], p0[11], nw1.y); ATT_GAP(2, blo, bhi, st.pw1, p0[12], p0[13], nw1.z); ATT_GAP(3, blo, bhi, st.pw1, p0[14], p0[15], nw1.w);
        ATT_RD(blo, bhi, 3); __builtin_amdgcn_sched_barrier(0);
        ATT_GAP(0, alo, ahi, st.pw2, p1[0], p1[1], nw2.x); ATT_GAP(1, alo, ahi, st.pw2, p1[2], p1[3], nw2.y); ATT_GAP(2, alo, ahi, st.pw2, p1[4], p1[5], nw2.z); ATT_GAP(3, alo, ahi, st.pw2, p1[6], p1[7], nw2.w);
        ATT_GAP(0, blo, bhi, st.pw3, p1[8], p1[9], nw3.x); ATT_GAP(1, blo, bhi, st.pw3, p1[10], p1[11], nw3.y); ATT_GAP(2, blo, bhi, st.pw3, p1[12], p1[13], nw3.z); ATT_GAP(3, blo, bhi, st.pw3, p1[14], p1[15], nw3.w);
#undef ATT_RD
#undef ATT_PK
#undef ATT_GAP
    }
    asm volatile("" : "+v"(nw0), "+v"(nw1), "+v"(nw2), "+v"(nw3), "+v"(sacc));
    st.l_reg = st.l_reg * f + sacc; st.pw0 = nw0; st.pw1 = nw1; st.pw2 = nw2; st.pw3 = nw3;
}

template <int VAR>
__device__ __forceinline__ void attn_unit(int h, int qb, int j_lo, int j_hi, int part, float* dump, unsigned* dcnt, __attribute__((address_space(3))) int* flag, unsigned* rdy, float smx, float tskip, const Tensors& T, lds_ptr shm) {
    typedef __hip_bfloat16 bf16;
    int tid = threadIdx.x; asm volatile("" : "+v"(tid));
    const int lane = tid & 63, r32 = lane & 31, hi = lane >> 5; const int wid = __builtin_amdgcn_readfirstlane(tid >> 6);
    const int rb = wid & 3, mp = wid >> 2;
    const int q0 = qb * 128 + rb * 32;
    const int cw = q0 >> 6;
    const int NT = 2 * qb + 2;
    const bf16* Qw = T.proj + (size_t)q0 * PITCH + COL_Q + h * 128 + mp * 64;
    const bf16* Kh = T.proj + COL_K + h * 128; const bf16* Vh = T.proj + COL_V + h * 128;
    const unsigned lds0 = (unsigned)(uintptr_t)shm;
    __attribute__((address_space(3))) float* wsf = (__attribute__((address_space(3))) float*)(shm + L_WS + wid * 256);
    const unsigned dvoff = (unsigned)(((lane >> 4) * PITCH + ((lane & 15) ^ (((lane >> 4) << 2) | (wid & 3))) * 8) * 2);
    const bf16* kpc = Kh + (size_t)(wid * 4) * PITCH; const bf16* vpc = Vh + (size_t)(wid * 4) * PITCH;
    const unsigned kdst = lds0 + L_K + wid * 1024, vdst = lds0 + L_V + wid * 1024;
#define ATT_DMA(t, ks, vs) do { const size_t toff_ = (size_t)(t) * 64 * PITCH; const unsigned ko_ = (unsigned)(ks) * SLOT, vo_ = (unsigned)(vs) * SLOT; \
        glds16(kpc + toff_, dvoff, (unsigned)__builtin_amdgcn_readfirstlane(kdst + ko_)); glds16(kpc + toff_ + (size_t)32 * PITCH, dvoff, (unsigned)__builtin_amdgcn_readfirstlane(kdst + ko_ + 8192)); \
        glds16(vpc + toff_, dvoff, (unsigned)__builtin_amdgcn_readfirstlane(vdst + vo_)); glds16(vpc + toff_ + (size_t)32 * PITCH, dvoff, (unsigned)__builtin_amdgcn_readfirstlane(vdst + vo_ + 8192)); } while (0)
    ATT_DMA(NT - 1 - j_lo, 0, 0);
    ATT_DMA((j_hi - j_lo > 1) ? NT - 2 - j_lo : 0, 1, 1);
    bf16x8 qr[4];
#pragma unroll
    for (int d0 = 0; d0 < 4; ++d0) qr[d0] = *reinterpret_cast<const bf16x8*>(&Qw[(size_t)r32 * PITCH + d0 * 16 + hi * 8]);
    const float slope2 = exp2f(-(float)(h + 1)) * LOG2E;
    asm volatile("" : "+v"(qr[0]), "+v"(qr[1]), "+v"(qr[2]), "+v"(qr[3]));
    WaveState st; st.mhat = 0.f; st.l_reg = 0.f; st.resc = false;
#pragma unroll
    for (int d = 0; d < 4; ++d) st.o[d] = f32x16{};
    st.pw0 = st.pw1 = st.pw2 = st.pw3 = (u32x4){0u, 0u, 0u, 0u};
    int kof, vof[2];
    { const int xr = ((r32 & 3) << 2) | ((r32 >> 2) & 3);
      kof = 256 * r32 + 16 * ((8 * mp + hi) ^ xr);
      const int q_ = (lane & 15) >> 2, p_ = lane & 3, blk = (lane >> 4) & 1;
#pragma unroll
      for (int t_ = 0; t_ < 2; ++t_) { const int row = 8 * t_ + 4 * hi + q_; const int xv = ((row & 3) << 2) | ((row >> 2) & 3);
          vof[t_] = 256 * row + 16 * ((2 * blk + (p_ >> 1)) ^ xv) + 8 * (p_ & 1); } }
    const lds_cptr kb0 = (lds_cptr)shm + L_K; const lds_cptr vb0 = (lds_cptr)shm + L_V;
    const int qpos = q0 + r32;
    bool pend = false; int pend_vs = 0;
    __attribute__((address_space(3))) float* tmin = (__attribute__((address_space(3))) float*)(shm + L_WS + 2048);
#pragma unroll 1
    for (int j = j_lo; j < j_hi; ++j) {
        const int t = NT - 1 - j, sl = (j - j_lo) & 3;
        asm volatile("s_waitcnt vmcnt(4)" ::: "memory");
        __builtin_amdgcn_s_barrier(); asm volatile("" ::: "memory");
        const bool act = (t <= cw);
        if (part == 0 && j == 4 && j_hi > 8) {
            float tn = tmin[0];
#pragma unroll
            for (int w_ = 1; w_ < 8; ++w_) tn = fminf(tn, tmin[w_]);
            const int t_need = __builtin_amdgcn_readfirstlane((int)floorf(tn));
            int jh = NT - t_need; jh = jh < 8 ? 8 : jh; j_hi = jh < j_hi ? jh : j_hi;
        }
        const int ds_ = (j - j_lo + 2) & 3; const int td_ = (j + 2 < j_hi) ? t - 2 : 0; const size_t dto = (size_t)td_ * 64 * PITCH;
        att_step(st, pend, vb0 + pend_vs * SLOT, vof, qr, kb0 + sl * SLOT, kof, wsf, slope2, qpos, t, t == cw, part ? (j == j_lo) : (t == cw), r32, hi,
                 kpc + dto, vpc + dto, (unsigned)__builtin_amdgcn_readfirstlane(kdst + ds_ * SLOT), (unsigned)__builtin_amdgcn_readfirstlane(vdst + ds_ * SLOT), dvoff, act);
        if (act) { pend = true; pend_vs = sl; }
        if (part == 0 && j == 3) {
            float tn = ((float)(qpos - 63) - (smx - st.mhat + tskip) / slope2) * (1.0f / 64.0f);
#pragma unroll
            for (int o_ = 1; o_ < 64; o_ <<= 1) tn = fminf(tn, __shfl_xor(tn, o_));
            if (lane == 0) tmin[wid] = tn;
        }
        asm volatile("s_waitcnt lgkmcnt(0)" ::: "memory");
    }
#undef ATT_DMA
    if (VAR != 2) { if (pend) { if (st.resc) att_rescale(st, wsf, hi); att_pv(st, vb0 + pend_vs * SLOT, vof); } }
    if (dump != nullptr) {
        __syncthreads();
        if (tid == 0) flag[0] = (int)__hip_atomic_fetch_add(dcnt, 1u, __ATOMIC_RELAXED, __HIP_MEMORY_SCOPE_AGENT);
        __syncthreads();
        const int arrived = __builtin_amdgcn_readfirstlane(flag[0]);
        if (arrived == 0) {
            f32x4* dw = (f32x4*)(dump + (size_t)wid * (17 * 256)) + lane;
#pragma unroll
            for (int d = 0; d < 4; ++d)
#pragma unroll
                for (int q = 0; q < 4; ++q) __builtin_nontemporal_store((f32x4){st.o[d][4 * q], st.o[d][4 * q + 1], st.o[d][4 * q + 2], st.o[d][4 * q + 3]}, dw + (d * 4 + q) * 64);
            __builtin_nontemporal_store((f32x4){st.l_reg, st.mhat, 0.f, 0.f}, dw + 16 * 64);
            asm volatile("s_waitcnt vmcnt(0)" ::: "memory");
            __syncthreads();
            if (tid == 0) { __builtin_amdgcn_fence(__ATOMIC_RELEASE, "agent"); __hip_atomic_store(rdy, 1u, __ATOMIC_RELAXED, __HIP_MEMORY_SCOPE_AGENT); }
            __syncthreads(); return;
        }
        if (tid == 0) { unsigned sp_ = 0; while (__hip_atomic_load(rdy, __ATOMIC_RELAXED, __HIP_MEMORY_SCOPE_AGENT) == 0u && ++sp_ < (1u << 20)) __builtin_amdgcn_s_sleep(4); }
        __syncthreads();
        __builtin_amdgcn_fence(__ATOMIC_ACQUIRE, "agent");
        const f32x4* pw_ = (const f32x4*)(dump + (size_t)wid * (17 * 256)) + lane;
        const f32x4 plm = __builtin_nontemporal_load(pw_ + 16 * 64); const float pl = plm[0], pm = plm[1];
        const float m_ = fmaxf(st.mhat, pm), fa = exp2f(st.mhat - m_), fb = exp2f(pm - m_);
        st.l_reg = st.l_reg * fa + pl * fb;
        if (hi == 0) { wsf[r32] = fa; wsf[32 + r32] = fb; }
        asm volatile("s_waitcnt lgkmcnt(0)" ::: "memory");
        float fra[16], frb[16];
#pragma unroll
        for (int r = 0; r < 16; ++r) { fra[r] = wsf[crow(r, hi)]; frb[r] = wsf[32 + crow(r, hi)]; }
#pragma unroll
        for (int d = 0; d < 4; ++d)
#pragma unroll
            for (int q = 0; q < 4; ++q) { const f32x4 po = __builtin_nontemporal_load(pw_ + (d * 4 + q) * 64);
#pragma unroll
                for (int e = 0; e < 4; ++e) st.o[d][4 * q + e] = st.o[d][4 * q + e] * fra[4 * q + e] + po[e] * frb[4 * q + e]; }
        asm volatile("s_waitcnt lgkmcnt(0)" ::: "memory");
    }
    asm volatile("s_waitcnt vmcnt(0) lgkmcnt(0)" ::: "memory"); __builtin_amdgcn_s_barrier(); asm volatile("" ::: "memory");
    float l_reg = st.l_reg; f32x16 (&o)[4] = st.o;
    l_reg += xhalf(l_reg);
    if (hi == 0) wsf[32 + r32] = l_reg;
    asm volatile("s_waitcnt lgkmcnt(0)" ::: "memory");
    float rli[16];
#pragma unroll
    for (int r = 0; r < 16; ++r) rli[r] = 1.0f / wsf[32 + crow(r, hi)];
    __attribute__((address_space(3))) float* X = (__attribute__((address_space(3))) float*)(shm + L_X + rb * XSTRIDE);
    if (mp == 1) {
#pragma unroll
        for (int d = 0; d < 4; ++d)
#pragma unroll
            for (int r = 0; r < 16; ++r) X[(d * 16 + r) * 64 + lane] = o[d][r] * rli[r];
    }
    asm volatile("s_waitcnt lgkmcnt(0)" ::: "memory"); __builtin_amdgcn_s_barrier(); asm volatile("" ::: "memory");
    if (mp == 0) {
        const float lam = T.lam;
#pragma unroll
        for (int d = 0; d < 4; ++d)
#pragma unroll
            for (int r = 0; r < 16; ++r) o[d][r] = o[d][r] * rli[r] - lam * X[(d * 16 + r) * 64 + lane];
        asm volatile("s_waitcnt lgkmcnt(0)" ::: "memory");
#pragma unroll
        for (int d = 0; d < 4; ++d)
#pragma unroll
            for (int r = 0; r < 16; ++r) X[crow(r, hi) * 132 + d * 32 + r32] = o[d][r];
        asm volatile("s_waitcnt lgkmcnt(0)" ::: "memory");
        f32x4 v[16]; float ss = 0.f;
#pragma unroll
        for (int i = 0; i < 16; ++i) { v[i] = *(const __attribute__((address_space(3))) f32x4*)(X + r32 * 132 + hi * 64 + 4 * i); ss += (v[i].x * v[i].x + v[i].y * v[i].y) + (v[i].z * v[i].z + v[i].w * v[i].w); }
        ss += xhalf(ss);
        const float rstd = 0.8f / sqrtf(ss * (1.0f / 128.0f) + 1e-5f);
        const float* gs = T.g_subln + hi * 64;
        asm volatile("s_waitcnt lgkmcnt(0)" ::: "memory");
        __attribute__((address_space(3))) char* Xb = (__attribute__((address_space(3))) char*)X;
#pragma unroll
        for (int i = 0; i < 8; ++i) {
            const f32x4 g0 = *(const f32x4*)(gs + 8 * i), g1 = *(const f32x4*)(gs + 8 * i + 4); const f32x4 a = v[2 * i] * rstd * g0, b = v[2 * i + 1] * rstd * g1;
            u32x4 w; w.x = cvtpk_s(a.x, a.y); w.y = cvtpk_s(a.z, a.w); w.z = cvtpk_s(b.x, b.y); w.w = cvtpk_s(b.z, b.w);
            *(__attribute__((address_space(3))) u32x4*)(Xb + r32 * 272 + hi * 128 + 16 * i) = w;
        }
        asm volatile("s_waitcnt lgkmcnt(0)" ::: "memory");
        bf16* Ob = T.ycat + (size_t)q0 * 2048 + h * 128;
#pragma unroll
        for (int i = 0; i < 8; ++i) { const int row = 4 * i + (lane >> 4);
            const u32x4 w = *(const __attribute__((address_space(3))) u32x4*)(Xb + row * 272 + (lane & 15) * 16);
            *(u32x4*)(Ob + (size_t)row * 2048 + (lane & 15) * 8) = w; }
    }
    asm volatile("s_waitcnt lgkmcnt(0)" ::: "memory"); __builtin_amdgcn_s_barrier(); asm volatile("" ::: "memory");
}
}

constexpr int NWAVES = 8;
constexpr int SEQ = 16384, DM = 2048, NPROJ = 6144, NHEAD = 8, NEXP = 32, DEXP = 512, CAP = 16384;
constexpr float NORM_EPS = 1e-6f;
#ifndef MK_N_LAUNCHES
#define MK_N_LAUNCHES 1
#endif
constexpr int N_PHASES = 9;
constexpr int N_LAUNCHES = MK_N_LAUNCHES;

constexpr size_t MiB = 1u << 20;
constexpr size_t WS_CTL = 0, CTL_ZERO_BYTES = 160 * 1024;
constexpr size_t WS_WRT = 1 * MiB;
constexpr size_t WS_GATES = 2 * MiB;
constexpr size_t WS_LIST = 3 * MiB;
constexpr size_t WS_WIN = 6 * MiB;
constexpr size_t WS_WOUT = 30 * MiB;
constexpr size_t WS_W1 = 38 * MiB;
constexpr size_t WS_W2 = 166 * MiB;
constexpr size_t WS_B = 230 * MiB;
constexpr size_t WS_A = 294 * MiB;
constexpr size_t WS_END = 494 * MiB;
constexpr int CW_BAR = 4096;
constexpr int CW_NMAXP = 12288;
constexpr int CW_NMAX = 8448;
constexpr int CW_QUEUE = 8704;
constexpr int CW_SPLIT = 10240;
constexpr int CW_CNT = 8192;
constexpr int CW_MOD = 16384;

constexpr int RING_OFF = 0, RING_BYTES = 131072;
constexpr int LDSCTL_OFF = RING_BYTES;
constexpr int LDS_BYTES = 147456;
constexpr int LT_PRE = LDSCTL_OFF + 256, LT_CNT = LT_PRE + 34 * 4;

#define GAS __attribute__((address_space(1)))
#define LAS __attribute__((address_space(3)))
typedef unsigned short bf16;
typedef unsigned v4u __attribute__((ext_vector_type(4)));
typedef unsigned v2u __attribute__((ext_vector_type(2)));
typedef float f32x4 __attribute__((ext_vector_type(4)));
typedef GAS unsigned gu32;
#define RLX_AGENT __ATOMIC_RELAXED, __HIP_MEMORY_SCOPE_AGENT
#define LDS_WAIT() asm volatile("s_waitcnt lgkmcnt(0)" ::: "memory")
#define VM_WAIT() asm volatile("s_waitcnt vmcnt(0)" ::: "memory")
__device__ __forceinline__ unsigned f2bf(float f) { unsigned u = __builtin_bit_cast(unsigned, f); return (u + 0x7fffu + ((u >> 16) & 1u)) >> 16; }
__device__ __forceinline__ unsigned pk2(float lo, float hi) { return f2bf(lo) | (f2bf(hi) << 16); }
__device__ __forceinline__ float bf_lo(unsigned w) { return __builtin_bit_cast(float, w << 16); }
__device__ __forceinline__ float bf_hi(unsigned w) { return __builtin_bit_cast(float, w & 0xffff0000u); }

#define XB_TMO      128
#define XB_XCNT(j)  (256  + 64 * (j))
#define XB_XSUB(j)  (1280 + 64 * (j))
#define XB_XGEN(j)  (2304 + 64 * (j))
#define XB_TOP      3328
#define XB_TOPGEN   3392
#define XCD_BAR_WORDS 3456
#define XB_SPIN_CAP (1u << 18)

__device__ __forceinline__ unsigned xb_ld(unsigned* p)              { return __hip_atomic_load(p, __ATOMIC_RELAXED, __HIP_MEMORY_SCOPE_AGENT); }
__device__ __forceinline__ unsigned xb_add(unsigned* p, unsigned v) { return __hip_atomic_fetch_add(p, v, __ATOMIC_RELAXED, __HIP_MEMORY_SCOPE_AGENT); }
__device__ __forceinline__ unsigned xb_xcc_id() { return (unsigned)__builtin_amdgcn_s_getreg((3 << 11) | 20) & 0xFu; }
#define XB_SPIN(cond, bar) do { unsigned _sp = 0; while (cond) { __builtin_amdgcn_s_sleep(1); \
    if ((++_sp & 255u) == 0u) { if (xb_ld(&(bar)[XB_TMO])) break; if (_sp > XB_SPIN_CAP) { atomicAdd(&(bar)[XB_TMO], 1u); break; } } } } while (0)

struct XcdBarrier {
    unsigned* bar; unsigned x;
    volatile LAS unsigned* st;
};

__device__ __forceinline__ XcdBarrier xcd_barrier_post(unsigned* bar, volatile LAS unsigned* st) {
    XcdBarrier b; b.bar = bar; b.x = xb_xcc_id(); b.st = st;
    if (threadIdx.x == 0) (void)xb_add(&bar[XB_XCNT(b.x)], 1u);
    return b;
}
__device__ __forceinline__ void xcd_barrier_complete(unsigned* bar, unsigned x, unsigned& nloc, unsigned& nx, unsigned& xmask) {
    const unsigned G = gridDim.x * gridDim.y * gridDim.z;
    unsigned sum, cnt, mine, msk, sp = 0u;
    for (;;) {
        sum = 0u; cnt = 0u; mine = 0u; msk = 0u;
#pragma unroll
        for (unsigned j = 0; j < 16; ++j) { const unsigned c = xb_ld(&bar[XB_XCNT(j)]); sum += c; cnt += (c > 0u) ? 1u : 0u; msk |= (c > 0u) ? (1u << j) : 0u; mine = (j == x) ? c : mine; }
        if (sum == G) break;
        __builtin_amdgcn_s_sleep(1);
        if ((++sp & 255u) == 0u) { if (xb_ld(&bar[XB_TMO])) break; if (sp > XB_SPIN_CAP) { atomicAdd(&bar[XB_TMO], 1u); break; } }
    }
    nloc = mine > 0u ? mine : 1u; nx = cnt > 0u ? cnt : 1u; xmask = msk;
}

__device__ __forceinline__ void xcd_barrier(const XcdBarrier& b) {
    asm volatile("s_waitcnt vmcnt(0)" ::: "memory");
    __syncthreads();
    if (threadIdx.x == 0) {
        unsigned* bar = b.bar;
        __builtin_amdgcn_s_waitcnt(0);
        unsigned nloc = b.st[0], nx = b.st[1], xmask = b.st[2];
        if (nloc == 0u) { xcd_barrier_complete(bar, b.x, nloc, nx, xmask); b.st[0] = nloc; b.st[1] = nx; b.st[2] = xmask; }
        const unsigned old = xb_add(&bar[XB_XSUB(b.x)], 1u);
        const unsigned gen = old / nloc;
        if (old + 1u == (gen + 1u) * nloc) {
            __builtin_amdgcn_fence(__ATOMIC_RELEASE, "agent");
            asm volatile("s_waitcnt vmcnt(0)" ::: "memory");
            const unsigned og = xb_add(&bar[XB_TOP], 1u);
            const unsigned tg = og / nx;
            if (og + 1u == (tg + 1u) * nx) {
#pragma unroll
                for (unsigned j = 0; j < 16; ++j) if (xmask & (1u << j)) (void)xb_add(&bar[XB_XGEN(j)], 1u);
            }
        }
        XB_SPIN(xb_ld(&bar[XB_XGEN(b.x)]) == gen, bar);
        __builtin_amdgcn_fence(__ATOMIC_ACQUIRE, "agent");
        asm volatile("s_waitcnt vmcnt(0)" ::: "memory");
    }
    __syncthreads();
}

struct Frame {
    LAS unsigned char* lds;
    gu32* ctl;
    int tid, lane, wave;
    int vcu, G;
    const float* in[23]; float* out; unsigned char* ws;
};
enum { I_X = 0, I_C, I_WADA, I_BADA, I_GPRE1, I_WIN, I_LQ1, I_LK1, I_LQ2, I_LK2, I_GSUB, I_WCONV, I_WOUT, I_GPOST1, I_GPRE2, I_WRG, I_BRG, I_WRE, I_BRE, I_WGATE, I_WUP, I_WDOWN, I_GPOST2 };

__device__ __forceinline__ int opaque_i(int v) { asm volatile("" : "+v"(v)); return v; }
__device__ __forceinline__ float wave_sum(float v) {
#pragma unroll
    for (int o = 1; o < 64; o <<= 1) v += __shfl_xor(v, o);
    return v;
}
__device__ __forceinline__ float modval(const Frame& F, int n) {
    const long long a = ((const long long*)(F.ctl + CW_MOD))[n];
    return F.in[I_BADA][n] + (float)a * 9.094947017729282e-13f;
}

template <bool NT_ST>
__device__ __forceinline__ void p0_transpose_item(const float* W, int K, int N, bf16* WT, int k0, int n0, int dst_row0, LAS float* scr, int lane) {
    unsigned vld = (unsigned)(((lane >> 5) * N + (lane & 31)) * 4), vst = (unsigned)((((lane >> 3) * K) + 8 * (lane & 7)) * 2);
    asm volatile("" : "+v"(vld), "+v"(vst));
    const GAS char* Wb = (const GAS char*)(W + (size_t)k0 * N + n0);
    float t_[32];
#pragma unroll
    for (int i = 0; i < 32; ++i) t_[i] = __builtin_nontemporal_load((const GAS float*)(Wb + (size_t)(2 * i) * N * 4 + vld));
#pragma unroll
    for (int i = 0; i < 32; ++i) { const int kk = 2 * i + (lane >> 5); scr[kk * 33 + (lane & 31)] = t_[i]; }
    LDS_WAIT(); asm volatile("" ::: "memory");
    const int c = lane & 7;
    GAS char* Tb = (GAS char*)(WT + (size_t)dst_row0 * K + k0);
#pragma unroll
    for (int j = 0; j < 4; ++j) { const int n = (lane >> 3) + 8 * j; const LAS float* s = scr + (8 * c) * 33 + n;
        v4u o; o.x = pk2(s[0 * 33], s[1 * 33]); o.y = pk2(s[2 * 33], s[3 * 33]); o.z = pk2(s[4 * 33], s[5 * 33]); o.w = pk2(s[6 * 33], s[7 * 33]);
        if (NT_ST) __builtin_nontemporal_store(o, (GAS v4u*)(Tb + (size_t)(8 * j) * K * 2 + vst)); else *(GAS v4u*)(Tb + (size_t)(8 * j) * K * 2 + vst) = o; }
    LDS_WAIT(); asm volatile("" ::: "memory");
}
constexpr int CVT_I_IN = 32 * 192, CVT_I_OUT = 32 * 64, CVT_I_G = 32 * 32 * 16, CVT_I_D = 32 * 8 * 64, CVT_NITEMS = CVT_I_IN + CVT_I_OUT + 2 * CVT_I_G + CVT_I_D;
constexpr int CVT_CHUNK = 64, CVT_NCHUNK = (CVT_NITEMS - CVT_I_IN + CVT_CHUNK - 1) / CVT_CHUNK;
__device__ __forceinline__ void cvt_item(Frame& F, int it, LAS float* scr, int lane) {
    int r = it;
    if (r < CVT_I_IN) { const int kb = r / 192, nb = r % 192; p0_transpose_item<false>(F.in[I_WIN], 2048, 6144, (bf16*)(F.ws + WS_WIN), 64 * kb, 32 * nb, 32 * nb, scr, lane); return; } r -= CVT_I_IN;
    if (r < CVT_I_OUT) { const int kb = r / 64, nb = r % 64; p0_transpose_item<false>(F.in[I_WOUT], 2048, 2048, (bf16*)(F.ws + WS_WOUT), 64 * kb, 32 * nb, 32 * nb, scr, lane); return; } r -= CVT_I_OUT;
    if (r < 2 * CVT_I_G) { const int up = r / CVT_I_G; r -= up * CVT_I_G; const int e = r / 512, q = r % 512, kb = q / 16, nb = q % 16, n0 = 32 * nb;
        p0_transpose_item<true>(F.in[up ? I_WUP : I_WGATE] + (size_t)e * 2048 * 512, 2048, 512, (bf16*)(F.ws + WS_W1), 64 * kb, n0, e * 1024 + (n0 >> 7) * 256 + up * 128 + (n0 & 127), scr, lane); return; } r -= 2 * CVT_I_G;
    { const int e = r / 512, q = r % 512, kb = q / 64, nb = q % 64;
        p0_transpose_item<true>(F.in[I_WDOWN] + (size_t)e * 512 * 2048, 512, 2048, (bf16*)(F.ws + WS_W2), 64 * kb, 32 * nb, e * 2048 + 32 * nb, scr, lane); }
}
__device__ __forceinline__ void cvt_chunk(Frame& F, int c) {
    const int ln = F.lane;
    LAS float* scr = (LAS float*)(F.lds + RING_OFF + F.wave * 16384);
    const int base = CVT_I_IN + c * CVT_CHUNK + F.wave * 8;
#pragma unroll 1
    for (int i = 0; i < 8; ++i) { const int it = base + i; if (it < CVT_NITEMS) cvt_item(F, it, scr, ln); }
}
__device__ __forceinline__ void p0_prologue(Frame& F) {
    const int gw = F.vcu * NWAVES + F.wave, NGW = F.G * NWAVES;
    {
        const float* c = F.in[I_C]; const float* W = F.in[I_WADA];
        unsigned long long* acc = (unsigned long long*)(F.ctl + CW_MOD);
        for (int it = gw; it < 48 * 32; it += NGW) {
            const int cg = it % 48, ks = it / 48, k0 = ks * 64, col = cg * 256 + F.lane * 4;
            f32x4 a = {0.f, 0.f, 0.f, 0.f};
#pragma unroll 16
            for (int kk = 0; kk < 64; ++kk) { const float cv = c[k0 + kk]; const float s = cv / (1.0f + __expf(-cv)); const f32x4 w = __builtin_nontemporal_load((const f32x4*)(W + (size_t)(k0 + kk) * 12288 + col)); a += w * s; }
#pragma unroll
            for (int i = 0; i < 4; ++i) { const long long q = __float2ll_rn(a[i] * 1099511627776.0f); atomicAdd(acc + col + i, (unsigned long long)q); }
        }
    }
    {
        bf16* WF = (bf16*)(F.ws + WS_WRT);
        for (int idx = blockIdx.x * 512 + F.tid; idx < 48 * 2048; idx += F.G * 512) {
            const int e = idx & 7, ln = (idx >> 3) & 63, f = idx >> 9; const int blk = f % 3, ks = (f / 3) & 3, wv = (f / 12) & 7, hf = f / 96;
            const int j = 16 * blk + (ln & 15), k = 1024 * hf + 128 * wv + 32 * ks + 8 * (ln >> 4) + e;
            const float w = (j < 32) ? F.in[I_WRE][k * 32 + j] : (j < 36) ? F.in[I_WRG][k * 4 + (j - 32)] : 0.f;
            const unsigned h = f2bf(w); const float r = w - __builtin_bit_cast(float, h << 16);
            WF[(size_t)f * 1024 + ln * 8 + e] = (bf16)h; WF[(size_t)f * 1024 + 512 + ln * 8 + e] = (bf16)f2bf(r); }
    }
    LAS float* scr = (LAS float*)(F.lds + RING_OFF + F.wave * 16384);
    for (int it = gw; it < CVT_I_IN; it += NGW) cvt_item(F, it, scr, F.lane);
#if defined(PROBE_PHASE) && PROBE_PHASE == 0
    for (int it = gw; it < CVT_NITEMS; it += NGW) cvt_item(F, it, scr, F.lane);
#endif
}

__device__ __forceinline__ void p1_norm(Frame& F) {
    const int lane_ = opaque_i(F.lane), tid_ = opaque_i(F.tid);
    LAS float* tA = (LAS float*)(F.lds + RING_OFF); LAS float* tB = tA + 2048;
    for (int i = tid_; i < 2048; i += 512) { tA[i] = F.in[I_GPRE1][i] * (1.0f + modval(F, 2048 + i)); tB[i] = modval(F, i); }
    __syncthreads();
    const int gw = F.vcu * NWAVES + F.wave, NGW = F.G * NWAVES;
    bf16* H1 = (bf16*)(F.ws + WS_B);
    for (int m = gw; m < SEQ; m += NGW) {
        const GAS f32x4* xr = (const GAS f32x4*)(F.in[I_X] + (size_t)m * DM) + lane_;
        f32x4 v[8]; float s = 0.f;
#pragma unroll
        for (int j = 0; j < 8; ++j) { v[j] = __builtin_nontemporal_load(xr + 64 * j); s += (v[j].x * v[j].x + v[j].y * v[j].y) + (v[j].z * v[j].z + v[j].w * v[j].w); }
        const float rstd = 1.0f / sqrtf(wave_sum(s) * (1.0f / DM) + NORM_EPS);
        GAS v2u* o8 = (GAS v2u*)(H1 + (size_t)m * DM) + lane_;
#pragma unroll
        for (int j = 0; j < 8; ++j) { const f32x4 a = *(const LAS f32x4*)(tA + 256 * j + 4 * lane_), b = *(const LAS f32x4*)(tB + 256 * j + 4 * lane_); const f32x4 h = v[j] * rstd * a + b;
            v2u w; w.x = pk2(h.x, h.y); w.y = pk2(h.z, h.w); o8[64 * j] = w; }
    }
    __syncthreads();
}

__device__ __noinline__ void p3_conv_item(const bf16* P, bf16* Y, const float* wc, int it, int lane) {
    {
        const int t0 = (it >> 1) * 16, ch = (it & 1) * 512 + lane * 8;
        float w0[8], w1[8], w2[8], z1[8], z2[8];
#pragma unroll
        for (int i = 0; i < 8; ++i) { w0[i] = wc[ch + i]; w1[i] = wc[1024 + ch + i]; w2[i] = wc[2048 + ch + i]; z1[i] = 0.f; z2[i] = 0.f; }
        for (int t = t0 - 2; t < t0 + 16; ++t) {
            if (t < 0) continue;
            const bf16* row = P + (size_t)t * att::PITCH;
            const v4u cg = __builtin_nontemporal_load((const GAS v4u*)(row + 4096 + ch)), xu = __builtin_nontemporal_load((const GAS v4u*)(row + 5120 + ch));
            float z[8];
#pragma unroll
            for (int i = 0; i < 4; ++i) { z[2 * i] = bf_lo(cg[i]) * bf_lo(xu[i]); z[2 * i + 1] = bf_hi(cg[i]) * bf_hi(xu[i]); }
            if (t >= t0) {
                const v4u bg = __builtin_nontemporal_load((const GAS v4u*)(row + 3072 + ch)); float y[8];
#pragma unroll
                for (int i = 0; i < 4; ++i) { y[2 * i] = bf_lo(bg[i]) * (w0[2 * i] * z2[2 * i] + w1[2 * i] * z1[2 * i] + w2[2 * i] * z[2 * i]);
                    y[2 * i + 1] = bf_hi(bg[i]) * (w0[2 * i + 1] * z2[2 * i + 1] + w1[2 * i + 1] * z1[2 * i + 1] + w2[2 * i + 1] * z[2 * i + 1]); }
                v4u o; o.x = pk2(y[0], y[1]); o.y = pk2(y[2], y[3]); o.z = pk2(y[4], y[5]); o.w = pk2(y[6], y[7]);
                *(GAS v4u*)(Y + (size_t)t * DM + 1024 + ch) = o;
            }
#pragma unroll
            for (int i = 0; i < 8; ++i) { z2[i] = z1[i]; z1[i] = z[i]; }
        }
    }
}
constexpr int CVT_NCHUNK_D = CVT_I_D / CVT_CHUNK, CVT_NCHUNK_P3 = CVT_NCHUNK - CVT_NCHUNK_D;
constexpr int SIDE_NCHUNK = CVT_NCHUNK_P3 + 2048 / NWAVES;
__device__ __forceinline__ void side_chunk(Frame& F, int c) {
    if (c < CVT_NCHUNK_P3) cvt_chunk(F, c); else p3_conv_item((const bf16*)(F.ws + WS_A), (bf16*)(F.ws + WS_B), F.in[I_WCONV], (c - CVT_NCHUNK_P3) * NWAVES + F.wave, F.lane);
}

__device__ __forceinline__ void p5_post_route(Frame& F) {
    const int lane_ = opaque_i(F.lane), tid_ = opaque_i(F.tid);
    LAS float* tG = (LAS float*)(F.lds + RING_OFF); LAS float* tA = tG + 2048; LAS float* tS = tA + 2048;
    for (int i = tid_; i < 2048; i += 512) { tG[i] = modval(F, 4096 + i) * F.in[I_GPOST1][i]; tA[i] = F.in[I_GPRE2][i] * (1.0f + modval(F, 8192 + i)); tS[i] = modval(F, 6144 + i); }
    __syncthreads();
    const bf16* Y1 = (const bf16*)(F.ws + WS_A); bf16* H2 = (bf16*)(F.ws + WS_B);
    float* gates = (float*)(F.ws + WS_GATES); int* slotix = (int*)(F.ws + WS_GATES + 256 * 1024); int* list = (int*)(F.ws + WS_LIST); unsigned* cnt = (unsigned*)(F.ctl + CW_CNT);
    LAS float* Lx = (LAS float*)(F.lds + RING_OFF + 40960);
    LAS float* Hh = (LAS float*)(F.lds + RING_OFF + 49152);
    constexpr int HS = 1028;
    for (int st = F.vcu; st < SEQ / 16; st += F.G) {
        f32x4 hv[2][8];
#pragma unroll
        for (int r = 0; r < 2; ++r) {
            const int m = 16 * st + 2 * F.wave + r;
            const GAS f32x4* xr = (const GAS f32x4*)(F.in[I_X] + (size_t)m * DM) + lane_;
            const GAS v2u* yr = (const GAS v2u*)(Y1 + (size_t)m * DM) + lane_;
            f32x4 xv[8]; v2u yp[8]; float s1 = 0.f;
#pragma unroll
            for (int j = 0; j < 8; ++j) { xv[j] = __builtin_nontemporal_load(xr + 64 * j); yp[j] = __builtin_nontemporal_load(yr + 64 * j); const f32x4 y = (f32x4){bf_lo(yp[j].x), bf_hi(yp[j].x), bf_lo(yp[j].y), bf_hi(yp[j].y)};
                s1 += (y.x * y.x + y.y * y.y) + (y.z * y.z + y.w * y.w); }
            const float r1 = 1.0f / sqrtf(wave_sum(s1) * (1.0f / DM) + NORM_EPS);
            GAS v2u* orow = (GAS v2u*)((bf16*)(F.ws + WS_END) + (size_t)m * DM) + lane_; float s2 = 0.f;
#pragma unroll
            for (int j = 0; j < 8; ++j) { const f32x4 g = *(const LAS f32x4*)(tG + 256 * j + 4 * lane_); const f32x4 y = (f32x4){bf_lo(yp[j].x), bf_hi(yp[j].x), bf_lo(yp[j].y), bf_hi(yp[j].y)};
                xv[j] = xv[j] + y * r1 * g; { v2u w_; w_.x = pk2(xv[j].x, xv[j].y); w_.y = pk2(xv[j].z, xv[j].w); __builtin_nontemporal_store(w_, orow + 64 * j); }
                s2 += (xv[j].x * xv[j].x + xv[j].y * xv[j].y) + (xv[j].z * xv[j].z + xv[j].w * xv[j].w); }
            const float r2 = 1.0f / sqrtf(wave_sum(s2) * (1.0f / DM) + NORM_EPS);
            GAS v2u* h8 = (GAS v2u*)(H2 + (size_t)m * DM) + lane_;
#pragma unroll
            for (int j = 0; j < 8; ++j) { const f32x4 a = *(const LAS f32x4*)(tA + 256 * j + 4 * lane_), s = *(const LAS f32x4*)(tS + 256 * j + 4 * lane_); const f32x4 h = xv[j] * r2 * a + s; hv[r][j] = h;
                v2u w; w.x = pk2(h.x, h.y); w.y = pk2(h.z, h.w); h8[64 * j] = w; }
        }
        f32x4 acc0 = {0.f, 0.f, 0.f, 0.f}, acc1 = {0.f, 0.f, 0.f, 0.f}, acc2 = {0.f, 0.f, 0.f, 0.f};
        const int lr = opaque_i(lane_); const int kq = lr >> 4, ir = lr & 15;
        const GAS char* WHg = (const GAS char*)(F.ws + WS_WRT);
#pragma unroll
        for (int hf = 0; hf < 2; ++hf) {
            pg8::bf16x8 wh[4][3], wl[4][3];
            { const GAS char* wf = WHg + (size_t)((hf * 8 + F.wave) * 12) * 2048 + (unsigned)(lr * 16);
#pragma unroll
              for (int ks = 0; ks < 4; ++ks)
#pragma unroll
                  for (int b_ = 0; b_ < 3; ++b_) { wh[ks][b_] = *(const GAS pg8::bf16x8*)(wf + (ks * 3 + b_) * 2048); wl[ks][b_] = *(const GAS pg8::bf16x8*)(wf + (ks * 3 + b_) * 2048 + 1024); } }
#pragma unroll
            for (int r = 0; r < 2; ++r)
#pragma unroll
                for (int jj = 0; jj < 4; ++jj) *(LAS f32x4*)(Hh + (2 * F.wave + r) * HS + 256 * jj + 4 * lane_) = hv[r][4 * hf + jj];
            LDS_WAIT(); __syncthreads();
            const LAS float* bp = Hh + ir * HS + 128 * F.wave + 8 * kq;
#pragma unroll
            for (int ks = 0; ks < 4; ++ks) {
                const f32x4 b0 = *(const LAS f32x4*)(bp + 32 * ks), b1 = *(const LAS f32x4*)(bp + 32 * ks + 4);
                v4u hh, hl;
                hh.x = pg8::cvt_pk_bf16(b0.x, b0.y); hh.y = pg8::cvt_pk_bf16(b0.z, b0.w); hh.z = pg8::cvt_pk_bf16(b1.x, b1.y); hh.w = pg8::cvt_pk_bf16(b1.z, b1.w);
                hl.x = pg8::cvt_pk_bf16(b0.x - bf_lo(hh.x), b0.y - bf_hi(hh.x)); hl.y = pg8::cvt_pk_bf16(b0.z - bf_lo(hh.y), b0.w - bf_hi(hh.y));
                hl.z = pg8::cvt_pk_bf16(b1.x - bf_lo(hh.z), b1.y - bf_hi(hh.z)); hl.w = pg8::cvt_pk_bf16(b1.z - bf_lo(hh.w), b1.w - bf_hi(hh.w));
                const pg8::bf16x8 bh = __builtin_bit_cast(pg8::bf16x8, hh), bl = __builtin_bit_cast(pg8::bf16x8, hl);
                acc0 = __builtin_amdgcn_mfma_f32_16x16x32_bf16(wh[ks][0], bh, acc0, 0, 0, 0); acc1 = __builtin_amdgcn_mfma_f32_16x16x32_bf16(wh[ks][1], bh, acc1, 0, 0, 0); acc2 = __builtin_amdgcn_mfma_f32_16x16x32_bf16(wh[ks][2], bh, acc2, 0, 0, 0);
                acc0 = __builtin_amdgcn_mfma_f32_16x16x32_bf16(wl[ks][0], bh, acc0, 0, 0, 0); acc1 = __builtin_amdgcn_mfma_f32_16x16x32_bf16(wl[ks][1], bh, acc1, 0, 0, 0); acc2 = __builtin_amdgcn_mfma_f32_16x16x32_bf16(wl[ks][2], bh, acc2, 0, 0, 0);
                acc0 = __builtin_amdgcn_mfma_f32_16x16x32_bf16(wh[ks][0], bl, acc0, 0, 0, 0); acc1 = __builtin_amdgcn_mfma_f32_16x16x32_bf16(wh[ks][1], bl, acc1, 0, 0, 0); acc2 = __builtin_amdgcn_mfma_f32_16x16x32_bf16(wh[ks][2], bl, acc2, 0, 0, 0);
            }
            LDS_WAIT(); __syncthreads();
        }
#pragma unroll
        for (int g = 0; g < 4; ++g) { Hh[(F.wave * 12 + g) * 64 + lane_] = acc0[g]; Hh[(F.wave * 12 + 4 + g) * 64 + lane_] = acc1[g]; Hh[(F.wave * 12 + 8 + g) * 64 + lane_] = acc2[g]; }
        LDS_WAIT(); __syncthreads();
        { const int g = tid_ >> 6, ln = tid_ & 63; float s = 0.f;
#pragma unroll
          for (int w = 0; w < 8; ++w) s += Hh[(w * 12 + g) * 64 + ln];
          Lx[(ln & 15) * 37 + 16 * (g >> 2) + 4 * (ln >> 4) + (g & 3)] = s;
          if (tid_ < 64) { const int g2 = tid_ >> 4, l2 = tid_ & 15; float s2 = 0.f;
#pragma unroll
              for (int w = 0; w < 8; ++w) s2 += Hh[(w * 12 + 8 + g2) * 64 + l2];
              Lx[l2 * 37 + 32 + g2] = s2; } }
        LDS_WAIT(); __syncthreads();
        if (tid_ < 16) {
            const int row = tid_, m = 16 * st + row;
            float gl[4]; int gi = 0; float gm;
#pragma unroll
            for (int g = 0; g < 4; ++g) gl[g] = Lx[row * 37 + 32 + g] + F.in[I_BRG][g];
            gm = gl[0];
#pragma unroll
            for (int g = 1; g < 4; ++g) if (gl[g] > gm) { gm = gl[g]; gi = g; }
            float gs = 0.f;
#pragma unroll
            for (int g = 0; g < 4; ++g) gs += __expf(gl[g] - gm);
            const float gwt = 1.0f / gs;
            float el[8];
#pragma unroll
            for (int e = 0; e < 8; ++e) el[e] = Lx[row * 37 + gi * 8 + e] + F.in[I_BRE][gi * 8 + e];
            int i1 = 0; float l1 = el[0];
#pragma unroll
            for (int e = 1; e < 8; ++e) if (el[e] > l1) { l1 = el[e]; i1 = e; }
            int i2 = -1; float l2 = -INFINITY;
#pragma unroll
            for (int e = 0; e < 8; ++e) if (e != i1 && el[e] > l2) { l2 = el[e]; i2 = e; }
            const float w1 = 1.0f / (1.0f + __expf(l2 - l1)), w2 = 1.0f - w1;
            const int e1 = gi * 8 + i1, e2 = gi * 8 + i2;
            const unsigned p1 = atomicAdd(cnt + e1, 1u), p2 = atomicAdd(cnt + e2, 1u);
            list[e1 * CAP + (int)p1] = 2 * m; list[e2 * CAP + (int)p2] = 2 * m + 1;
            slotix[2 * m] = e1 * CAP + (int)p1; slotix[2 * m + 1] = e2 * CAP + (int)p2;
            gates[2 * m] = gwt * w1; gates[2 * m + 1] = gwt * w2;
        }
    }
}

__device__ __forceinline__ void p8_final(Frame& F) {
    const int lane_ = opaque_i(F.lane), tid_ = opaque_i(F.tid);
    LAS float* tG = (LAS float*)(F.lds + RING_OFF);
    for (int i = tid_; i < 2048; i += 512) tG[i] = modval(F, 10240 + i) * F.in[I_GPOST2][i];
    __syncthreads();
    const int gw = F.vcu * NWAVES + F.wave, NGW = F.G * NWAVES;
    const bf16* Y2 = (const bf16*)(F.ws + WS_A);
    const float* gates = (const float*)(F.ws + WS_GATES); const int* slotix = (const int*)(F.ws + WS_GATES + 256 * 1024);
    const LAS int* pre = (const LAS int*)(F.lds + LT_PRE);
    for (int m = gw; m < SEQ; m += NGW) {
        const GAS v2u* xr = (const GAS v2u*)((const bf16*)(F.ws + WS_END) + (size_t)m * DM) + lane_; GAS f32x4* orow = (GAS f32x4*)(F.out + (size_t)m * DM) + lane_;
        const int i0 = slotix[2 * m], i1 = slotix[2 * m + 1]; const float g0 = gates[2 * m], g1 = gates[2 * m + 1];
        const int r0 = pre[i0 >> 14] * 256 + (i0 & (CAP - 1)), r1 = pre[i1 >> 14] * 256 + (i1 & (CAP - 1));
        const GAS v2u* ya = (const GAS v2u*)(Y2 + (size_t)r0 * DM) + lane_; const GAS v2u* yb = (const GAS v2u*)(Y2 + (size_t)r1 * DM) + lane_;
        f32x4 xv[8], yv[8]; float s = 0.f;
#pragma unroll
        for (int j = 0; j < 8; ++j) { { const v2u xb_ = __builtin_nontemporal_load(xr + 64 * j); xv[j] = (f32x4){bf_lo(xb_.x), bf_hi(xb_.x), bf_lo(xb_.y), bf_hi(xb_.y)}; } const v2u a = __builtin_nontemporal_load(ya + 64 * j), b = __builtin_nontemporal_load(yb + 64 * j);
            yv[j] = (f32x4){g0 * bf_lo(a.x) + g1 * bf_lo(b.x), g0 * bf_hi(a.x) + g1 * bf_hi(b.x), g0 * bf_lo(a.y) + g1 * bf_lo(b.y), g0 * bf_hi(a.y) + g1 * bf_hi(b.y)};
            s += (yv[j].x * yv[j].x + yv[j].y * yv[j].y) + (yv[j].z * yv[j].z + yv[j].w * yv[j].w); }
        const float rstd = 1.0f / sqrtf(wave_sum(s) * (1.0f / DM) + NORM_EPS);
#pragma unroll
        for (int j = 0; j < 8; ++j) { const f32x4 g = *(const LAS f32x4*)(tG + 256 * j + 4 * lane_); __builtin_nontemporal_store(xv[j] + yv[j] * rstd * g, orow + 64 * j); }
    }
}

template <int NPN, bool TOKEN_ROWS>
struct MoeOrder {
    static constexpr bool GATHER = true; static constexpr bool SPLIT = true;
    const LAS int* pre; const LAS int* cntl; const int* list; int G, c;
    __device__ __forceinline__ bool next(int i, pg8::Unit& u) const {
        const int U = __builtin_amdgcn_readfirstlane(pre[32]) * NPN, R = U / G, Lo = U - R * G;
        int L = i * G + c; u.half = -1;
        if (i >= R) { if (i > R) return false;
            if (2 * Lo <= G) { if (c >= 2 * Lo) return false; L = R * G + (c >> 1); u.half = c & 1; } else if (c >= Lo) return false; }
        const int rt = L / NPN, pnl = L % NPN;
        const int ln_ = (int)(threadIdx.x & 31u);
        const unsigned long long bal = __ballot(pre[ln_] <= rt);
        const int e = __builtin_amdgcn_readfirstlane(31 - __builtin_clz((unsigned)(bal & 0xffffffffull)));
        u.pm = rt; u.e = e; u.row0 = __builtin_amdgcn_readfirstlane((rt - pre[e]) * 256); const int left = __builtin_amdgcn_readfirstlane(cntl[e]) - u.row0; u.nvalid = left < 256 ? left : 256; u.pn = e * NPN + pnl;
        return true;
    }
    __device__ __forceinline__ void rows(const pg8::Unit& u, const int (&RA)[2], const int (&CA)[2], int K, unsigned (&v)[2][2]) const {
#pragma unroll
        for (int h = 0; h < 2; ++h)
#pragma unroll
            for (int i = 0; i < 2; ++i) { const int r = (u.half < 0 ? h : u.half) * 128 + RA[i];
                if (TOKEN_ROWS) { const int ts = list[u.e * CAP + u.row0 + (r < u.nvalid ? r : 0)]; v[h][i] = (unsigned)(((ts >> 1) * K + CA[i]) * 2); }
                else v[h][i] = (unsigned)(((u.pm * 256 + r) * K + CA[i]) * 2); }
    }
};
struct EpiSwiglu {
    static constexpr bool PERM = true;
    bf16* act;
    __device__ __forceinline__ void operator()(const pg8::f32x4 (&acc)[2][2][4][2], const pg8::Unit& u, int wr, int wc, int fr, int fq) const {
        const int pnl = u.pn & 3; const int col0 = pnl * 128 + wc * 32 + 8 * fq;
#pragma unroll
        for (int ai = 0; ai < 2; ++ai) { if (ai == 1 && u.half >= 0) break;
#pragma unroll
            for (int m = 0; m < 4; ++m) { const int r = (u.half < 0 ? ai : u.half) * 128 + wr * 64 + m * 16 + fr;
                float o[8];
#pragma unroll
                for (int n = 0; n < 2; ++n)
#pragma unroll
                    for (int i = 0; i < 4; ++i) { const float g = acc[ai][0][m][n][i], up = acc[ai][1][m][n][i]; o[4 * n + i] = g * __builtin_amdgcn_rcpf(1.0f + __expf(-g)) * up; }
                pg8::u32x4 w; w.x = pg8::cvt_pk_bf16(o[0], o[1]); w.y = pg8::cvt_pk_bf16(o[2], o[3]); w.z = pg8::cvt_pk_bf16(o[4], o[5]); w.w = pg8::cvt_pk_bf16(o[6], o[7]);
                *(pg8::u32x4*)(act + (size_t)(u.pm * 256 + r) * DEXP + col0) = w; } }
    }
};
struct EpiDown {
    static constexpr bool PERM = true;
    bf16* y2;
    __device__ __forceinline__ void operator()(const pg8::f32x4 (&acc)[2][2][4][2], const pg8::Unit& u, int wr, int wc, int fr, int fq) const {
        const int pnl = u.pn & 7; const int col0 = pnl * 256 + wc * 32 + 8 * fq;
#pragma unroll
        for (int ai = 0; ai < 2; ++ai) { if (ai == 1 && u.half >= 0) break;
#pragma unroll
            for (int m = 0; m < 4; ++m) { const int r = (u.half < 0 ? ai : u.half) * 128 + wr * 64 + m * 16 + fr; bf16* rowp = y2 + (size_t)(u.pm * 256 + r) * DM + col0;
#pragma unroll
                for (int bj = 0; bj < 2; ++bj) { const pg8::f32x4 v0 = acc[ai][bj][m][0], v1 = acc[ai][bj][m][1];
                    pg8::u32x4 w; w.x = pg8::cvt_pk_bf16(v0[0], v0[1]); w.y = pg8::cvt_pk_bf16(v0[2], v0[3]); w.z = pg8::cvt_pk_bf16(v1[0], v1[1]); w.w = pg8::cvt_pk_bf16(v1[2], v1[3]);
                    *(pg8::u32x4*)(rowp + bj * 128) = w; } } }
    }
};
struct EpiNull { static constexpr bool PERM = true; float* sink; __device__ __forceinline__ void operator()(const pg8::f32x4 (&acc)[2][2][4][2], const pg8::Unit& u, int wr, int wc, int fr, int fq) const {
              float s = 0.f; _Pragma("unroll") for (int a = 0; a < 2; ++a) _Pragma("unroll") for (int b = 0; b < 2; ++b) _Pragma("unroll") for (int m = 0; m < 4; ++m) _Pragma("unroll") for (int n = 0; n < 2; ++n) s += acc[a][b][m][n][0] + acc[a][b][m][n][1] + acc[a][b][m][n][2] + acc[a][b][m][n][3];
              if (s == 123.456f) sink[0] = s; } };
__device__ __forceinline__ void moe_tables(Frame& F) {
    LAS int* pre = (LAS int*)(F.lds + LT_PRE); LAS int* cl = (LAS int*)(F.lds + LT_CNT);
    if (F.tid == 0) { int s = 0; const unsigned* cnt = (const unsigned*)(F.ctl + CW_CNT);
        for (int e = 0; e < 32; ++e) { int c = (int)cnt[e]; c = c < 0 ? 0 : (c > CAP ? CAP : c); cl[e] = c; pre[e] = s; s += (c + 255) >> 8; } pre[32] = s; }
    __syncthreads();
}

struct Args { const float* in[23]; float* out; unsigned char* ws; int ph_lo, ph_hi; };
__global__ void __launch_bounds__(NWAVES * 64, 2) mk_fwd(Args args) {
    extern __shared__ __attribute__((aligned(16))) unsigned char lds[];
    Frame F;
    F.lds = (LAS unsigned char*)lds;
    F.tid = threadIdx.x; F.lane = F.tid & 63; F.wave = __builtin_amdgcn_readfirstlane(F.tid >> 6);
    F.G = gridDim.x; { const int bx = blockIdx.x; F.vcu = (F.G % 8 == 0) ? (bx % 8) * (F.G / 8) + bx / 8 : bx; }
    F.ws = args.ws; F.ctl = (gu32*)(args.ws + WS_CTL); F.out = args.out;
#pragma unroll
    for (int i = 0; i < 23; ++i) F.in[i] = args.in[i];
    for (int u = F.tid; u < (LDS_BYTES - LDSCTL_OFF) / 4; u += NWAVES * 64) ((LAS unsigned*)(F.lds + LDSCTL_OFF))[u] = 0u;
    __syncthreads();
    XcdBarrier bar; bar.bar = (unsigned*)(F.ctl + CW_BAR); bar.x = 0; bar.st = nullptr;
    if (N_LAUNCHES == 1) bar = xcd_barrier_post((unsigned*)(F.ctl + CW_BAR), (volatile LAS unsigned*)(F.lds + LDSCTL_OFF));
    const int lo = args.ph_lo, hi = args.ph_hi;
#define IN(k) (lo <= (k) && (k) < hi)
#define SEAM(k) do { if (IN(k) && IN((k) + 1)) xcd_barrier(bar); } while (0)
#ifdef PROBE_PHASE
#define REP(k) ((k) == PROBE_PHASE ? 2 : 1)
#else
#define REP(k) 1
#endif
#ifdef PROBE_SPIN
#define PH_BEGIN(k) const unsigned long long t0_##k = (PROBE_SPIN == (k)) ? __builtin_amdgcn_s_memrealtime() : 0ull;
#define PH_END(k) if (PROBE_SPIN == (k)) { __syncthreads(); const unsigned long long t1_ = __builtin_amdgcn_s_memrealtime(); while (__builtin_amdgcn_s_memrealtime() < t1_ + (t1_ - t0_##k)) __builtin_amdgcn_s_sleep(8); __syncthreads(); }
#else
#define PH_BEGIN(k)
#define PH_END(k)
#endif

    if (IN(0)) { PH_BEGIN(0) p0_prologue(F); PH_END(0) } SEAM(0);
    if (IN(1)) { PH_BEGIN(1) p1_norm(F); PH_END(1) } SEAM(1);
    if (IN(2)) { PH_BEGIN(2)
        pg8::Gemm g{(const pg8::bf16_t*)(F.ws + WS_B), (const pg8::bf16_t*)(F.ws + WS_WIN), SEQ, NPROJ, DM}; pg8::StaticOrder S; S.init(SEQ, NPROJ, F.G, (int)blockIdx.x);
        pg8::EpiBf16 E{(pg8::bf16_t*)(F.ws + WS_A), att::PITCH, 1024, att::QSCALE, 1024, 3072, (unsigned*)(F.ctl + CW_NMAXP), (unsigned*)(F.ctl + CW_NMAX), 2048};
        pg8::gemm_phase<pg8::EpiBf16, pg8::StaticOrder, true>(F.lds + RING_OFF, g, S, E); if (REP(2) == 2) { pg8::gemm_phase<pg8::EpiBf16, pg8::StaticOrder, true>(F.lds + RING_OFF, g, S, E); }
    PH_END(2) } SEAM(2);
    if (IN(3)) { PH_BEGIN(3)
        float lam;
        { const float a = wave_sum(F.in[I_LQ1][F.lane] * F.in[I_LK1][F.lane]), b = wave_sum(F.in[I_LQ2][F.lane] * F.in[I_LK2][F.lane]); lam = __expf(a) - __expf(b) + 0.2f; }
        const att::Tensors T{(const __hip_bfloat16*)(F.ws + WS_A), (__hip_bfloat16*)(F.ws + WS_B), F.in[I_GSUB], lam};
        const unsigned* nmx = (const unsigned*)(F.ctl + CW_NMAX); const unsigned* nmxp = (const unsigned*)(F.ctl + CW_NMAXP);
        LAS int* qslot = (LAS int*)(F.lds + LT_CNT + 256);
        constexpr int ATT_NITEMS = 1024 + 256; constexpr float T_SKIP = 40.0f;
#define ATT_QUEUE(VARIANT, TT, QW, WITH_CVT) for (bool more_ = true; more_;) { \
            if (F.tid == 0) { qslot[0] = (int)atomicAdd((unsigned*)(F.ctl + CW_QUEUE) + (QW), 1u); if (WITH_CVT) qslot[1] = (int)atomicAdd((unsigned*)(F.ctl + CW_QUEUE) + 128, 1u); } \
            __syncthreads(); \
            const int ui = __builtin_amdgcn_readfirstlane(qslot[0]); const int ci = WITH_CVT ? __builtin_amdgcn_readfirstlane(qslot[1]) : SIDE_NCHUNK; \
            __syncthreads(); \
            more_ = (ui < ATT_NITEMS) || (ci < SIDE_NCHUNK); \
            if (ui < ATT_NITEMS) { \
              \
            const int part = ui < 256 ? 1 : 0, u2 = ui - 256; \
            const int qb = part ? 127 - (ui >> 1) : 127 - (u2 >> 3), h = part ? 7 - (ui & 1) : (u2 & 7); \
            float sm = 0.f; \
            _Pragma("unroll") for (int mp = 0; mp < 2; ++mp) { const float qn = __uint_as_float(nmxp[32 * (qb >> 1) + 4 * h + 2 * mp]) + __uint_as_float(nmxp[32 * (qb >> 1) + 4 * h + 2 * mp + 1]), kn = __uint_as_float(nmx[32 + 4 * h + 2 * mp]) + __uint_as_float(nmx[32 + 4 * h + 2 * mp + 1]); \
                sm = fmaxf(sm, sqrtf(qn * kn)); } \
            const float slope2 = exp2f(-(float)(h + 1)) * att::LOG2E; \
            const float D = (2.0f * 1.02f * sm + T_SKIP) / slope2; \
            int t_lo = (int)ceilf(((float)(qb * 128 - 63) - D) * (1.0f / 64.0f)); t_lo = t_lo < 0 ? 0 : t_lo; \
            t_lo = __builtin_amdgcn_readfirstlane(t_lo); \
            const int n_t = 2 * qb + 2 - t_lo; const bool split = (h >= 6) && (n_t >= 96); const int n_a = n_t >> 1; \
            const int sidx = (h - 6) * 128 + qb; \
            float* dump = split ? (float*)(F.ws + WS_END) + (size_t)sidx * (8 * 17 * 256) : nullptr; \
            if (!part || split) att::attn_unit<VARIANT>(h, qb, part ? n_a : 0, (split && !part) ? n_a : n_t, part, dump, (unsigned*)(F.ctl + CW_SPLIT) + sidx, qslot + 2, (unsigned*)(F.ctl + CW_SPLIT) + 256 + sidx, 1.02f * sm, T_SKIP, TT, (att::lds_ptr)(F.lds + RING_OFF)); } \
            if (ci < SIDE_NCHUNK) side_chunk(F, ci); }
        ATT_QUEUE(0, T, 0, true)
#ifdef PROBE_ATT
        { const att::Tensors T2{(const __hip_bfloat16*)(F.ws + WS_A), (__hip_bfloat16*)(F.ws + WS_END), F.in[I_GSUB], lam};
          ATT_QUEUE(PROBE_ATT, T2, 64, false) }
#endif
#undef ATT_QUEUE
    PH_END(3) } SEAM(3);
    if (IN(4)) { PH_BEGIN(4)
        pg8::Gemm g{(const pg8::bf16_t*)(F.ws + WS_B), (const pg8::bf16_t*)(F.ws + WS_WOUT), SEQ, DM, DM}; pg8::StaticOrder S; S.init(SEQ, DM, F.G, (int)blockIdx.x);
        pg8::EpiBf16 E{(pg8::bf16_t*)(F.ws + WS_A), DM, 0, 1.0f, 0, 0, nullptr, nullptr, 0};
        pg8::gemm_phase<pg8::EpiBf16, pg8::StaticOrder, true>(F.lds + RING_OFF, g, S, E);
#ifdef PROBE_K
        { pg8::Gemm g2{(const pg8::bf16_t*)(F.ws + WS_B), (const pg8::bf16_t*)(F.ws + WS_WOUT), SEQ, DM, PROBE_K};
#ifdef PROBE_NOEPI
          EpiNull E2{(float*)(F.ws + WS_END)};
          pg8::gemm_phase<EpiNull, pg8::StaticOrder, true>(F.lds + RING_OFF, g2, S, E2); }
#else
          pg8::EpiBf16 E2{(pg8::bf16_t*)(F.ws + WS_END), DM, 0, 1.0f, 0, 0, nullptr, nullptr, 0};
          pg8::gemm_phase<pg8::EpiBf16, pg8::StaticOrder, true>(F.lds + RING_OFF, g2, S, E2); }
#endif
#endif if (REP(4) == 2) { pg8::gemm_phase<pg8::EpiBf16, pg8::StaticOrder, true>(F.lds + RING_OFF, g, S, E); }
    PH_END(4) } SEAM(4);
    if (IN(5)) { PH_BEGIN(5) p5_post_route(F); PH_END(5) } SEAM(5);
    if (IN(6)) { PH_BEGIN(6)
        moe_tables(F);
        pg8::Gemm g{(const pg8::bf16_t*)(F.ws + WS_B), (const pg8::bf16_t*)(F.ws + WS_W1), SEQ, 1024, DM};
        MoeOrder<4, true> S{(const LAS int*)(F.lds + LT_PRE), (const LAS int*)(F.lds + LT_CNT), (const int*)(F.ws + WS_LIST), F.G, F.vcu};
        EpiSwiglu E{(bf16*)(F.ws + WS_A + 160 * MiB)};
        pg8::gemm_phase<EpiSwiglu, MoeOrder<4, true>, true>(F.lds + RING_OFF, g, S, E);
        { LAS int* qs = (LAS int*)(F.lds + LT_CNT + 256);
          for (;;) { if (F.tid == 0) qs[0] = (int)atomicAdd((unsigned*)(F.ctl + CW_QUEUE) + 192, 1u);
              __syncthreads(); const int ci = __builtin_amdgcn_readfirstlane(qs[0]); __syncthreads();
              if (ci >= CVT_NCHUNK_D) break;
              cvt_chunk(F, CVT_NCHUNK_P3 + ci); } }
    PH_END(6) } SEAM(6);
    if (IN(7)) { PH_BEGIN(7)
        if (N_LAUNCHES != 1) moe_tables(F);
        pg8::Gemm g{(const pg8::bf16_t*)(F.ws + WS_A + 160 * MiB), (const pg8::bf16_t*)(F.ws + WS_W2), 2 * SEQ, DM, DEXP};
        MoeOrder<8, false> S{(const LAS int*)(F.lds + LT_PRE), (const LAS int*)(F.lds + LT_CNT), (const int*)(F.ws + WS_LIST), F.G, F.vcu};
        EpiDown E{(bf16*)(F.ws + WS_A)};
        pg8::gemm_phase<EpiDown, MoeOrder<8, false>, true>(F.lds + RING_OFF, g, S, E); if (REP(7) == 2) { pg8::gemm_phase<EpiDown, MoeOrder<8, false>, true>(F.lds + RING_OFF, g, S, E); }
    PH_END(7) } SEAM(7);
    if (IN(8)) { PH_BEGIN(8) if (N_LAUNCHES != 1) moe_tables(F); p8_final(F); PH_END(8) }
#undef IN
#undef SEAM
}

extern "C" void kernel_launch(void* const* d_in, const int* in_sizes, int n_in, void* d_out, int out_size, void* d_ws, size_t ws_size, hipStream_t stream) {
    static int grid = 0;
    if (grid == 0) {
        if (n_in != 23 || in_sizes[0] != SEQ * DM || out_size != SEQ * DM || ws_size < WS_END + 72 * MiB) { fprintf(stderr, "kernel_launch: shape/workspace mismatch (n_in %d, in0 %d, out %d, ws %zu < %zu); nothing launched\n", n_in, n_in > 0 ? in_sizes[0] : -1, out_size, ws_size, (size_t)WS_END); grid = -1; return; }
        int dev = 0, cus = 0, per_cu = 0;
        if (hipGetDevice(&dev) != hipSuccess || hipDeviceGetAttribute(&cus, hipDeviceAttributeMultiprocessorCount, dev) != hipSuccess) { fprintf(stderr, "kernel_launch: hipGetDevice / hipDeviceGetAttribute failed\n"); grid = -1; return; }
        if (hipFuncSetAttribute((const void*)mk_fwd, hipFuncAttributeMaxDynamicSharedMemorySize, LDS_BYTES) != hipSuccess) { fprintf(stderr, "kernel_launch: hipFuncSetAttribute failed\n"); grid = -1; return; }
        if (hipOccupancyMaxActiveBlocksPerMultiprocessor(&per_cu, (const void*)mk_fwd, NWAVES * 64, LDS_BYTES) != hipSuccess || per_cu < 1) { fprintf(stderr, "kernel_launch: occupancy query reports %d workgroups per CU\n", per_cu); }
        (void)hipGetLastError();
        grid = cus;
    }
    if (grid < 0) return;
    if (hipMemsetAsync((char*)d_ws + WS_CTL, 0, CTL_ZERO_BYTES, stream) != hipSuccess) { fprintf(stderr, "kernel_launch: hipMemsetAsync failed\n"); return; }
    Args a{};
    for (int i = 0; i < 23; ++i) a.in[i] = (const float*)d_in[i];
    a.out = (float*)d_out; a.ws = (unsigned char*)d_ws;
    for (int li = 0; li < N_LAUNCHES; ++li) {
        a.ph_lo = (N_LAUNCHES == 1) ? 0 : li; a.ph_hi = (N_LAUNCHES == 1) ? N_PHASES : li + 1;
        hipLaunchKernelGGL(mk_fwd, dim3(grid), dim3(NWAVES * 64), LDS_BYTES, stream, a);
        const hipError_t le = hipPeekAtLastError();
        if (le != hipSuccess) { fprintf(stderr, "kernel_launch: launch %d failed: %s\n", li, hipGetErrorName(le)); break; }
    }
}
```
